# Optimizing an MI355X kernel written in HIP

```python
import jax
import jax.numpy as jnp
from jax import lax
import numpy as np

D_MODEL = 1024
BATCH = 8
SEQ = 4096
DEPTH = 4
DEC_BATCH = 8
DEC_SEQ = 2048
PAST_LEN = 128

HEAD_DIM = 64
A_WIDTH = D_MODEL // 2
A_HEADS = A_WIDTH // HEAD_DIM
B_WIDTH = D_MODEL - A_WIDTH
IN_AB = 3 * A_WIDTH + 3 * B_WIDTH
DILATED_BRANCHES = ((128, 1), (512, 4), (2048, 16))
CONV_WIDTH = 3
ROPE_THETA = 500000.0
ROPE_DIM = HEAD_DIM // 4
RWKV_HEAD = 64
RWKV_HEADS = D_MODEL // RWKV_HEAD
DECAY_LORA = 64
AAA_LORA = 64
GATE_LORA = 128
GN_EPS = 64e-5
N_MEM = 256
CA_HEADS = 4
CA_HEAD_DIM = D_MODEL // CA_HEADS
FF_RAW = -(-8 * D_MODEL // 3)
D_FF = -(-FF_RAW // 256) * 256
N_EVEN = (DEPTH + 1) // 2
N_ODD = DEPTH // 2
RMS_EPS = 1e-6
NEG_INF = -1e30

kernel_name = 'hybrid_dilated_conv_rwkv7_encoder'


def rmsnorm(x, g):
    x32 = x.astype(jnp.float32)
    y = x32 * lax.rsqrt(jnp.mean(x32 * x32, axis=-1, keepdims=True) + RMS_EPS)
    return y.astype(x.dtype) * g


def partial_rotary(x, pos):
    half = ROPE_DIM // 2
    inv = ROPE_THETA ** (-2.0 * jnp.arange(half, dtype=jnp.float32) / ROPE_DIM)
    ang = pos.astype(jnp.float32)[:, None] * inv[None, :]
    cos = jnp.cos(ang)[None, :, None, :]
    sin = jnp.sin(ang)[None, :, None, :]
    x1 = x[..., :half].astype(jnp.float32)
    x2 = x[..., half:ROPE_DIM].astype(jnp.float32)
    rot = jnp.concatenate([x1 * cos - x2 * sin, x2 * cos + x1 * sin], axis=-1).astype(x.dtype)
    return jnp.concatenate([rot, x[..., ROPE_DIM:]], axis=-1)


def dilated_window_branch(q, k, v, window, dilation):
    B, S, H, hd = q.shape
    half = window // (2 * dilation)
    blk = half
    L = S // dilation
    nb = -(-L // blk)
    Lp = nb * blk

    def strided(t):
        return t.reshape(B, L, dilation, H, hd)

    qb = jnp.pad(strided(q), ((0, 0), (0, Lp - L), (0, 0), (0, 0), (0, 0)))
    qb = qb.reshape(B, nb, blk, dilation, H, hd)

    def neighbourhood(t):
        tb = jnp.pad(strided(t), ((0, 0), (blk, Lp - L + blk), (0, 0), (0, 0), (0, 0)))
        tb = tb.reshape(B, nb + 2, blk, dilation, H, hd)
        return jnp.concatenate([tb[:, :-2], tb[:, 1:-1], tb[:, 2:]], axis=2)

    kb = neighbourhood(k)
    vb = neighbourhood(v)
    s = jnp.einsum('bnqrhd,bnkrhd->bnrhqk', qb, kb, preferred_element_type=jnp.float32)
    qi = jnp.arange(blk)[:, None]
    kj = jnp.arange(3 * blk)[None, :]
    band = jnp.abs(kj - blk - qi) <= half
    tk = (jnp.arange(nb)[:, None] - 1) * blk + jnp.arange(3 * blk)[None, :]
    inside = (tk >= 0) & (tk < L)
    mask = band[None, :, :] & inside[:, None, :]
    s = jnp.where(mask[None, :, None, None], s, NEG_INF)
    m = jnp.max(s, axis=-1, keepdims=True)
    p = jnp.exp(s - m)
    den = jnp.sum(p, axis=-1, keepdims=True)
    o = jnp.einsum('bnrhqk,bnkrhd->bnqrhd', (p / den).astype(v.dtype), vb)
    lse = (m + jnp.log(den))[..., 0]
    o = o.reshape(B, Lp, dilation, H, hd)[:, :L].reshape(B, S, H, hd)
    lse = jnp.transpose(lse, (0, 1, 4, 2, 3)).reshape(B, Lp, dilation, H)[:, :L].reshape(B, S, H)
    return o, lse


def dilated_attention(q, k, v):
    outs, lses = [], []
    for window, dilation in DILATED_BRANCHES:
        o, l = dilated_window_branch(q, k, v, window, dilation)
        outs.append(o)
        lses.append(l)
    wts = jax.nn.softmax(jnp.stack(lses, axis=0), axis=0).astype(v.dtype)
    return jnp.einsum('gbsh,gbshd->bshd', wts, jnp.stack(outs, axis=0))


def short_gated_conv(bg, cg, h, conv_w):
    S = h.shape[1]
    u = cg * h
    pad = CONV_WIDTH // 2
    up = jnp.pad(u, ((0, 0), (pad, pad), (0, 0)))
    y = sum(conv_w[j] * up[:, j:j + S] for j in range(CONV_WIDTH))
    return bg * y


def window_conv_mixer(xn, pos, w_in, w_out, conv_w):
    B, S, _ = xn.shape
    z = xn @ w_in
    cuts = [A_WIDTH, 2 * A_WIDTH, 3 * A_WIDTH, 3 * A_WIDTH + B_WIDTH, 3 * A_WIDTH + 2 * B_WIDTH]
    q, k, v, bg, cg, h = jnp.split(z, cuts, axis=-1)

    def heads(t):
        return t.reshape(B, S, A_HEADS, HEAD_DIM)

    q = partial_rotary(heads(q), pos) * (HEAD_DIM ** -0.5)
    k = partial_rotary(heads(k), pos)
    ya = dilated_attention(q, k, heads(v)).reshape(B, S, A_WIDTH)
    yb = short_gated_conv(bg, cg, h, conv_w)
    return jnp.concatenate([ya, yb], axis=-1) @ w_out


def wkv7_scan(r, w, k, v, a, b, reverse):
    B, S, H, N = r.shape

    def step(state, inp):
        rt, wt, kt, vt, at, bt = inp
        sa = jnp.einsum('bhij,bhj->bhi', state, at)
        state = state * wt[:, :, None, :] + sa[..., None] * bt[:, :, None, :] + vt[..., None] * kt[:, :, None, :]
        return state, jnp.einsum('bhij,bhj->bhi', state, rt)

    xs = tuple(jnp.moveaxis(t, 1, 0) for t in (r, w, k, v, a, b))
    s0 = jnp.zeros((B, H, N, N), jnp.float32)
    _, out = lax.scan(step, s0, xs, reverse=reverse)
    return jnp.moveaxis(out, 0, 1)


def rwkv7_bidir_time_mix(xn, mu, w_r, w_k, w_v, w_o, w0, w1, w2, a0, a1, a2, g1, g2, k_k, k_a, r_k, lnx_w, lnx_b):
    B, S, D = xn.shape
    f32 = jnp.float32

    def heads(t):
        return t.astype(f32).reshape(B, S, RWKV_HEADS, RWKV_HEAD)

    xp = jnp.pad(xn, ((0, 0), (1, 1), (0, 0)))
    xx = 0.5 * (xp[:, :-2] + xp[:, 2:]) - xn
    xr, xw, xk, xv, xa, xg = [xn + xx * mu[i] for i in range(6)]
    r = heads(xr @ w_r)
    k_lin = xk @ w_k
    k = heads(k_lin)
    v = heads(xv @ w_v)
    g = jax.nn.sigmoid(xg @ g1) @ g2
    kk = heads(k_lin * k_k)
    kk = kk * lax.rsqrt(jnp.maximum(jnp.sum(kk * kk, axis=-1, keepdims=True), 1e-24))
    k_a_h = k_a.astype(f32).reshape(RWKV_HEADS, RWKV_HEAD)
    r_k32 = r_k.astype(f32)
    outs, bonus = [], []
    for d in range(2):
        w_log = -jax.nn.softplus(-(w0[d] + jnp.tanh(xw @ w1[d]) @ w2[d]).astype(f32)) - 0.5
        decay = heads(jnp.exp(-jnp.exp(w_log)))
        a = heads(jax.nn.sigmoid((a0[d] + (xa @ a1[d]) @ a2[d]).astype(f32)))
        k_d = k * (1.0 + (a - 1.0) * k_a_h)
        outs.append(wkv7_scan(r, decay, k_d, v, -kk, kk * a, reverse=(d == 1)))
        bonus.append(jnp.sum(r * k_d * r_k32, axis=-1, keepdims=True) * v)
    y = outs[0] + outs[1]
    mean = jnp.mean(y, axis=-1, keepdims=True)
    var = jnp.mean(jnp.square(y - mean), axis=-1, keepdims=True)
    y = (y - mean) * lax.rsqrt(var + GN_EPS)
    y = y.reshape(B, S, D) * lnx_w.astype(f32) + lnx_b.astype(f32) + (bonus[0] + bonus[1]).reshape(B, S, D)
    return (y.astype(xn.dtype) * g) @ w_o


def memory_cross_attention(xn, mem_n, w_q, w_kv, w_o):
    B, S, D = xn.shape
    M = mem_n.shape[1]
    q = (xn @ w_q).reshape(B, S, CA_HEADS, CA_HEAD_DIM)
    k, v = jnp.split(mem_n @ w_kv, 2, axis=-1)
    k = k.reshape(B, M, CA_HEADS, CA_HEAD_DIM)
    v = v.reshape(B, M, CA_HEADS, CA_HEAD_DIM)
    s = jnp.einsum('bqhd,bkhd->bhqk', q, k, preferred_element_type=jnp.float32) * (CA_HEAD_DIM ** -0.5)
    p = jax.nn.softmax(s, axis=-1).astype(v.dtype)
    o = jnp.einsum('bhqk,bkhd->bqhd', p, v).reshape(B, S, D)
    return o @ w_o


def swiglu(xn, w_gu, w_down):
    gate, up = jnp.split(xn @ w_gu, 2, axis=-1)
    return (jax.nn.silu(gate) * up) @ w_down


def encoder_trunk(x, mem, p):
    pos = jnp.arange(x.shape[1])
    for l in range(DEPTH):
        xn = rmsnorm(x, p['norm_mix'][l])
        if l % 2 == 0:
            e = l // 2
            x = x + window_conv_mixer(xn, pos, p['ab_w_in'][e], p['ab_w_out'][e], p['ab_conv'][e])
        else:
            o = l // 2
            x = x + rwkv7_bidir_time_mix(
                xn, p['rw_mu'][o], p['rw_wr'][o], p['rw_wk'][o], p['rw_wv'][o], p['rw_wo'][o],
                p['rw_w0'][o], p['rw_w1'][o], p['rw_w2'][o], p['rw_a0'][o], p['rw_a1'][o], p['rw_a2'][o],
                p['rw_g1'][o], p['rw_g2'][o], p['rw_kk'][o], p['rw_ka'][o], p['rw_rk'][o],
                p['rw_lnx_w'][o], p['rw_lnx_b'][o])
        mem_n = rmsnorm(mem, p['norm_mem'][l])
        x = x + memory_cross_attention(rmsnorm(x, p['norm_cross'][l]), mem_n,
                                       p['ca_wq'][l], p['ca_wkv'][l], p['ca_wo'][l])
        x = x + swiglu(rmsnorm(x, p['norm_ffn'][l]), p['ffn_wgu'][l], p['ffn_wdown'][l])
    return rmsnorm(x, p['norm_final'])


def setup_inputs(seed: int = 0) -> dict:
    key = jax.random.key(seed)
    keys = jax.random.split(key, 64)
    counter = iter(range(64))
    f32 = jnp.float32

    def nk():
        return keys[next(counter)]

    def nrm(shape, scale):
        return jax.random.normal(nk(), shape, f32) * scale

    def gain(shape, base=1.0):
        return base + 0.05 * jax.random.normal(nk(), shape, f32)

    def unif(shape, lo, hi):
        return jax.random.uniform(nk(), shape, f32, lo, hi)

    D = D_MODEL
    return {
        'x_prompt': nrm((BATCH, SEQ, D), 1.0),
        'x_sample': nrm((DEC_BATCH, DEC_SEQ, D), 1.0),
        'mem_prompt': nrm((BATCH, N_MEM, D), 1.0),
        'mem_sample': nrm((DEC_BATCH, N_MEM, D), 1.0),
        'norm_mix': gain((DEPTH, D)),
        'norm_cross': gain((DEPTH, D)),
        'norm_mem': gain((DEPTH, D)),
        'norm_ffn': gain((DEPTH, D)),
        'norm_final': gain((D,)),
        'ab_w_in': nrm((N_EVEN, D, IN_AB), D ** -0.5),
        'ab_w_out': nrm((N_EVEN, A_WIDTH + B_WIDTH, D), (A_WIDTH + B_WIDTH) ** -0.5),
        'ab_conv': nrm((N_EVEN, CONV_WIDTH, B_WIDTH), CONV_WIDTH ** -0.5),
        'rw_mu': unif((N_ODD, 6, D), 0.0, 1.0),
        'rw_wr': nrm((N_ODD, D, D), D ** -0.5),
        'rw_wk': nrm((N_ODD, D, D), D ** -0.5),
        'rw_wv': nrm((N_ODD, D, D), D ** -0.5),
        'rw_wo': nrm((N_ODD, D, D), D ** -0.5),
        'rw_w0': unif((N_ODD, 2, D), -5.0, 0.0),
        'rw_w1': nrm((N_ODD, 2, D, DECAY_LORA), D ** -0.5),
        'rw_w2': nrm((N_ODD, 2, DECAY_LORA, D), 0.1 * DECAY_LORA ** -0.5),
        'rw_a0': nrm((N_ODD, 2, D), 0.5),
        'rw_a1': nrm((N_ODD, 2, D, AAA_LORA), D ** -0.5),
        'rw_a2': nrm((N_ODD, 2, AAA_LORA, D), 0.5 * AAA_LORA ** -0.5),
        'rw_g1': nrm((N_ODD, D, GATE_LORA), D ** -0.5),
        'rw_g2': nrm((N_ODD, GATE_LORA, D), GATE_LORA ** -0.5),
        'rw_kk': gain((N_ODD, D), 0.85),
        'rw_ka': gain((N_ODD, D)),
        'rw_rk': nrm((N_ODD, RWKV_HEADS, RWKV_HEAD), 0.1),
        'rw_lnx_w': gain((N_ODD, D)),
        'rw_lnx_b': nrm((N_ODD, D), 0.02),
        'ca_wq': nrm((DEPTH, D, D), D ** -0.5),
        'ca_wkv': nrm((DEPTH, D, 2 * D), D ** -0.5),
        'ca_wo': nrm((DEPTH, D, D), D ** -0.5),
        'ffn_wgu': nrm((DEPTH, D, 2 * D_FF), D ** -0.5),
        'ffn_wdown': nrm((DEPTH, D_FF, D), D_FF ** -0.5),
    }


def reference(x_prompt, x_sample, mem_prompt, mem_sample, norm_mix, norm_cross, norm_mem, norm_ffn,
              norm_final, ab_w_in, ab_w_out, ab_conv, rw_mu, rw_wr, rw_wk, rw_wv, rw_wo, rw_w0, rw_w1,
              rw_w2, rw_a0, rw_a1, rw_a2, rw_g1, rw_g2, rw_kk, rw_ka, rw_rk, rw_lnx_w, rw_lnx_b,
              ca_wq, ca_wkv, ca_wo, ffn_wgu, ffn_wdown):
    p = dict(norm_mix=norm_mix, norm_cross=norm_cross, norm_mem=norm_mem, norm_ffn=norm_ffn,
             norm_final=norm_final, ab_w_in=ab_w_in, ab_w_out=ab_w_out, ab_conv=ab_conv,
             rw_mu=rw_mu, rw_wr=rw_wr, rw_wk=rw_wk, rw_wv=rw_wv, rw_wo=rw_wo,
             rw_w0=rw_w0, rw_w1=rw_w1, rw_w2=rw_w2, rw_a0=rw_a0, rw_a1=rw_a1, rw_a2=rw_a2,
             rw_g1=rw_g1, rw_g2=rw_g2, rw_kk=rw_kk, rw_ka=rw_ka, rw_rk=rw_rk,
             rw_lnx_w=rw_lnx_w, rw_lnx_b=rw_lnx_b, ca_wq=ca_wq, ca_wkv=ca_wkv, ca_wo=ca_wo,
             ffn_wgu=ffn_wgu, ffn_wdown=ffn_wdown)
    y_prompt = encoder_trunk(x_prompt, mem_prompt, p)
    y_sample = encoder_trunk(x_sample, mem_sample, p)
    return (y_prompt, y_sample)
```

```cpp
#include <hip/hip_runtime.h>
#include <hip/hip_cooperative_groups.h>
#include <cstdio>
namespace cg = cooperative_groups;

#define LAS __attribute__((address_space(3)))
typedef unsigned short u16;
typedef short bf16x8 __attribute__((ext_vector_type(8)));
typedef float f32x4 __attribute__((ext_vector_type(4)));
typedef float f32x2 __attribute__((ext_vector_type(2)));
typedef unsigned u32x4 __attribute__((ext_vector_type(4)));
typedef unsigned u32x2 __attribute__((ext_vector_type(2)));

constexpr int DM = 1024;
constexpr int TC = 16384;
constexpr int NCHUNK = 3;
constexpr int NTHREADS = 512;
constexpr int LDS_BYTES = 139264;

__device__ __forceinline__ unsigned cvt_pk_bf16(float lo, float hi) { unsigned r; asm volatile("v_cvt_pk_bf16_f32 %0, %1, %2" : "=v"(r) : "v"(lo), "v"(hi)); return r; }
__device__ __forceinline__ u16 f2bf(float x) { return (u16)(cvt_pk_bf16(x, 0.f) & 0xffffu); }
__device__ __forceinline__ float bf2f(u16 b) { return __uint_as_float(((unsigned)b) << 16); }
__device__ __forceinline__ float bflo(unsigned w) { return __uint_as_float(w << 16); }
__device__ __forceinline__ float bfhi(unsigned w) { return __uint_as_float(w & 0xffff0000u); }
__device__ __forceinline__ float sigmoidf_(float x) { return 1.0f / (1.0f + __expf(-x)); }
__device__ __forceinline__ float wave_sum(float v) {
#pragma unroll
    for (int o = 32; o >= 1; o >>= 1) v += __shfl_xor(v, o);
    return v;
}
__device__ __forceinline__ int ltid() { int v = threadIdx.x; asm volatile("" : "+v"(v)); return v; }
namespace pg8 {
#define PG8_LAS __attribute__((address_space(3)))
typedef unsigned short bf16_t;
typedef short bf16x8 __attribute__((ext_vector_type(8)));
typedef float f32x4 __attribute__((ext_vector_type(4)));
typedef unsigned u32x4 __attribute__((ext_vector_type(4)));
constexpr int BM = 256, BK = 64, HALF = 128, HTB = HALF * BK * 2  , STAGE_BYTES = 8 * HTB, NXCD = 8, WGM = 8;

__host__ __device__ __forceinline__ int lds_byte(int r, int c) { const int st = (r >> 4) * 2 + (c >> 5), rr = r & 15, cc = c & 31, ob = rr * 64 + cc * 2; return st * 1024 + (ob ^ (((ob >> 9) & 1) << 5)); }
__host__ __device__ __forceinline__ void stage_rc(int b, int& R, int& C) { const int st = b / 1024, sb = b % 1024, swz = sb ^ (((sb >> 9) & 1) << 5); R = (st >> 1) * 16 + swz / 64; C = (st & 1) * 32 + (swz % 64) / 2; }
__host__ __device__ __forceinline__ int perm32(int rho) { const int n = rho >> 4, i = rho & 15; return 8 * (i >> 2) + 4 * n + (i & 3); }

struct Unit { int pm, pn; };
struct Gemm { const bf16_t* A; const bf16_t* Bt; int M, N, K; };

struct StaticOrder {
    int nM, nN, nwg, G, c;
    __host__ __device__ void init(int M, int N, int G_, int c_) { nM = M / BM; nN = N / BM; nwg = nM * nN; G = G_; c = c_; }
    __host__ __device__ bool next(int i, Unit& u) const {
        const long L = (long)i * G + c; if (L >= nwg) return false;
        int wgid = (int)L; { const int q = nwg / NXCD, r = nwg % NXCD, xcd = wgid % NXCD, off = wgid / NXCD; wgid = (xcd < r ? xcd * (q + 1) : r * (q + 1) + (xcd - r) * q) + off; }
        const int nig = WGM * nN, gid = wgid / nig, fm = gid * WGM, gsz = (nM - fm) < WGM ? (nM - fm) : WGM;
        u.pm = fm + ((wgid % nig) % gsz); u.pn = (wgid % nig) / gsz; return true;
    }
    __device__ __forceinline__ void a_ready(const Unit&) const {}
    __device__ __forceinline__ void done(const Unit&) const {}
};
struct EpiStore16 {
    static constexpr bool PERM = false, AFTER_DRAIN = false;
    u16* O; int ldc;
    __device__ __forceinline__ void operator()(const f32x4 (&acc)[2][2][4][2], const Unit& u, int wr, int wc, int fr, int fq) const {
        const int row0 = u.pm * BM + wr * 64 + fr, col0 = u.pn * BM + wc * 32 + 4 * fq;
#pragma unroll
        for (int ai = 0; ai < 2; ++ai)
#pragma unroll
            for (int m = 0; m < 4; ++m) { u16* rowp = O + (size_t)(row0 + ai * HALF + m * 16) * ldc + col0;
#pragma unroll
                for (int bj = 0; bj < 2; ++bj)
#pragma unroll
                    for (int n = 0; n < 2; ++n) { const f32x4 v = acc[ai][bj][m][n]; u32x2 w; w.x = cvt_pk_bf16(v[0], v[1]); w.y = cvt_pk_bf16(v[2], v[3]); *(u32x2*)(rowp + bj * HALF + n * 16) = w; } }
    }
};
struct EpiResid {
    static constexpr bool PERM = false, AFTER_DRAIN = false;
    float* X;
    __device__ __forceinline__ void operator()(const f32x4 (&acc)[2][2][4][2], const Unit& u, int wr, int wc, int fr, int fq) const {
        const int row0 = u.pm * BM + wr * 64 + fr, col0 = u.pn * BM + wc * 32 + 4 * fq;
#pragma unroll
        for (int ai = 0; ai < 2; ++ai)
#pragma unroll
            for (int m = 0; m < 4; ++m) { float* rowp = X + (size_t)(row0 + ai * HALF + m * 16) * 1024 + col0;
#pragma unroll
                for (int bj = 0; bj < 2; ++bj)
#pragma unroll
                    for (int n = 0; n < 2; ++n) { f32x4* p = (f32x4*)(rowp + bj * HALF + n * 16); *p = *p + acc[ai][bj][m][n]; } }
    }
};
struct EpiSwiglu {
    static constexpr bool PERM = false, AFTER_DRAIN = false;
    u16* H;
    __device__ __forceinline__ void operator()(const f32x4 (&acc)[2][2][4][2], const Unit& u, int wr, int wc, int fr, int fq) const {
        const int row0 = u.pm * BM + wr * 64 + fr, col0 = u.pn * 128 + wc * 16 + 4 * fq;
#pragma unroll
        for (int ai = 0; ai < 2; ++ai)
#pragma unroll
            for (int m = 0; m < 4; ++m) { u16* rowp = H + (size_t)(row0 + ai * HALF + m * 16) * 2816 + col0;
#pragma unroll
                for (int bj = 0; bj < 2; ++bj) { const f32x4 g = acc[ai][bj][m][0], up = acc[ai][bj][m][1]; float h[4];
#pragma unroll
                    for (int j = 0; j < 4; ++j) h[j] = g[j] / (1.0f + __expf(-g[j])) * up[j];
                    u32x2 w; w.x = cvt_pk_bf16(h[0], h[1]); w.y = cvt_pk_bf16(h[2], h[3]); *(u32x2*)(rowp + bj * 64) = w; } }
    }
};
struct EpiRwkv {
    static constexpr bool PERM = false, AFTER_DRAIN = false;
    u16* RKV; u16* L1;
    __device__ __forceinline__ void operator()(const f32x4 (&acc)[2][2][4][2], const Unit& u, int wr, int wc, int fr, int fq) const {
        const int row0 = u.pm * BM + wr * 64 + fr;
        if (u.pn < 12) {
            const int col0 = u.pn * BM + wc * 32 + 4 * fq;
#pragma unroll
            for (int ai = 0; ai < 2; ++ai)
#pragma unroll
                for (int m = 0; m < 4; ++m) { u16* rowp = RKV + (size_t)(row0 + ai * HALF + m * 16) * 3072 + col0;
#pragma unroll
                    for (int bj = 0; bj < 2; ++bj)
#pragma unroll
                        for (int n = 0; n < 2; ++n) { const f32x4 v = acc[ai][bj][m][n]; u32x2 w; w.x = cvt_pk_bf16(v[0], v[1]); w.y = cvt_pk_bf16(v[2], v[3]); *(u32x2*)(rowp + bj * HALF + n * 16) = w; } }
        } else {
            const int col0 = (u.pn - 12) * BM + wc * 32 + 4 * fq; const int t = u.pn - 12;
#pragma unroll
            for (int ai = 0; ai < 2; ++ai)
#pragma unroll
                for (int m = 0; m < 4; ++m) { u16* rowp = L1 + (size_t)(row0 + ai * HALF + m * 16) * 512 + col0;
#pragma unroll
                    for (int bj = 0; bj < 2; ++bj)
#pragma unroll
                        for (int n = 0; n < 2; ++n) { f32x4 v = acc[ai][bj][m][n];
#pragma unroll
                            for (int j = 0; j < 4; ++j) { float x = v[j]; if (t == 1) x = sigmoidf_(x); else if (bj == 0) x = tanhf(x); v[j] = x; }
                            u32x2 w; w.x = cvt_pk_bf16(v[0], v[1]); w.y = cvt_pk_bf16(v[2], v[3]); *(u32x2*)(rowp + bj * HALF + n * 16) = w; } }
        }
    }
};
struct EpiLora2 {
    static constexpr bool PERM = false, AFTER_DRAIN = false;
    u16* EAG; const float* w0; const float* a0; int M;
    __device__ __forceinline__ void operator()(const f32x4 (&acc)[2][2][4][2], const Unit& u, int wr, int wc, int fr, int fq) const {
        const int row0 = u.pm * BM + wr * 64 + fr; const int sel = u.pn >> 2; const int col0 = (u.pn & 3) * BM + wc * 32 + 4 * fq;
        u16* base = EAG + (size_t)sel * M * 1024;
        const float* bias = sel < 2 ? (w0 + sel * 1024) : (a0 + ((sel - 2) & 1) * 1024);
        f32x4 bv[2][2];
#pragma unroll
        for (int bj = 0; bj < 2; ++bj)
#pragma unroll
            for (int n = 0; n < 2; ++n) bv[bj][n] = (sel < 4) ? *(const f32x4*)(bias + col0 + bj * HALF + n * 16) : (f32x4){0.f, 0.f, 0.f, 0.f};
#pragma unroll
        for (int ai = 0; ai < 2; ++ai)
#pragma unroll
            for (int m = 0; m < 4; ++m) { u16* rowp = base + (size_t)(row0 + ai * HALF + m * 16) * 1024 + col0;
#pragma unroll
                for (int bj = 0; bj < 2; ++bj)
#pragma unroll
                    for (int n = 0; n < 2; ++n) { const f32x4 v = acc[ai][bj][m][n] + bv[bj][n]; u32x2 w;
                        if (sel < 2) { _Float16 h[4];
#pragma unroll
                            for (int j = 0; j < 4; ++j) h[j] = (_Float16)(0.60653066f * sigmoidf_(v[j]));
                            w.x = (unsigned)__builtin_bit_cast(u16, h[0]) | ((unsigned)__builtin_bit_cast(u16, h[1]) << 16);
                            w.y = (unsigned)__builtin_bit_cast(u16, h[2]) | ((unsigned)__builtin_bit_cast(u16, h[3]) << 16);
                        } else if (sel < 4) { w.x = cvt_pk_bf16(sigmoidf_(v[0]), sigmoidf_(v[1])); w.y = cvt_pk_bf16(sigmoidf_(v[2]), sigmoidf_(v[3]));
                        } else { w.x = cvt_pk_bf16(v[0], v[1]); w.y = cvt_pk_bf16(v[2], v[3]); }
                        *(u32x2*)(rowp + bj * HALF + n * 16) = w; } }
    }
};
template <class Epi, class Sched, bool STAMP = false>
__device__ __forceinline__ void gemm_phase(PG8_LAS unsigned char* lds, const Gemm g, const Sched& S, const Epi& E, unsigned long long* stamps) {
    const int tid = threadIdx.x, wid = __builtin_amdgcn_readfirstlane(tid >> 6), lane = tid & 63, wr = wid >> 2, wc = wid & 3, fr = lane & 15, fq = lane >> 4;
    const int K = g.K, nt = K / BK;
    int ts_lo = 0, ts_hi = 0, nts = 0; const unsigned long long rt_entry = STAMP ? (unsigned long long)wall_clock64() : 0ull;
#define PG8_STAMP() do { if (STAMP && wid == 0 && nts < 64) { const unsigned long long _c = (unsigned long long)clock64(); \
        ts_lo = (lane == nts) ? (int)(unsigned)_c : ts_lo; ts_hi = (lane == nts) ? (int)(unsigned)(_c >> 32) : ts_hi; ++nts; } } while (0)
    PG8_STAMP();
    unsigned voffA[2], voffB[2];
#pragma unroll
    for (int i = 0; i < 2; ++i) { int R, C; stage_rc(tid * 16 + i * 8192, R, C); const int Rb = Epi::PERM ? ((R & ~31) + perm32(R & 31)) : R;
        voffA[i] = (unsigned)(R * K + C) * 2u; voffB[i] = (unsigned)(Rb * K + C) * 2u; }
    const size_t kstep = (size_t)(BK * 2);
    const size_t hstep = (size_t)HALF * K * 2;
    const size_t tstep = 2 * hstep;
    const unsigned ldsw = (unsigned)wid * 1024u;
    const int aoff = lds_byte(wr * 64 + fr, fq * 8), boff = lds_byte(wc * 32 + fr, fq * 8);
#define PG8_SA(b, h) (((b) * 2 + (h)) * HTB)
#define PG8_SB(b, h) ((4 + (b) * 2 + (h)) * HTB)
#define PG8_STAGE(bufoff, gbase, voff) do { _Pragma("unroll") for (int _i = 0; _i < 2; ++_i) \
        __builtin_amdgcn_global_load_lds((const unsigned*)((const char*)(gbase) + (voff)[_i]), (PG8_LAS unsigned*)(lds + (bufoff) + ldsw + _i * 8192), 16, 0, 0); } while (0)
#define PG8_LDA(dst, b, h) do { _Pragma("unroll") for (int m = 0; m < 4; ++m) _Pragma("unroll") for (int k = 0; k < 2; ++k) dst[m][k] = *(const PG8_LAS bf16x8*)(lds + PG8_SA(b, h) + aoff + m * 2048 + k * 1024); } while (0)
#define PG8_LDB(dst, b, h) do { _Pragma("unroll") for (int n = 0; n < 2; ++n) _Pragma("unroll") for (int k = 0; k < 2; ++k) dst[n][k] = *(const PG8_LAS bf16x8*)(lds + PG8_SB(b, h) + boff + n * 2048 + k * 1024); } while (0)
#define PG8_MMA(ai, bj, At, Bt) do { __builtin_amdgcn_s_setprio(1); _Pragma("unroll") for (int m = 0; m < 4; ++m) _Pragma("unroll") for (int n = 0; n < 2; ++n) _Pragma("unroll") for (int k = 0; k < 2; ++k) \
        acc[ai][bj][m][n] = __builtin_amdgcn_mfma_f32_16x16x32_bf16(Bt[n][k], At[m][k], acc[ai][bj][m][n], 0, 0, 0); __builtin_amdgcn_s_setprio(0); } while (0)
#define PG8_WAIT_V(n) asm volatile("s_waitcnt vmcnt(" #n ")" ::: "memory")
#define PG8_WAIT_L(n) asm volatile("s_waitcnt lgkmcnt(" #n ")" ::: "memory")
#define PG8_BAR __builtin_amdgcn_s_barrier()
#define PG8_SCHED __builtin_amdgcn_sched_barrier(0)
    Unit cur, nxt; int ui = 0;
    if (!S.next(0, cur)) return;
    f32x4 acc[2][2][4][2];
#pragma unroll
    for (int a = 0; a < 2; ++a)
#pragma unroll
        for (int b = 0; b < 2; ++b)
#pragma unroll
            for (int m = 0; m < 4; ++m)
#pragma unroll
                for (int n = 0; n < 2; ++n) acc[a][b][m][n] = (f32x4){0.f, 0.f, 0.f, 0.f};
    bf16x8 At[4][2], B0[2][2], B1[2][2];
    const char* cA = (const char*)g.A + (size_t)cur.pm * tstep; const char* cB = (const char*)g.Bt + (size_t)cur.pn * tstep;
    S.a_ready(cur);
    PG8_STAGE(PG8_SB(0, 0), cB, voffB); PG8_STAGE(PG8_SA(0, 0), cA, voffA); PG8_STAGE(PG8_SB(0, 1), cB + hstep, voffB); PG8_STAGE(PG8_SA(0, 1), cA + hstep, voffA);
    if (wr == 1) PG8_BAR;
    PG8_WAIT_V(4); PG8_BAR;
    PG8_STAGE(PG8_SB(1, 0), cB + kstep, voffB); PG8_STAGE(PG8_SA(1, 0), cA + kstep, voffA); PG8_STAGE(PG8_SB(1, 1), cB + hstep + kstep, voffB);
    PG8_WAIT_V(6); PG8_BAR;
    PG8_STAMP();
    for (;;) {
        const bool has_next = S.next(ui + 1, nxt);
        const char* nA = has_next ? (const char*)g.A + (size_t)nxt.pm * tstep : cA; const char* nB = has_next ? (const char*)g.Bt + (size_t)nxt.pn * tstep : cB;
        for (int t = 0; t < nt; t += 2) {
            const bool last = (t == nt - 2);
            const char* a1 = cA + (size_t)(t + 1) * kstep;
            const char* a2 = last ? nA : cA + (size_t)(t + 2) * kstep; const char* b2 = last ? nB : cB + (size_t)(t + 2) * kstep;
            const char* a3 = a2 + kstep; const char* b3 = b2 + kstep;
            if (last && has_next) S.a_ready(nxt);
            PG8_LDB(B0, 0, 0); PG8_SCHED; PG8_LDA(At, 0, 0); PG8_STAGE(PG8_SA(1, 1), a1 + hstep, voffA);
            PG8_WAIT_L(8); PG8_BAR; PG8_WAIT_L(0); PG8_MMA(0, 0, At, B0); PG8_BAR; PG8_SCHED;
            PG8_LDB(B1, 0, 1); PG8_STAGE(PG8_SB(0, 0), b2, voffB);
            PG8_BAR; PG8_WAIT_L(0); PG8_MMA(0, 1, At, B1); PG8_BAR;
            PG8_LDA(At, 0, 1); PG8_STAGE(PG8_SA(0, 0), a2, voffA);
            PG8_BAR; PG8_WAIT_L(0); PG8_MMA(1, 0, At, B0); PG8_BAR; PG8_SCHED;
            PG8_STAGE(PG8_SB(0, 1), b2 + hstep, voffB);
            PG8_WAIT_V(6); PG8_BAR; PG8_MMA(1, 1, At, B1); PG8_BAR;
            PG8_LDB(B0, 1, 0); PG8_SCHED; PG8_LDA(At, 1, 0); PG8_STAGE(PG8_SA(0, 1), a2 + hstep, voffA);
            PG8_WAIT_L(8); PG8_BAR; PG8_WAIT_L(0); PG8_MMA(0, 0, At, B0); PG8_BAR; PG8_SCHED;
            PG8_LDB(B1, 1, 1); PG8_STAGE(PG8_SB(1, 0), b3, voffB);
            PG8_BAR; PG8_WAIT_L(0); PG8_MMA(0, 1, At, B1); PG8_BAR;
            PG8_LDA(At, 1, 1); PG8_STAGE(PG8_SA(1, 0), a3, voffA);
            PG8_BAR; PG8_WAIT_L(0); PG8_MMA(1, 0, At, B0); PG8_BAR; PG8_SCHED;
            PG8_STAGE(PG8_SB(1, 1), b3 + hstep, voffB);
            PG8_WAIT_V(6); PG8_BAR; PG8_MMA(1, 1, At, B1); PG8_BAR;
        }
        PG8_STAMP();
        if constexpr (!Epi::AFTER_DRAIN) { E(acc, cur, wr, wc, fr, fq); S.done(cur); }
        PG8_STAMP();
        if (!has_next) break;
#pragma unroll
        for (int a = 0; a < 2; ++a)
#pragma unroll
            for (int b = 0; b < 2; ++b)
#pragma unroll
                for (int m = 0; m < 4; ++m)
#pragma unroll
                    for (int n = 0; n < 2; ++n) acc[a][b][m][n] = (f32x4){0.f, 0.f, 0.f, 0.f};
        cur = nxt; cA = nA; cB = nB; ++ui;
    }
    PG8_WAIT_V(0);
    if (wr == 0) PG8_BAR;
    PG8_BAR;
    if constexpr (Epi::AFTER_DRAIN) { E.fused(acc, cur, wr, wc, fr, fq, lds, wid, lane); S.done(cur); }
    PG8_STAMP();
    if (STAMP && wid == 0) { stamps[lane] = lane < nts ? (((unsigned long long)(unsigned)ts_hi << 32) | (unsigned)ts_lo) : 0ull;
        if (lane == 62) stamps[62] = rt_entry; if (lane == 63) stamps[63] = (unsigned long long)wall_clock64(); }
#undef PG8_STAMP
#undef PG8_SA
#undef PG8_SB
#undef PG8_STAGE
#undef PG8_LDA
#undef PG8_LDB
#undef PG8_MMA
#undef PG8_WAIT_V
#undef PG8_WAIT_L
#undef PG8_BAR
#undef PG8_SCHED
}
}
struct Params { const float* in[35]; float* out; unsigned char* ws; int pad0, pad1; };

constexpr size_t MB = 1u << 20;
constexpr size_t WS_WMIX  = 0;
constexpr size_t WMIX_B   = (size_t)3584 * 2048 * 2;
constexpr size_t WMIX_C   = WMIX_B + (size_t)5120 * 512 * 2;
constexpr size_t WS_WQ    = WS_WMIX + WMIX_C + (size_t)1024 * 1024 * 2;
constexpr size_t WS_WKV   = WS_WQ + (size_t)1024 * 1024 * 2;
constexpr size_t WS_WO    = WS_WKV + (size_t)2048 * 1024 * 2;
constexpr size_t WS_WGU   = WS_WO + (size_t)1024 * 1024 * 2;
constexpr size_t WS_WDN   = WS_WGU + (size_t)5632 * 1024 * 2;
constexpr size_t WS_MN    = WS_WDN + (size_t)1024 * 2816 * 2;
constexpr size_t WS_KV    = WS_MN + (size_t)4096 * 1024 * 2;
constexpr size_t WS_ROPE  = WS_KV + (size_t)4096 * 2048 * 2;
constexpr size_t WS_ARENA = WS_ROPE + (size_t)4096 * 16 * 4;
constexpr size_t AR_A = 0, AR_B = (size_t)TC * 8192, AR_C = (size_t)TC * 14336, AR_D = (size_t)TC * 24576, AR_END = (size_t)TC * 26624;
constexpr size_t WS_END = WS_ARENA + AR_END;

__device__ __forceinline__ int map_row(int n, int mode) {
    if (mode == 0) return n;
    const int up = n >= 2816, c = up ? n - 2816 : n;
    return (c >> 4) * 32 + up * 16 + (c & 15);
}
__device__ void tr_job(LAS unsigned char* lds, const float* __restrict__ src, int ld_src, int K, int N, u16* dst, int ld_dst, int col0, const float* __restrict__ s1, int mode, int rot) {
    LAS float* T = (LAS float*)lds;
    const int tid = ltid(), nkt = K >> 6, nnt = N >> 6, ntile = nkt * nnt;
    for (int t = (blockIdx.x + rot) % gridDim.x; t < ntile; t += gridDim.x) {
        const int kt = t / nnt, nt = t % nnt;
#pragma unroll
        for (int it = 0; it < 2; ++it) {
            const int kk = (tid >> 4) + it * 32, n4 = (tid & 15) * 4;
            f32x4 v = *(const f32x4*)(src + (size_t)(kt * 64 + kk) * ld_src + nt * 64 + n4);
            const float s = s1 ? s1[kt * 64 + kk] : 1.0f;
#pragma unroll
            for (int e = 0; e < 4; ++e) T[(n4 + e) * 65 + kk] = v[e] * s;
        }
        __syncthreads();
        {
            const int n = tid >> 3, k8 = (tid & 7) * 8; float f[8];
#pragma unroll
            for (int e = 0; e < 8; ++e) f[e] = T[n * 65 + k8 + e];
            u32x4 w; w.x = cvt_pk_bf16(f[0], f[1]); w.y = cvt_pk_bf16(f[2], f[3]); w.z = cvt_pk_bf16(f[4], f[5]); w.w = cvt_pk_bf16(f[6], f[7]);
            *(u32x4*)(dst + (size_t)map_row(nt * 64 + n, mode) * ld_dst + col0 + kt * 64 + k8) = w;
        }
        __syncthreads();
    }
}

__device__ void norm_rows(const float* __restrict__ X, const float* __restrict__ g, u16* dst, int ld_dst, int nrows) {
    const int lane = ltid() & 63, gw = blockIdx.x * 8 + (ltid() >> 6), nw = gridDim.x * 8;
    f32x4 gv[4];
#pragma unroll
    for (int i = 0; i < 4; ++i) gv[i] = *(const f32x4*)(g + i * 256 + lane * 4);
    for (int r = gw; r < nrows; r += nw) {
        const float* xr = X + (size_t)r * 1024; f32x4 v[4]; float ss = 0.f;
#pragma unroll
        for (int i = 0; i < 4; ++i) { v[i] = *(const f32x4*)(xr + i * 256 + lane * 4); ss += v[i][0] * v[i][0] + v[i][1] * v[i][1] + v[i][2] * v[i][2] + v[i][3] * v[i][3]; }
        ss = wave_sum(ss); const float rs = rsqrtf(ss * (1.0f / 1024.0f) + 1e-6f);
#pragma unroll
        for (int i = 0; i < 4; ++i) { u32x2 w; w.x = cvt_pk_bf16(v[i][0] * rs * gv[i][0], v[i][1] * rs * gv[i][1]); w.y = cvt_pk_bf16(v[i][2] * rs * gv[i][2], v[i][3] * rs * gv[i][3]);
            *(u32x2*)(dst + (size_t)r * ld_dst + i * 256 + lane * 4) = w; }
    }
}
__device__ void norm_final(float* X, const float* __restrict__ g, int nrows) {
    const int lane = ltid() & 63, gw = blockIdx.x * 8 + (ltid() >> 6), nw = gridDim.x * 8;
    f32x4 gv[4];
#pragma unroll
    for (int i = 0; i < 4; ++i) gv[i] = *(const f32x4*)(g + i * 256 + lane * 4);
    for (int r = gw; r < nrows; r += nw) {
        float* xr = X + (size_t)r * 1024; f32x4 v[4]; float ss = 0.f;
#pragma unroll
        for (int i = 0; i < 4; ++i) { v[i] = *(const f32x4*)(xr + i * 256 + lane * 4); ss += v[i][0] * v[i][0] + v[i][1] * v[i][1] + v[i][2] * v[i][2] + v[i][3] * v[i][3]; }
        ss = wave_sum(ss); const float rs = rsqrtf(ss * (1.0f / 1024.0f) + 1e-6f);
#pragma unroll
        for (int i = 0; i < 4; ++i) *(f32x4*)(xr + i * 256 + lane * 4) = v[i] * rs * gv[i];
    }
}
__device__ void norm_shift(const float* __restrict__ X, const float* __restrict__ g, u16* XNX, int S) {
    const int lane = ltid() & 63, gw = blockIdx.x * 8 + (ltid() >> 6), nw = gridDim.x * 8;
    f32x4 gv[4];
#pragma unroll
    for (int i = 0; i < 4; ++i) gv[i] = *(const f32x4*)(g + i * 256 + lane * 4);
    for (int r = gw; r < TC; r += nw) {
        const int s = r % S; const bool hp = s > 0, hn = s < S - 1;
        const float* xr = X + (size_t)r * 1024; f32x4 vc[4], vp[4], vn[4]; float sc = 0.f, sp = 0.f, sn = 0.f;
#pragma unroll
        for (int i = 0; i < 4; ++i) {
            vc[i] = *(const f32x4*)(xr + i * 256 + lane * 4);
            vp[i] = hp ? *(const f32x4*)(xr - 1024 + i * 256 + lane * 4) : (f32x4){0.f, 0.f, 0.f, 0.f};
            vn[i] = hn ? *(const f32x4*)(xr + 1024 + i * 256 + lane * 4) : (f32x4){0.f, 0.f, 0.f, 0.f};
#pragma unroll
            for (int e = 0; e < 4; ++e) { sc += vc[i][e] * vc[i][e]; sp += vp[i][e] * vp[i][e]; sn += vn[i][e] * vn[i][e]; }
        }
        sc = wave_sum(sc); sp = wave_sum(sp); sn = wave_sum(sn);
        const float rc = rsqrtf(sc * (1.0f / 1024.0f) + 1e-6f), rp = hp ? rsqrtf(sp * (1.0f / 1024.0f) + 1e-6f) : 0.f, rn = hn ? rsqrtf(sn * (1.0f / 1024.0f) + 1e-6f) : 0.f;
#pragma unroll
        for (int i = 0; i < 4; ++i) { float xn[4], xx[4];
#pragma unroll
            for (int e = 0; e < 4; ++e) { xn[e] = vc[i][e] * rc * gv[i][e]; xx[e] = 0.5f * (vp[i][e] * rp + vn[i][e] * rn) * gv[i][e] - xn[e]; }
            u32x2 w; w.x = cvt_pk_bf16(xn[0], xn[1]); w.y = cvt_pk_bf16(xn[2], xn[3]); *(u32x2*)(XNX + (size_t)r * 2048 + i * 256 + lane * 4) = w;
            u32x2 z; z.x = cvt_pk_bf16(xx[0], xx[1]); z.y = cvt_pk_bf16(xx[2], xx[3]); *(u32x2*)(XNX + (size_t)r * 2048 + 1024 + i * 256 + lane * 4) = z; }
    }
}

__device__ __forceinline__ bf16x8 as_bf16x8(u32x4 v) { return __builtin_bit_cast(bf16x8, v); }
__device__ __forceinline__ u32x4 rot8(u32x4 mine, u32x4 partner, int c, const float* __restrict__ rope, float scale) {
    float cs[16];
#pragma unroll
    for (int i = 0; i < 4; ++i) { const f32x4 t = *(const f32x4*)(rope + 4 * i); cs[4 * i] = t[0]; cs[4 * i + 1] = t[1]; cs[4 * i + 2] = t[2]; cs[4 * i + 3] = t[3]; }
    float o[8];
#pragma unroll
    for (int i = 0; i < 4; ++i) {
        const unsigned mw = mine[i], pw = partner[i];
        const float m0 = bflo(mw), m1 = bfhi(mw), p0 = bflo(pw), p1 = bfhi(pw);
        const float c0 = cs[4 * i], s0 = cs[4 * i + 1], c1 = cs[4 * i + 2], s1 = cs[4 * i + 3];
        if (c == 0) { o[2 * i] = (m0 * c0 - p0 * s0) * scale; o[2 * i + 1] = (m1 * c1 - p1 * s1) * scale; }
        else        { o[2 * i] = (m0 * c0 + p0 * s0) * scale; o[2 * i + 1] = (m1 * c1 + p1 * s1) * scale; }
    }
    u32x4 r; r.x = cvt_pk_bf16(o[0], o[1]); r.y = cvt_pk_bf16(o[2], o[3]); r.z = cvt_pk_bf16(o[4], o[5]); r.w = cvt_pk_bf16(o[6], o[7]); return r;
}
__device__ __forceinline__ u32x4 scale8(u32x4 v, float scale) {
    u32x4 r;
#pragma unroll
    for (int i = 0; i < 4; ++i) r[i] = cvt_pk_bf16(bflo(v[i]) * scale, bfhi(v[i]) * scale);
    return r;
}

__device__ void dil_attn_phase(LAS unsigned char* lds, const u16* __restrict__ Z, u16* PART, float* LSE, const float* __restrict__ ROPE, int S) {
    const int tid = ltid(), lane = tid & 63, w = tid >> 6, fr = lane & 15, fq = lane >> 4;
    LAS u16* Ks = (LAS u16*)lds;
    LAS u16* Vt = (LAS u16*)(lds + 272 * 144);
    const int upb = S >> 7, nunits = (TC / S) * 8 * 3 * upb;
    for (int u = blockIdx.x; u < nunits; u += gridDim.x) {
        const int sh = u / (3 * upb), rem = u % (3 * upb), g = rem / upb, idx = rem % upb, seq = sh >> 3, head = sh & 7;
        const int d = 1 << (2 * g), L = S / d, nb2 = upb / d, r = idx / nb2, pair = idx % nb2;
        const int seqbase = seq * S, kl0 = 128 * pair - 64;
        for (int task = tid; task < 272 * 8; task += NTHREADS) {
            const int kl = task >> 3, c = task & 7, lp = kl0 + kl;
            u32x4 kv = {0u, 0u, 0u, 0u}, vv = {0u, 0u, 0u, 0u};
            if (lp >= 0 && lp < L) {
                const int s = lp * d + r; const u16* row = Z + (size_t)(seqbase + s) * 3072 + head * 64;
                kv = *(const u32x4*)(row + 512 + c * 8); vv = *(const u32x4*)(row + 1024 + c * 8);
                if (c < 2) { const u32x4 pk = *(const u32x4*)(row + 512 + (c ^ 1) * 8); kv = rot8(kv, pk, c, ROPE + s * 16, 1.0f); }
            }
            *(LAS u32x4*)(Ks + kl * 72 + c * 8) = kv;
#pragma unroll
            for (int e = 0; e < 4; ++e) { Vt[(c * 8 + 2 * e) * 280 + kl] = (u16)(vv[e] & 0xffffu); Vt[(c * 8 + 2 * e + 1) * 280 + kl] = (u16)(vv[e] >> 16); }
        }
        const int lq = 128 * pair + 16 * w + fr, sq = lq * d + r; const int tokq = seqbase + sq;
        bf16x8 qf[2];
        {
            const u16* row = Z + (size_t)tokq * 3072 + head * 64;
            u32x4 q0 = *(const u32x4*)(row + fq * 8), q1 = *(const u32x4*)(row + 32 + fq * 8);
            if (fq < 2) { const u32x4 pk = *(const u32x4*)(row + (fq ^ 1) * 8); q0 = rot8(q0, pk, fq, ROPE + sq * 16, 0.125f); } else q0 = scale8(q0, 0.125f);
            q1 = scale8(q1, 0.125f);
            qf[0] = as_bf16x8(q0); qf[1] = as_bf16x8(q1);
        }
        __syncthreads();
        f32x4 sacc[10];
#pragma unroll
        for (int kt = 0; kt < 10; ++kt) { sacc[kt] = (f32x4){0.f, 0.f, 0.f, 0.f};
#pragma unroll
            for (int sl = 0; sl < 2; ++sl) { const bf16x8 a = *(const LAS bf16x8*)(Ks + (16 * w + 16 * kt + fr) * 72 + sl * 32 + fq * 8); sacc[kt] = __builtin_amdgcn_mfma_f32_16x16x32_bf16(a, qf[sl], sacc[kt], 0, 0, 0); } }
        float mx = -3.0e38f;
#pragma unroll
        for (int kt = 0; kt < 10; ++kt)
#pragma unroll
            for (int j = 0; j < 4; ++j) { const int diff = 16 * kt + fq * 4 + j - 64 - fr, lp = lq + diff; const bool ok = (diff >= -64) && (diff <= 64) && (lp >= 0) && (lp < L);
                const float sv = ok ? sacc[kt][j] : -1.0e30f; sacc[kt][j] = sv; mx = fmaxf(mx, sv); }
        mx = fmaxf(mx, __shfl_xor(mx, 16)); mx = fmaxf(mx, __shfl_xor(mx, 32));
        float den = 0.f;
#pragma unroll
        for (int kt = 0; kt < 10; ++kt)
#pragma unroll
            for (int j = 0; j < 4; ++j) { const float sv = sacc[kt][j]; const float p = (sv > -1.0e29f) ? __expf(sv - mx) : 0.f; sacc[kt][j] = p; den += p; }
        den += __shfl_xor(den, 16); den += __shfl_xor(den, 32);
        bf16x8 pb[5];
#pragma unroll
        for (int uu = 0; uu < 5; ++uu) { u32x4 t; t.x = cvt_pk_bf16(sacc[2 * uu][0], sacc[2 * uu][1]); t.y = cvt_pk_bf16(sacc[2 * uu][2], sacc[2 * uu][3]);
            t.z = cvt_pk_bf16(sacc[2 * uu + 1][0], sacc[2 * uu + 1][1]); t.w = cvt_pk_bf16(sacc[2 * uu + 1][2], sacc[2 * uu + 1][3]); pb[uu] = as_bf16x8(t); }
        const float inv = 1.0f / den;
        u16* po = PART + ((size_t)g * TC + tokq) * 512 + head * 64 + fq * 4;
#pragma unroll
        for (int mt = 0; mt < 4; ++mt) { f32x4 o = (f32x4){0.f, 0.f, 0.f, 0.f};
#pragma unroll
            for (int uu = 0; uu < 5; ++uu) { const LAS u16* vp = Vt + (mt * 16 + fr) * 280 + 16 * w + 32 * uu + fq * 4;
                const u32x2 lo = *(const LAS u32x2*)vp, hi = *(const LAS u32x2*)(vp + 16); u32x4 t; t.x = lo.x; t.y = lo.y; t.z = hi.x; t.w = hi.y;
                o = __builtin_amdgcn_mfma_f32_16x16x32_bf16(as_bf16x8(t), pb[uu], o, 0, 0, 0); }
            u32x2 wv; wv.x = cvt_pk_bf16(o[0] * inv, o[1] * inv); wv.y = cvt_pk_bf16(o[2] * inv, o[3] * inv); *(u32x2*)(po + mt * 16) = wv; }
        if (fq == 0) LSE[((size_t)g * TC + tokq) * 8 + head] = mx + __logf(den);
        __syncthreads();
    }
}

__device__ void merge_conv_phase(const u16* __restrict__ Z, const u16* __restrict__ PART, const float* __restrict__ LSE, const float* __restrict__ convw, u16* Y, int S) {
    const int lane = ltid() & 63, gw = blockIdx.x * 8 + (ltid() >> 6), nw = gridDim.x * 8;
    float cw[3][8];
#pragma unroll
    for (int j = 0; j < 3; ++j)
#pragma unroll
        for (int e = 0; e < 8; ++e) cw[j][e] = convw[j * 512 + lane * 8 + e];
    for (int t = gw; t < TC; t += nw) {
        const int s = t % S, head = lane >> 3;
        const float l0 = LSE[((size_t)0 * TC + t) * 8 + head], l1 = LSE[((size_t)1 * TC + t) * 8 + head], l2 = LSE[((size_t)2 * TC + t) * 8 + head];
        const float lm = fmaxf(l0, fmaxf(l1, l2)); float w0 = __expf(l0 - lm), w1 = __expf(l1 - lm), w2 = __expf(l2 - lm); const float wi = 1.0f / (w0 + w1 + w2); w0 *= wi; w1 *= wi; w2 *= wi;
        const u32x4 p0 = *(const u32x4*)(PART + ((size_t)0 * TC + t) * 512 + lane * 8), p1 = *(const u32x4*)(PART + ((size_t)1 * TC + t) * 512 + lane * 8), p2 = *(const u32x4*)(PART + ((size_t)2 * TC + t) * 512 + lane * 8);
        u32x4 ya;
#pragma unroll
        for (int i = 0; i < 4; ++i) ya[i] = cvt_pk_bf16(w0 * bflo(p0[i]) + w1 * bflo(p1[i]) + w2 * bflo(p2[i]), w0 * bfhi(p0[i]) + w1 * bfhi(p1[i]) + w2 * bfhi(p2[i]));
        *(u32x4*)(Y + (size_t)t * 1024 + lane * 8) = ya;
        const u16* zr = Z + (size_t)t * 3072;
        const u32x4 bg = *(const u32x4*)(zr + 1536 + lane * 8);
        float acc[8];
#pragma unroll
        for (int e = 0; e < 8; ++e) acc[e] = 0.f;
#pragma unroll
        for (int j = 0; j < 3; ++j) { const int sj = s + j - 1;
            if (sj >= 0 && sj < S) { const u16* zj = zr + (ptrdiff_t)(j - 1) * 3072; const u32x4 cg = *(const u32x4*)(zj + 2048 + lane * 8), hh = *(const u32x4*)(zj + 2560 + lane * 8);
#pragma unroll
                for (int i = 0; i < 4; ++i) { acc[2 * i] += cw[j][2 * i] * (bflo(cg[i]) * bflo(hh[i])); acc[2 * i + 1] += cw[j][2 * i + 1] * (bfhi(cg[i]) * bfhi(hh[i])); } } }
        u32x4 yb;
#pragma unroll
        for (int i = 0; i < 4; ++i) yb[i] = cvt_pk_bf16(bflo(bg[i]) * acc[2 * i], bfhi(bg[i]) * acc[2 * i + 1]);
        *(u32x4*)(Y + (size_t)t * 1024 + 512 + lane * 8) = yb;
    }
}

__device__ void cross_attn_phase(LAS unsigned char* lds, const u16* __restrict__ Q, const u16* __restrict__ KV, int memrow0, u16* O, int S) {
    const int tid = ltid(), lane = tid & 63, w = tid >> 6, fr = lane & 15, fq = lane >> 4;
    LAS u16* Ks = (LAS u16*)lds;
    const int qpb = S >> 7, nunits = (TC / S) * 4 * qpb;
    for (int u = blockIdx.x; u < nunits; u += gridDim.x) {
        const int sh = u / qpb, qt = u % qpb, seq = sh >> 2, head = sh & 3;
        const u16* kvb = KV + (size_t)(memrow0 + seq * 256) * 2048 + head * 256;
        for (int task = tid; task < 256 * 32; task += NTHREADS) { const int key = task >> 5, c = task & 31;
            *(LAS u32x4*)(Ks + key * 264 + c * 8) = *(const u32x4*)(kvb + (size_t)key * 2048 + c * 8); }
        const int tokq = seq * S + qt * 128 + 16 * w + fr;
        bf16x8 qf[8];
        { const u16* row = Q + (size_t)tokq * 1024 + head * 256;
#pragma unroll
          for (int sl = 0; sl < 8; ++sl) qf[sl] = as_bf16x8(scale8(*(const u32x4*)(row + sl * 32 + fq * 8), 0.0625f)); }
        __syncthreads();
        f32x4 sacc[16];
#pragma unroll
        for (int kt = 0; kt < 16; ++kt) { sacc[kt] = (f32x4){0.f, 0.f, 0.f, 0.f};
#pragma unroll
            for (int sl = 0; sl < 8; ++sl) { const bf16x8 a = *(const LAS bf16x8*)(Ks + (16 * kt + fr) * 264 + sl * 32 + fq * 8); sacc[kt] = __builtin_amdgcn_mfma_f32_16x16x32_bf16(a, qf[sl], sacc[kt], 0, 0, 0); } }
        float mx = -3.0e38f;
#pragma unroll
        for (int kt = 0; kt < 16; ++kt)
#pragma unroll
            for (int j = 0; j < 4; ++j) mx = fmaxf(mx, sacc[kt][j]);
        mx = fmaxf(mx, __shfl_xor(mx, 16)); mx = fmaxf(mx, __shfl_xor(mx, 32));
        float den = 0.f;
#pragma unroll
        for (int kt = 0; kt < 16; ++kt)
#pragma unroll
            for (int j = 0; j < 4; ++j) { const float p = __expf(sacc[kt][j] - mx); sacc[kt][j] = p; den += p; }
        den += __shfl_xor(den, 16); den += __shfl_xor(den, 32);
        bf16x8 pb[8];
#pragma unroll
        for (int uu = 0; uu < 8; ++uu) { u32x4 t; t.x = cvt_pk_bf16(sacc[2 * uu][0], sacc[2 * uu][1]); t.y = cvt_pk_bf16(sacc[2 * uu][2], sacc[2 * uu][3]);
            t.z = cvt_pk_bf16(sacc[2 * uu + 1][0], sacc[2 * uu + 1][1]); t.w = cvt_pk_bf16(sacc[2 * uu + 1][2], sacc[2 * uu + 1][3]); pb[uu] = as_bf16x8(t); }
        __syncthreads();
        for (int task = tid; task < 256 * 32; task += NTHREADS) { const int key = task >> 5, c = task & 31;
            const u32x4 vv = *(const u32x4*)(kvb + 1024 + (size_t)key * 2048 + c * 8);
#pragma unroll
            for (int e = 0; e < 4; ++e) { Ks[(c * 8 + 2 * e) * 264 + key] = (u16)(vv[e] & 0xffffu); Ks[(c * 8 + 2 * e + 1) * 264 + key] = (u16)(vv[e] >> 16); } }
        __syncthreads();
        const float inv = 1.0f / den;
        u16* po = O + (size_t)tokq * 1024 + head * 256 + fq * 4;
#pragma unroll
        for (int mt = 0; mt < 16; ++mt) { f32x4 o = (f32x4){0.f, 0.f, 0.f, 0.f};
#pragma unroll
            for (int uu = 0; uu < 8; ++uu) { const LAS u16* vp = Ks + (mt * 16 + fr) * 264 + 32 * uu + fq * 4;
                const u32x2 lo = *(const LAS u32x2*)vp, hi = *(const LAS u32x2*)(vp + 16); u32x4 t; t.x = lo.x; t.y = lo.y; t.z = hi.x; t.w = hi.y;
                o = __builtin_amdgcn_mfma_f32_16x16x32_bf16(as_bf16x8(t), pb[uu], o, 0, 0, 0); }
            u32x2 wv; wv.x = cvt_pk_bf16(o[0] * inv, o[1] * inv); wv.y = cvt_pk_bf16(o[2] * inv, o[3] * inv); *(u32x2*)(po + mt * 16) = wv; }
        __syncthreads();
    }
}
template <int CTRL> __device__ __forceinline__ float dpp_add(float v) { const int t = __builtin_amdgcn_update_dpp(0, __float_as_int(v), CTRL, 0xf, 0xf, false); return v + __int_as_float(t); }
template <int L> __device__ __forceinline__ float row_reduce(float v) {
    v = dpp_add<0xB1>(v); v = dpp_add<0x4E>(v); v = dpp_add<0x141>(v);
    if (L == 16) v = dpp_add<0x140>(v);
    return v;
}
constexpr int TS = 32;
struct ScanRaw { u16 r[4], k[4], v[4], e[4], a[4]; };
template <int R>
__device__ void scan_item(LAS unsigned char* lds, const u16* __restrict__ RKV, const u16* __restrict__ Ed, const u16* __restrict__ Ad, const float* __restrict__ kkw, const float* __restrict__ kaw,
                          float* OD, int S, int seqbase, int head, int dir, int rowbase) {
    constexpr int L = 64 / R, J = R;
    const int tid = ltid(), lane = tid & 63, w = tid >> 6;
    const int rw = lane / L, jg = lane % L, j0 = jg * J, row = rowbase + w * R + rw;
    const float kkc = kkw[head * 64 + lane], kac = kaw[head * 64 + lane];
    float st[J];
#pragma unroll
    for (int j = 0; j < J; ++j) st[j] = 0.f;
    const int nch = S / TS;
    ScanRaw raw;
#define SCAN_LOAD(ch) do { _Pragma("unroll") for (int q = 0; q < 4; ++q) { const int i = (ch) * TS + w * 4 + q; const int t = dir ? (S - 1 - i) : i; const size_t tok = (size_t)(seqbase + t); \
        raw.r[q] = RKV[tok * 3072 + head * 64 + lane]; raw.k[q] = RKV[tok * 3072 + 1024 + head * 64 + lane]; raw.v[q] = RKV[tok * 3072 + 2048 + head * 64 + lane]; \
        raw.e[q] = Ed[tok * 1024 + head * 64 + lane]; raw.a[q] = Ad[tok * 1024 + head * 64 + lane]; } } while (0)
#define SCAN_PREP(buf) do { LAS float* B_ = (LAS float*)(lds + (buf) * 49152); _Pragma("unroll") for (int q = 0; q < 4; ++q) { const int ls = w * 4 + q; \
        const float r_ = bf2f(raw.r[q]), k_ = bf2f(raw.k[q]), v_ = bf2f(raw.v[q]), a_ = bf2f(raw.a[q]); const float e_ = (float)__builtin_bit_cast(_Float16, raw.e[q]); \
        const float kr_ = k_ * kkc; const float ss_ = wave_sum(kr_ * kr_); const float kk_ = kr_ * rsqrtf(fmaxf(ss_, 1e-24f)); \
        B_[(0 * TS + ls) * 64 + lane] = __expf(-e_); B_[(1 * TS + ls) * 64 + lane] = -kk_; B_[(2 * TS + ls) * 64 + lane] = kk_ * a_; \
        B_[(3 * TS + ls) * 64 + lane] = k_ * (1.0f + (a_ - 1.0f) * kac); B_[(4 * TS + ls) * 64 + lane] = r_; B_[(5 * TS + ls) * 64 + lane] = v_; } } while (0)
    SCAN_LOAD(0);
    SCAN_PREP(0);
    __syncthreads();
    for (int ch = 0; ch < nch; ++ch) {
        if (ch + 1 < nch) SCAN_LOAD(ch + 1);
        const LAS float* B = (const LAS float*)(lds + (ch & 1) * 49152);
#pragma unroll 4
        for (int ls = 0; ls < TS; ++ls) {
            float wv[J], av[J], bv[J], kv[J], rv[J];
#pragma unroll
            for (int j4 = 0; j4 < J; j4 += 4) {
                const f32x4 t0 = *(const LAS f32x4*)(B + (0 * TS + ls) * 64 + j0 + j4), t1 = *(const LAS f32x4*)(B + (1 * TS + ls) * 64 + j0 + j4), t2 = *(const LAS f32x4*)(B + (2 * TS + ls) * 64 + j0 + j4),
                            t3 = *(const LAS f32x4*)(B + (3 * TS + ls) * 64 + j0 + j4), t4 = *(const LAS f32x4*)(B + (4 * TS + ls) * 64 + j0 + j4);
#pragma unroll
                for (int e = 0; e < 4; ++e) { wv[j4 + e] = t0[e]; av[j4 + e] = t1[e]; bv[j4 + e] = t2[e]; kv[j4 + e] = t3[e]; rv[j4 + e] = t4[e]; }
            }
            const float vi = B[(5 * TS + ls) * 64 + row];
            float sa = 0.f;
#pragma unroll
            for (int j = 0; j < J; ++j) sa += st[j] * av[j];
            sa = row_reduce<L>(sa);
            float o = 0.f;
#pragma unroll
            for (int j = 0; j < J; ++j) { st[j] = st[j] * wv[j] + (sa * bv[j] + vi * kv[j]); o += st[j] * rv[j]; }
            o = row_reduce<L>(o);
            const int i = ch * TS + ls; const int t = dir ? (S - 1 - i) : i;
            if (jg == 0) OD[((size_t)dir * TC + seqbase + t) * 1024 + head * 64 + row] = o;
        }
        if (ch + 1 < nch) SCAN_PREP((ch + 1) & 1);
        __syncthreads();
    }
#undef SCAN_LOAD
#undef SCAN_PREP
}
__device__ void scan_phase(LAS unsigned char* lds, const u16* RKV, const u16* EAG, const float* kkw, const float* kaw, float* OD, int S) {
    for (int item = blockIdx.x; item < 256; item += gridDim.x) {
        if (S == 4096) { const int id = item >> 1, half = item & 1, seq = id >> 5, rem = id & 31, head = rem >> 1, dir = rem & 1;
            scan_item<4>(lds, RKV, EAG + (size_t)dir * TC * 1024, EAG + (size_t)(2 + dir) * TC * 1024, kkw, kaw, OD, S, seq * S, head, dir, half * 32);
        } else { const int seq = item >> 5, rem = item & 31, head = rem >> 1, dir = rem & 1;
            scan_item<8>(lds, RKV, EAG + (size_t)dir * TC * 1024, EAG + (size_t)(2 + dir) * TC * 1024, kkw, kaw, OD, S, seq * S, head, dir, 0);
        }
        __syncthreads();
    }
}
__device__ void rwkv_post_phase(const float* __restrict__ OD, const u16* __restrict__ RKV, const u16* __restrict__ EAG, const float* __restrict__ kaw, const float* __restrict__ rkw,
                                const float* __restrict__ lnw, const float* __restrict__ lnb, u16* Y) {
    const int lane = ltid() & 63, gw = blockIdx.x * 8 + (ltid() >> 6), nw = gridDim.x * 8;
    for (int t = gw; t < TC; t += nw) {
#pragma unroll 2
        for (int h = 0; h < 16; ++h) { const int c = h * 64 + lane;
            const float y = OD[(size_t)t * 1024 + c] + OD[((size_t)TC + t) * 1024 + c];
            const float mean = wave_sum(y) * (1.0f / 64.0f); const float dv = y - mean; const float var = wave_sum(dv * dv) * (1.0f / 64.0f);
            const float yn = dv * rsqrtf(var + 64e-5f);
            const float r = bf2f(RKV[(size_t)t * 3072 + c]), k = bf2f(RKV[(size_t)t * 3072 + 1024 + c]), v = bf2f(RKV[(size_t)t * 3072 + 2048 + c]);
            const float a0 = bf2f(EAG[((size_t)2 * TC + t) * 1024 + c]), a1 = bf2f(EAG[((size_t)3 * TC + t) * 1024 + c]), g = bf2f(EAG[((size_t)4 * TC + t) * 1024 + c]);
            const float ka = kaw[c], rk = rkw[c];
            const float b0 = wave_sum(r * (k * (1.0f + (a0 - 1.0f) * ka)) * rk), b1 = wave_sum(r * (k * (1.0f + (a1 - 1.0f) * ka)) * rk);
            const float out = (yn * lnw[c] + lnb[c] + (b0 + b1) * v) * g;
            Y[(size_t)t * 1024 + c] = f2bf(out);
        }
    }
}
__device__ void build_w2comb(u16* W2, const float* __restrict__ w2, const float* __restrict__ a2, const float* __restrict__ g2) {
    const size_t total = (size_t)512 * 5120, stride = (size_t)gridDim.x * NTHREADS;
    for (size_t idx = (size_t)blockIdx.x * NTHREADS + ltid(); idx < total; idx += stride) {
        const int k = (int)(idx / 5120), n = (int)(idx % 5120), sel = n >> 10, nn = n & 1023; float v = 0.f;
        if (sel == 0 && k < 64) v = w2[(size_t)k * 1024 + nn];
        else if (sel == 1 && k >= 64 && k < 128) v = w2[(size_t)(64 + (k - 64)) * 1024 + nn];
        else if (sel == 2 && k >= 128 && k < 192) v = a2[(size_t)(k - 128) * 1024 + nn];
        else if (sel == 3 && k >= 192 && k < 256) v = a2[(size_t)(64 + (k - 192)) * 1024 + nn];
        else if (sel == 4 && k >= 256 && k < 384) v = g2[(size_t)(k - 256) * 1024 + nn];
        W2[(size_t)n * 512 + k] = f2bf(v);
    }
}

namespace pg8 {
struct EpiAny {
    static constexpr bool PERM = false, AFTER_DRAIN = false;
    int mode; u16* o16; u16* o16b; float* x; const float* b0; const float* b1; int ldc; int M;
    __device__ __forceinline__ void operator()(const f32x4 (&acc)[2][2][4][2], const Unit& u, int wr, int wc, int fr, int fq) const {
        if (mode == 0) EpiStore16{o16, ldc}(acc, u, wr, wc, fr, fq);
        else if (mode == 1) EpiResid{x}(acc, u, wr, wc, fr, fq);
        else if (mode == 2) EpiSwiglu{o16}(acc, u, wr, wc, fr, fq);
        else if (mode == 3) EpiRwkv{o16, o16b}(acc, u, wr, wc, fr, fq);
        else EpiLora2{o16, b0, b1, M}(acc, u, wr, wc, fr, fq);
    }
};
}

__global__ void __launch_bounds__(NTHREADS, 2) mega(Params p) {
    extern __shared__ __attribute__((aligned(16))) unsigned char lds_raw[];
    LAS unsigned char* lds = (LAS unsigned char*)lds_raw;
    cg::grid_group grid = cg::this_grid();
    unsigned char* const ws = p.ws;
    float* const X = p.out;
    const size_t gtid = (size_t)blockIdx.x * NTHREADS + ltid(), gstride = (size_t)gridDim.x * NTHREADS;

    {
        const size_t n4p = (size_t)32768 * 256, n4 = (size_t)49152 * 256;
        for (size_t i = gtid; i < n4; i += gstride) ((f32x4*)X)[i] = i < n4p ? ((const f32x4*)p.in[0])[i] : ((const f32x4*)p.in[1])[i - n4p];
        float* const ROPE = (float*)(ws + WS_ROPE);
        for (size_t i = gtid; i < 4096 * 8; i += gstride) { const int pos = (int)(i >> 3), fi = (int)(i & 7);
            const float inv = powf(500000.0f, -2.0f * (float)fi / 16.0f); const float ang = (float)pos * inv;
            ROPE[i * 2] = (float)cos((double)ang); ROPE[i * 2 + 1] = (float)sin((double)ang); }
    }
    for (int ph = 0; ph < 4 * NCHUNK * 15; ++ph) {
        const int l = ph / (NCHUNK * 15), c = (ph / 15) % NCHUNK, s = ph % 15;
        const int e = l >> 1; const bool odd = (l & 1) != 0;
        if (s < 2 && c != 0) continue;
        if (s == 6 && !odd) continue;
        const int S = c < 2 ? 4096 : 2048;
        float* const Xc = X + (size_t)c * TC * 1024;
        unsigned char* const AR = ws + WS_ARENA;
        u16* const XN = (u16*)(AR + AR_A); u16* const BUFB = (u16*)(AR + AR_B); u16* const BUFC = (u16*)(AR + AR_C); u16* const Y = (u16*)(AR + AR_D);
        bool do_gemm = false; const u16* gA = nullptr; const u16* gB = nullptr; int gM = TC, gN = 1024, gK = 1024;
        pg8::EpiAny E{0, nullptr, nullptr, nullptr, nullptr, nullptr, 0, TC};
        if (s == 0) {
            const float* mu = p.in[12] + (size_t)e * 6 * 1024;
            u16* const WMIX = (u16*)(ws + WS_WMIX);
            for (int j = 0; j < 22; ++j) {
                const float* src = nullptr; int ld_src = 1024, K = 1024, N = 1024, ld_dst = 1024, col0 = 0, mode = 0; u16* dst = nullptr; const float* s1 = nullptr;
                if (j < 17) {
                    if (!odd) {
                        if (j == 0) { src = p.in[9] + (size_t)e * 1024 * 3072; ld_src = 3072; N = 3072; dst = WMIX; }
                        else if (j == 1) { src = p.in[10] + (size_t)e * 1024 * 1024; dst = WMIX + (size_t)3072 * 1024; }
                        else continue;
                    } else {
                        const int half = j & 1, q = j >> 1;
                        ld_dst = 2048; col0 = half * 1024;
                        if (q < 3) { src = p.in[13 + q] + (size_t)e * 1024 * 1024; dst = WMIX + (size_t)q * 1024 * 2048; if (half) s1 = mu + (q == 0 ? 0 : q + 1) * 1024; }
                        else if (q < 5) { const int d = q - 3; src = p.in[18] + ((size_t)e * 2 + d) * 1024 * 64; ld_src = 64; N = 64; dst = WMIX + (size_t)(3072 + d * 64) * 2048; if (half) s1 = mu + 1 * 1024; }
                        else if (q < 7) { const int d = q - 5; src = p.in[21] + ((size_t)e * 2 + d) * 1024 * 64; ld_src = 64; N = 64; dst = WMIX + (size_t)(3200 + d * 64) * 2048; if (half) s1 = mu + 4 * 1024; }
                        else if (q == 7) { src = p.in[23] + (size_t)e * 1024 * 128; ld_src = 128; N = 128; dst = WMIX + (size_t)3328 * 2048; if (half) s1 = mu + 5 * 1024; }
                        else { if (half) continue; src = p.in[16] + (size_t)e * 1024 * 1024; dst = (u16*)(ws + WS_WMIX + WMIX_C); ld_dst = 1024; col0 = 0; }
                    }
                } else if (j == 17) { src = p.in[30] + (size_t)l * 1024 * 1024; dst = (u16*)(ws + WS_WQ); }
                else if (j == 18) { src = p.in[31] + (size_t)l * 1024 * 2048; ld_src = 2048; N = 2048; dst = (u16*)(ws + WS_WKV); }
                else if (j == 19) { src = p.in[32] + (size_t)l * 1024 * 1024; dst = (u16*)(ws + WS_WO); }
                else if (j == 20) { src = p.in[33] + (size_t)l * 1024 * 5632; ld_src = 5632; N = 5632; dst = (u16*)(ws + WS_WGU); mode = 1; }
                else { src = p.in[34] + (size_t)l * 2816 * 1024; K = 2816; dst = (u16*)(ws + WS_WDN); ld_dst = 2816; }
                tr_job(lds, src, ld_src, K, N, dst, ld_dst, col0, s1, mode, j * 37);
            }
            if (odd) {
                for (size_t i = gtid; i < (size_t)128 * 2048 / 8; i += gstride) ((u32x4*)(WMIX + (size_t)3456 * 2048))[i] = (u32x4){0u, 0u, 0u, 0u};
                build_w2comb((u16*)(ws + WS_WMIX + WMIX_B), p.in[19] + (size_t)e * 2 * 64 * 1024, p.in[22] + (size_t)e * 2 * 64 * 1024, p.in[24] + (size_t)e * 128 * 1024);
            }
        }
        if (s == 0 || s == 2 || s == 8 || s == 12) {
            if (s == 2 && odd) norm_shift(Xc, p.in[4] + l * 1024, XN, S);
            else {
                for (int rep = 0; rep < (s == 0 ? 2 : 1); ++rep) {
                    const float* src = s == 0 ? p.in[2 + rep] : Xc; const float* g = p.in[s == 0 ? 6 : (s == 2 ? 4 : (s == 8 ? 5 : 7))] + l * 1024;
                    u16* dst = s == 0 ? (u16*)(ws + WS_MN) + (size_t)rep * 2048 * 1024 : XN;
                    norm_rows(src, g, dst, 1024, s == 0 ? 2048 : TC);
                }
            }
        }
        else if (s == 1) { do_gemm = true; gA = (u16*)(ws + WS_MN); gB = (u16*)(ws + WS_WKV); gM = 4096; gN = 2048; E.o16 = (u16*)(ws + WS_KV); E.ldc = 2048; }
        else if (s == 3) { do_gemm = true; gA = XN; gB = (u16*)(ws + WS_WMIX);
            if (!odd) { gN = 3072; E.o16 = BUFB; E.ldc = 3072; } else { gN = 3584; gK = 2048; E.mode = 3; E.o16 = BUFB; E.o16b = (u16*)(AR + AR_A + (size_t)TC * 4096); } }
        else if (s == 4) {
            if (!odd) dil_attn_phase(lds, BUFB, BUFC, (float*)(AR + AR_C + (size_t)3 * TC * 512 * 2), (const float*)(ws + WS_ROPE), S);
            else { do_gemm = true; gA = (u16*)(AR + AR_A + (size_t)TC * 4096); gB = (u16*)(ws + WS_WMIX + WMIX_B); gN = 5120; gK = 512; E.mode = 4; E.o16 = BUFC; E.b0 = p.in[17] + (size_t)e * 2048; E.b1 = p.in[20] + (size_t)e * 2048; }
        }
        else if (s == 5) {
            if (!odd) merge_conv_phase(BUFB, BUFC, (const float*)(AR + AR_C + (size_t)3 * TC * 512 * 2), p.in[11] + (size_t)e * 3 * 512, Y, S);
            else scan_phase(lds, BUFB, BUFC, p.in[25] + (size_t)e * 1024, p.in[26] + (size_t)e * 1024, (float*)(AR + AR_A), S);
        }
        else if (s == 6) rwkv_post_phase((const float*)(AR + AR_A), BUFB, BUFC, p.in[26] + (size_t)e * 1024, p.in[27] + (size_t)e * 1024, p.in[28] + (size_t)e * 1024, p.in[29] + (size_t)e * 1024, Y);
        else if (s == 7) { do_gemm = true; gA = Y; gB = odd ? (u16*)(ws + WS_WMIX + WMIX_C) : (u16*)(ws + WS_WMIX) + (size_t)3072 * 1024; E.mode = 1; E.x = Xc; }
        else if (s == 9) { do_gemm = true; gA = XN; gB = (u16*)(ws + WS_WQ); E.o16 = BUFB; E.ldc = 1024; }
        else if (s == 10) cross_attn_phase(lds, BUFB, (const u16*)(ws + WS_KV), c < 2 ? c * 1024 : 2048, BUFC, S);
        else if (s == 11) { do_gemm = true; gA = BUFC; gB = (u16*)(ws + WS_WO); E.mode = 1; E.x = Xc; }
        else if (s == 13) { do_gemm = true; gA = XN; gB = (u16*)(ws + WS_WGU); gN = 5632; E.mode = 2; E.o16 = BUFB; }
        else if (s == 14) { do_gemm = true; gA = BUFB; gB = (u16*)(ws + WS_WDN); gK = 2816; E.mode = 1; E.x = Xc; }
        if (do_gemm) {
            pg8::Gemm g{gA, gB, gM, gN, gK}; pg8::StaticOrder SO; SO.init(gM, gN, (int)gridDim.x, (int)blockIdx.x);
            pg8::gemm_phase<pg8::EpiAny, pg8::StaticOrder, false>(lds, g, SO, E, nullptr);
        }
        grid.sync();
    }
    norm_final(X, p.in[8], 49152);
}

extern "C" void kernel_launch(void* const* d_in, const int* in_sizes, int n_in, void* d_out, int out_size, void* d_ws, size_t ws_size, hipStream_t stream) {
    static int grid_blocks = 0;
    if (!grid_blocks) {
        int dev = 0, cus = 0, per_cu = 0;
        if (n_in != 35 || out_size != 49152 * 1024 || ws_size < WS_END) { fprintf(stderr, "kernel_launch: unexpected problem (n_in %d out %d ws %zu need %zu)\n", n_in, out_size, ws_size, (size_t)WS_END); grid_blocks = -1; return; }
        (void)hipGetDevice(&dev);
        (void)hipDeviceGetAttribute(&cus, hipDeviceAttributeMultiprocessorCount, dev);
        (void)hipFuncSetAttribute((const void*)mega, hipFuncAttributeMaxDynamicSharedMemorySize, LDS_BYTES);
        (void)hipOccupancyMaxActiveBlocksPerMultiprocessor(&per_cu, (const void*)mega, NTHREADS, LDS_BYTES);
        if (per_cu < 1) { fprintf(stderr, "kernel_launch: occupancy query says %d blocks per CU\n", per_cu); }
        grid_blocks = cus > 0 ? cus : 256;
    }
    if (grid_blocks < 0) return;
    Params p{};
    for (int i = 0; i < 35; ++i) p.in[i] = (const float*)d_in[i];
    p.out = (float*)d_out; p.ws = (unsigned char*)d_ws;
    void* args[] = {&p};
    hipError_t err = hipLaunchCooperativeKernel((void*)mega, dim3(grid_blocks), dim3(NTHREADS), args, LDS_BYTES, stream);
    if (err != hipSuccess) fprintf(stderr, "cooperative launch failed: %s (grid %d)\n", hipGetErrorString(err), grid_blocks);
}
```

```cpp
#include <hip/hip_runtime.h>
#include <hip/hip_cooperative_groups.h>
#include <cstdio>
namespace cg = cooperative_groups;

#define LAS __attribute__((address_space(3)))
typedef unsigned short u16;
typedef short bf16x8 __attribute__((ext_vector_type(8)));
typedef float f32x4 __attribute__((ext_vector_type(4)));
typedef float f32x2 __attribute__((ext_vector_type(2)));
typedef unsigned u32x4 __attribute__((ext_vector_type(4)));
typedef unsigned u32x2 __attribute__((ext_vector_type(2)));

constexpr int DM = 1024;
constexpr int TC = 16384;
constexpr int NCHUNK = 3;
constexpr int NTHREADS = 512;
constexpr int LDS_BYTES = 139264;

__device__ __forceinline__ unsigned cvt_pk_bf16(float lo, float hi) { unsigned r; asm volatile("v_cvt_pk_bf16_f32 %0, %1, %2" : "=v"(r) : "v"(lo), "v"(hi)); return r; }
__device__ __forceinline__ u16 f2bf(float x) { return (u16)(cvt_pk_bf16(x, 0.f) & 0xffffu); }
__device__ __forceinline__ float bf2f(u16 b) { return __uint_as_float(((unsigned)b) << 16); }
__device__ __forceinline__ float bflo(unsigned w) { return __uint_as_float(w << 16); }
__device__ __forceinline__ float bfhi(unsigned w) { return __uint_as_float(w & 0xffff0000u); }
__device__ __forceinline__ float sigmoidf_(float x) { return 1.0f / (1.0f + __expf(-x)); }
__device__ __forceinline__ float wave_sum(float v) {
#pragma unroll
    for (int o = 32; o >= 1; o >>= 1) v += __shfl_xor(v, o);
    return v;
}
constexpr int WVMAP_OFF = LDS_BYTES - 16 - 256;
__device__ __forceinline__ unsigned hw_slot() { return (unsigned)__builtin_amdgcn_s_getreg((5 << 11) | 4) & 63u; }
__device__ __forceinline__ int ltid() {
    extern __shared__ __attribute__((aligned(16))) unsigned char lds_dyn_[];
    const int wv = __builtin_amdgcn_readfirstlane(*(const volatile LAS int*)((LAS unsigned char*)lds_dyn_ + WVMAP_OFF + hw_slot() * 4));
    int lane; asm volatile("v_mbcnt_lo_u32_b32 %0, -1, 0\n\tv_mbcnt_hi_u32_b32 %0, -1, %0" : "=v"(lane));
    return (wv << 6) | lane;
}
__device__ __forceinline__ void ltid_setup() {
    extern __shared__ __attribute__((aligned(16))) unsigned char lds_dyn_[];
    if ((threadIdx.x & 63) == 0) *(volatile LAS int*)((LAS unsigned char*)lds_dyn_ + WVMAP_OFF + hw_slot() * 4) = (int)(threadIdx.x >> 6);
    __syncthreads();
}
#define XB_TMO      128
#define XB_XCNT(j)  (256  + 64 * (j))
#define XB_XSUB(j)  (1280 + 64 * (j))
#define XB_XGEN(j)  (2304 + 64 * (j))
#define XB_TOP      3328
#define XB_TOPGEN   3392
#define XCD_BAR_WORDS 3456
#define XB_SPIN_CAP (1u << 18)

__device__ __forceinline__ unsigned xb_ld(unsigned* p)              { return __hip_atomic_load(p, __ATOMIC_RELAXED, __HIP_MEMORY_SCOPE_AGENT); }
__device__ __forceinline__ unsigned xb_add(unsigned* p, unsigned v) { return __hip_atomic_fetch_add(p, v, __ATOMIC_RELAXED, __HIP_MEMORY_SCOPE_AGENT); }
__device__ __forceinline__ unsigned xb_xcc_id() { return (unsigned)__builtin_amdgcn_s_getreg((3 << 11) | 20) & 0xFu; }
#define XB_SPIN(cond, bar) do { unsigned _sp = 0; while (cond) { __builtin_amdgcn_s_sleep(1); \
    if ((++_sp & 255u) == 0u) { if (xb_ld(&(bar)[XB_TMO])) break; if (_sp > XB_SPIN_CAP) { atomicAdd(&(bar)[XB_TMO], 1u); break; } } } } while (0)

struct XcdBarrier {
    unsigned* bar; unsigned x;
    volatile LAS unsigned* st;
};

__device__ __forceinline__ XcdBarrier xcd_barrier_post(unsigned* bar, volatile LAS unsigned* st) {
    XcdBarrier b; b.bar = bar; b.x = xb_xcc_id(); b.st = st;
    if (ltid() == 0) (void)xb_add(&bar[XB_XCNT(b.x)], 1u);
    return b;
}
__device__ __forceinline__ void xcd_barrier_complete(unsigned* bar, unsigned x, unsigned& nloc, unsigned& nx) {
    const unsigned G = gridDim.x * gridDim.y * gridDim.z;
    unsigned sum, cnt, mine, sp = 0u;
    for (;;) {
        sum = 0u; cnt = 0u; mine = 0u;
#pragma unroll
        for (unsigned j = 0; j < 16; ++j) { const unsigned c = xb_ld(&bar[XB_XCNT(j)]); sum += c; cnt += (c > 0u) ? 1u : 0u; mine = (j == x) ? c : mine; }
        if (sum == G) break;
        __builtin_amdgcn_s_sleep(1);
        if ((++sp & 255u) == 0u) { if (xb_ld(&bar[XB_TMO])) break; if (sp > XB_SPIN_CAP) { atomicAdd(&bar[XB_TMO], 1u); break; } }
    }
    nloc = mine > 0u ? mine : 1u; nx = cnt > 0u ? cnt : 1u;
}

__device__ __forceinline__ void xcd_barrier(const XcdBarrier& b) {
    asm volatile("s_waitcnt vmcnt(0)" ::: "memory");
    __syncthreads();
    if (ltid() == 0) {
        unsigned* bar = b.bar;
        __builtin_amdgcn_s_waitcnt(0);
        unsigned nloc = b.st[0], nx = b.st[1];
        if (nloc == 0u) { xcd_barrier_complete(bar, b.x, nloc, nx); b.st[0] = nloc; b.st[1] = nx; }
        const unsigned old = xb_add(&bar[XB_XSUB(b.x)], 1u);
        const unsigned gen = old / nloc;
        if (old + 1u == (gen + 1u) * nloc) {
            __builtin_amdgcn_fence(__ATOMIC_RELEASE, "agent");
            asm volatile("s_waitcnt vmcnt(0)" ::: "memory");
            const unsigned og = xb_add(&bar[XB_TOP], 1u);
            const unsigned tg = og / nx;
            if (og + 1u == (tg + 1u) * nx) xb_add(&bar[XB_TOPGEN], 1u);
            else XB_SPIN(xb_ld(&bar[XB_TOPGEN]) == tg, bar);
            __builtin_amdgcn_fence(__ATOMIC_ACQUIRE, "agent");
            xb_add(&bar[XB_XGEN(b.x)], 1u);
            asm volatile("s_waitcnt vmcnt(0)" ::: "memory");
        } else {
            XB_SPIN(xb_ld(&bar[XB_XGEN(b.x)]) == gen, bar);
            __builtin_amdgcn_fence(__ATOMIC_ACQUIRE, "agent");
            asm volatile("s_waitcnt vmcnt(0)" ::: "memory");
        }
    }
    __syncthreads();
}
namespace pg8 {
#define PG8_LAS __attribute__((address_space(3)))
typedef unsigned short bf16_t;
typedef short bf16x8 __attribute__((ext_vector_type(8)));
typedef float f32x4 __attribute__((ext_vector_type(4)));
typedef unsigned u32x4 __attribute__((ext_vector_type(4)));
constexpr int BM = 256, BK = 64, HALF = 128, HTB = HALF * BK * 2  , STAGE_BYTES = 8 * HTB, NXCD = 8, WGM = 8;

__host__ __device__ __forceinline__ int lds_byte(int r, int c) { const int st = (r >> 4) * 2 + (c >> 5), rr = r & 15, cc = c & 31, ob = rr * 64 + cc * 2; return st * 1024 + (ob ^ (((ob >> 9) & 1) << 5)); }
__host__ __device__ __forceinline__ void stage_rc(int b, int& R, int& C) { const int st = b / 1024, sb = b % 1024, swz = sb ^ (((sb >> 9) & 1) << 5); R = (st >> 1) * 16 + swz / 64; C = (st & 1) * 32 + (swz % 64) / 2; }
__host__ __device__ __forceinline__ int perm32(int rho) { const int n = rho >> 4, i = rho & 15; return 8 * (i >> 2) + 4 * n + (i & 3); }

struct Unit { int pm, pn; };
struct Gemm { const bf16_t* A; const bf16_t* Bt; int M, N, K; size_t a_grp_bytes; int a_grp_shift; };

struct StaticOrder {
    int nM, nN, nwg, G, c;
    __host__ __device__ __forceinline__ void init(int M, int N, int G_, int c_) { nM = M / BM; nN = N / BM; nwg = nM * nN; G = G_; c = c_; }
    __host__ __device__ __forceinline__ bool next(int i, Unit& u) const {
        const long L = (long)i * G + c; if (L >= nwg) return false;
        int wgid = (int)L; { const int q = nwg / NXCD, r = nwg % NXCD, xcd = wgid % NXCD, off = wgid / NXCD; wgid = (xcd < r ? xcd * (q + 1) : r * (q + 1) + (xcd - r) * q) + off; }
        const int nig = WGM * nN, gid = wgid / nig, fm = gid * WGM, gsz = (nM - fm) < WGM ? (nM - fm) : WGM;
        u.pm = fm + ((wgid % nig) % gsz); u.pn = (wgid % nig) / gsz; return true;
    }
    __device__ __forceinline__ void a_ready(const Unit&) const {}
    __device__ __forceinline__ void done(const Unit&) const {}
};
struct EpiStore16 {
    static constexpr bool PERM = true, AFTER_DRAIN = false;
    u16* O; int ldc; const unsigned long long* SS;
    __device__ __forceinline__ void operator()(const f32x4 (&acc)[2][2][4][2], const Unit& u, int wr, int wc, int fr, int fq) const {
        const int row0 = u.pm * BM + wr * 64 + fr, col0 = u.pn * BM + wc * 32 + 8 * fq;
#pragma unroll
        for (int ai = 0; ai < 2; ++ai)
#pragma unroll
            for (int m = 0; m < 4; ++m) { const int row = row0 + ai * HALF + m * 16; u16* rowp = O + (size_t)row * ldc + col0;
                const float rs = SS ? rsqrtf((float)SS[row] * (1.0f / (1024.0f * 1048576.0f)) + 1e-6f) : 1.0f;
#pragma unroll
                for (int bj = 0; bj < 2; ++bj) { const f32x4 v0 = acc[ai][bj][m][0] * rs, v1 = acc[ai][bj][m][1] * rs; u32x4 w; w.x = cvt_pk_bf16(v0[0], v0[1]); w.y = cvt_pk_bf16(v0[2], v0[3]); w.z = cvt_pk_bf16(v1[0], v1[1]); w.w = cvt_pk_bf16(v1[2], v1[3]);
                    *(u32x4*)(rowp + bj * HALF) = w; } }
    }
};
struct EpiResid {
    static constexpr bool PERM = true, AFTER_DRAIN = false;
    float* X; const float* Xin; u16* XB; unsigned long long* SS;
    __device__ __forceinline__ void operator()(const f32x4 (&acc)[2][2][4][2], const Unit& u, int wr, int wc, int fr, int fq) const {
        const int row0 = u.pm * BM + wr * 64 + fr, col0 = u.pn * BM + wc * 32 + 8 * fq;
#pragma unroll
        for (int ai = 0; ai < 2; ++ai)
#pragma unroll
            for (int m = 0; m < 4; ++m) { const int row = row0 + ai * HALF + m * 16; const unsigned off = (unsigned)(row * 1024 + col0) * 4u; float ss = 0.f;
#pragma unroll
                for (int bj = 0; bj < 2; ++bj) { const unsigned o = off + bj * HALF * 4u; u32x4 w;
                    { const f32x4 v = *(const f32x4*)((const char*)Xin + o) + acc[ai][bj][m][0]; *(f32x4*)((char*)X + o) = v; if (XB) { w.x = cvt_pk_bf16(v[0], v[1]); w.y = cvt_pk_bf16(v[2], v[3]); ss += v[0] * v[0] + v[1] * v[1] + v[2] * v[2] + v[3] * v[3]; } }
                    { const f32x4 v = *(const f32x4*)((const char*)Xin + o + 16u) + acc[ai][bj][m][1]; *(f32x4*)((char*)X + o + 16u) = v; if (XB) { w.z = cvt_pk_bf16(v[0], v[1]); w.w = cvt_pk_bf16(v[2], v[3]); ss += v[0] * v[0] + v[1] * v[1] + v[2] * v[2] + v[3] * v[3]; } }
                    if (XB) *(u32x4*)((char*)XB + (o >> 1)) = w; }
                if (XB) { ss += __shfl_xor(ss, 16); ss += __shfl_xor(ss, 32); if (fq == 0) atomicAdd(SS + row, (unsigned long long)(ss * 1048576.0f)); } }
    }
};
struct EpiSwiglu {
    static constexpr bool PERM = true, AFTER_DRAIN = false;
    u16* H; const unsigned long long* SS;
    __device__ __forceinline__ void operator()(const f32x4 (&acc)[2][2][4][2], const Unit& u, int wr, int wc, int fr, int fq) const {
        const int row0 = u.pm * BM + wr * 64 + fr, col0 = u.pn * 128 + wc * 16 + 4 * fq;
#pragma unroll
        for (int ai = 0; ai < 2; ++ai)
#pragma unroll
            for (int m = 0; m < 4; ++m) { const int row = row0 + ai * HALF + m * 16; u16* rowp = H + (size_t)row * 2816 + col0;
                const float rs = rsqrtf((float)SS[row] * (1.0f / (1024.0f * 1048576.0f)) + 1e-6f);
#pragma unroll
                for (int bj = 0; bj < 2; ++bj) { const f32x4 g = acc[ai][bj][m][0] * rs, up = acc[ai][bj][m][1] * rs; float h[4];
#pragma unroll
                    for (int j = 0; j < 4; ++j) h[j] = g[j] / (1.0f + __expf(-g[j])) * up[j];
                    u32x2 w; w.x = cvt_pk_bf16(h[0], h[1]); w.y = cvt_pk_bf16(h[2], h[3]); *(u32x2*)(rowp + bj * 64) = w; } }
    }
};
struct EpiRwkv {
    static constexpr bool PERM = true, AFTER_DRAIN = false;
    u16* L1;
    __device__ __forceinline__ void operator()(const f32x4 (&acc)[2][2][4][2], const Unit& u, int wr, int wc, int fr, int fq) const {
        const int row0 = u.pm * BM + wr * 64 + fr;
        const int col0 = u.pn * BM + wc * 32 + 8 * fq; const int t = u.pn;
#pragma unroll
        for (int ai = 0; ai < 2; ++ai)
#pragma unroll
            for (int m = 0; m < 4; ++m) { u16* rowp = L1 + (size_t)(row0 + ai * HALF + m * 16) * 384 + col0;
#pragma unroll
                for (int bj = 0; bj < 2; ++bj) if (!(t == 1 && bj == 1)) {
#pragma unroll
                    for (int n = 0; n < 2; ++n) { f32x4 v = acc[ai][bj][m][n];
#pragma unroll
                        for (int j = 0; j < 4; ++j) { float x = v[j]; if (t == 1) x = sigmoidf_(x); else if (bj == 0) x = tanhf(x); v[j] = x; }
                        u32x2 w; w.x = cvt_pk_bf16(v[0], v[1]); w.y = cvt_pk_bf16(v[2], v[3]); *(u32x2*)(rowp + bj * HALF + n * 4) = w; } } }
    }
};
struct EpiLora2 {
    static constexpr bool PERM = true, AFTER_DRAIN = false;
    u16* EAG; const float* w0; const float* a0; int M;
    __device__ __forceinline__ void operator()(const f32x4 (&acc)[2][2][4][2], const Unit& u, int wr, int wc, int fr, int fq) const {
        const int row0 = u.pm * BM + wr * 64 + fr; const int sel = u.pn >> 2; const int col0 = (u.pn & 3) * BM + wc * 32 + 8 * fq;
        u16* base = EAG + (size_t)sel * M * 1024;
        const float* bias = sel < 2 ? (w0 + sel * 1024) : (a0 + ((sel - 2) & 1) * 1024);
        f32x4 bv[2][2];
#pragma unroll
        for (int bj = 0; bj < 2; ++bj)
#pragma unroll
            for (int n = 0; n < 2; ++n) bv[bj][n] = (sel < 4) ? *(const f32x4*)(bias + col0 + bj * HALF + n * 4) : (f32x4){0.f, 0.f, 0.f, 0.f};
#pragma unroll
        for (int ai = 0; ai < 2; ++ai)
#pragma unroll
            for (int m = 0; m < 4; ++m) { u16* rowp = base + (size_t)(row0 + ai * HALF + m * 16) * 1024 + col0;
#pragma unroll
                for (int bj = 0; bj < 2; ++bj)
#pragma unroll
                    for (int n = 0; n < 2; ++n) { const f32x4 v = acc[ai][bj][m][n] + bv[bj][n]; u32x2 w;
                        if (sel < 2) { _Float16 h[4];
#pragma unroll
                            for (int j = 0; j < 4; ++j) h[j] = (_Float16)(0.60653066f * sigmoidf_(v[j]));
                            w.x = (unsigned)__builtin_bit_cast(u16, h[0]) | ((unsigned)__builtin_bit_cast(u16, h[1]) << 16);
                            w.y = (unsigned)__builtin_bit_cast(u16, h[2]) | ((unsigned)__builtin_bit_cast(u16, h[3]) << 16);
                        } else if (sel < 4) { w.x = cvt_pk_bf16(sigmoidf_(v[0]), sigmoidf_(v[1])); w.y = cvt_pk_bf16(sigmoidf_(v[2]), sigmoidf_(v[3]));
                        } else { w.x = cvt_pk_bf16(v[0], v[1]); w.y = cvt_pk_bf16(v[2], v[3]); }
                        *(u32x2*)(rowp + bj * HALF + n * 4) = w; } }
    }
};
template <class Epi, class Sched, bool STAMP = false>
__device__ __forceinline__ void gemm_phase(PG8_LAS unsigned char* lds, const Gemm g, const Sched& S, const Epi& E, unsigned long long* stamps) {
    const int tid = ltid(), wid = __builtin_amdgcn_readfirstlane(tid >> 6), lane = tid & 63, wr = wid >> 2, wc = wid & 3, fr = lane & 15, fq = lane >> 4;
    const int K = g.K, nt = K / BK;
    int ts_lo = 0, ts_hi = 0, nts = 0; const unsigned long long rt_entry = STAMP ? (unsigned long long)wall_clock64() : 0ull;
#define PG8_STAMP() do { if (STAMP && wid == 0 && nts < 64) { const unsigned long long _c = (unsigned long long)clock64(); \
        ts_lo = (lane == nts) ? (int)(unsigned)_c : ts_lo; ts_hi = (lane == nts) ? (int)(unsigned)(_c >> 32) : ts_hi; ++nts; } } while (0)
    PG8_STAMP();
    unsigned voffA[2], voffB[2];
#pragma unroll
    for (int i = 0; i < 2; ++i) { int R, C; stage_rc(tid * 16 + i * 8192, R, C); const int Rb = Epi::PERM ? ((R & ~31) + perm32(R & 31)) : R;
        voffA[i] = (unsigned)(R * K + C) * 2u; voffB[i] = (unsigned)(Rb * K + C) * 2u; }
    const size_t kstep = (size_t)(BK * 2);
    const size_t hstep = (size_t)HALF * K * 2;
    const size_t tstep = 2 * hstep;
    const unsigned ldsw = (unsigned)wid * 1024u;
    const int aoff = lds_byte(wr * 64 + fr, fq * 8), boff = lds_byte(wc * 32 + fr, fq * 8);
#define PG8_SA(b, h) (((b) * 2 + (h)) * HTB)
#define PG8_SB(b, h) ((4 + (b) * 2 + (h)) * HTB)
#define PG8_STAGE(bufoff, gbase, voff) do { _Pragma("unroll") for (int _i = 0; _i < 2; ++_i) \
        __builtin_amdgcn_global_load_lds((const unsigned*)((const char*)(gbase) + (voff)[_i]), (PG8_LAS unsigned*)(lds + (bufoff) + ldsw + _i * 8192), 16, 0, 0); } while (0)
#define PG8_LDA(dst, b, h) do { _Pragma("unroll") for (int m = 0; m < 4; ++m) _Pragma("unroll") for (int k = 0; k < 2; ++k) dst[m][k] = *(const PG8_LAS bf16x8*)(lds + PG8_SA(b, h) + aoff + m * 2048 + k * 1024); } while (0)
#define PG8_LDB(dst, b, h) do { _Pragma("unroll") for (int n = 0; n < 2; ++n) _Pragma("unroll") for (int k = 0; k < 2; ++k) dst[n][k] = *(const PG8_LAS bf16x8*)(lds + PG8_SB(b, h) + boff + n * 2048 + k * 1024); } while (0)
#define PG8_MMA(ai, bj, At, Bt) do { __builtin_amdgcn_s_setprio(1); _Pragma("unroll") for (int m = 0; m < 4; ++m) _Pragma("unroll") for (int n = 0; n < 2; ++n) _Pragma("unroll") for (int k = 0; k < 2; ++k) \
        acc[ai][bj][m][n] = __builtin_amdgcn_mfma_f32_16x16x32_bf16(Bt[n][k], At[m][k], acc[ai][bj][m][n], 0, 0, 0); __builtin_amdgcn_s_setprio(0); } while (0)
#define PG8_WAIT_V(n) asm volatile("s_waitcnt vmcnt(" #n ")" ::: "memory")
#define PG8_WAIT_L(n) asm volatile("s_waitcnt lgkmcnt(" #n ")" ::: "memory")
#define PG8_BAR __builtin_amdgcn_s_barrier()
#define PG8_SCHED __builtin_amdgcn_sched_barrier(0)
    Unit cur, nxt; int ui = 0;
    if (!S.next(0, cur)) return;
    f32x4 acc[2][2][4][2];
#pragma unroll
    for (int a = 0; a < 2; ++a)
#pragma unroll
        for (int b = 0; b < 2; ++b)
#pragma unroll
            for (int m = 0; m < 4; ++m)
#pragma unroll
                for (int n = 0; n < 2; ++n) acc[a][b][m][n] = (f32x4){0.f, 0.f, 0.f, 0.f};
    bf16x8 At[4][2], B0[2][2], B1[2][2];
    const char* cA = (const char*)g.A + (size_t)cur.pm * tstep + (size_t)(cur.pn >> g.a_grp_shift) * g.a_grp_bytes; const char* cB = (const char*)g.Bt + (size_t)cur.pn * tstep;
    S.a_ready(cur);
    PG8_STAGE(PG8_SB(0, 0), cB, voffB); PG8_STAGE(PG8_SA(0, 0), cA, voffA); PG8_STAGE(PG8_SB(0, 1), cB + hstep, voffB); PG8_STAGE(PG8_SA(0, 1), cA + hstep, voffA);
    if (wr == 1) PG8_BAR;
    PG8_WAIT_V(4); PG8_BAR;
    PG8_STAGE(PG8_SB(1, 0), cB + kstep, voffB); PG8_STAGE(PG8_SA(1, 0), cA + kstep, voffA); PG8_STAGE(PG8_SB(1, 1), cB + hstep + kstep, voffB);
    PG8_WAIT_V(6); PG8_BAR;
    PG8_STAMP();
    for (;;) {
        const bool has_next = S.next(ui + 1, nxt);
        const char* nA = has_next ? (const char*)g.A + (size_t)nxt.pm * tstep + (size_t)(nxt.pn >> g.a_grp_shift) * g.a_grp_bytes : cA; const char* nB = has_next ? (const char*)g.Bt + (size_t)nxt.pn * tstep : cB;
        for (int t = 0; t < nt; t += 2) {
            const bool last = (t == nt - 2);
            const char* a1 = cA + (size_t)(t + 1) * kstep;
            const char* a2 = last ? nA : cA + (size_t)(t + 2) * kstep; const char* b2 = last ? nB : cB + (size_t)(t + 2) * kstep;
            const char* a3 = a2 + kstep; const char* b3 = b2 + kstep;
            if (last && has_next) S.a_ready(nxt);
            PG8_LDB(B0, 0, 0); PG8_SCHED; PG8_LDA(At, 0, 0); PG8_STAGE(PG8_SA(1, 1), a1 + hstep, voffA);
            PG8_WAIT_L(8); PG8_BAR; PG8_WAIT_L(0); PG8_MMA(0, 0, At, B0); PG8_BAR; PG8_SCHED;
            PG8_LDB(B1, 0, 1); PG8_STAGE(PG8_SB(0, 0), b2, voffB);
            PG8_BAR; PG8_WAIT_L(0); PG8_MMA(0, 1, At, B1); PG8_BAR;
            PG8_LDA(At, 0, 1); PG8_STAGE(PG8_SA(0, 0), a2, voffA);
            PG8_BAR; PG8_WAIT_L(0); PG8_MMA(1, 0, At, B0); PG8_BAR; PG8_SCHED;
            PG8_STAGE(PG8_SB(0, 1), b2 + hstep, voffB);
            PG8_WAIT_V(6); PG8_BAR; PG8_MMA(1, 1, At, B1); PG8_BAR;
            PG8_LDB(B0, 1, 0); PG8_SCHED; PG8_LDA(At, 1, 0); PG8_STAGE(PG8_SA(0, 1), a2 + hstep, voffA);
            PG8_WAIT_L(8); PG8_BAR; PG8_WAIT_L(0); PG8_MMA(0, 0, At, B0); PG8_BAR; PG8_SCHED;
            PG8_LDB(B1, 1, 1); PG8_STAGE(PG8_SB(1, 0), b3, voffB);
            PG8_BAR; PG8_WAIT_L(0); PG8_MMA(0, 1, At, B1); PG8_BAR;
            PG8_LDA(At, 1, 1); PG8_STAGE(PG8_SA(1, 0), a3, voffA);
            PG8_BAR; PG8_WAIT_L(0); PG8_MMA(1, 0, At, B0); PG8_BAR; PG8_SCHED;
            PG8_STAGE(PG8_SB(1, 1), b3 + hstep, voffB);
            PG8_WAIT_V(6); PG8_BAR; PG8_MMA(1, 1, At, B1); PG8_BAR;
        }
        PG8_STAMP();
        if constexpr (!Epi::AFTER_DRAIN) { E(acc, cur, wr, wc, fr, fq); S.done(cur); }
        PG8_STAMP();
        if (!has_next) break;
#pragma unroll
        for (int a = 0; a < 2; ++a)
#pragma unroll
            for (int b = 0; b < 2; ++b)
#pragma unroll
                for (int m = 0; m < 4; ++m)
#pragma unroll
                    for (int n = 0; n < 2; ++n) acc[a][b][m][n] = (f32x4){0.f, 0.f, 0.f, 0.f};
        cur = nxt; cA = nA; cB = nB; ++ui;
    }
    PG8_WAIT_V(0);
    if (wr == 0) PG8_BAR;
    PG8_BAR;
    if constexpr (Epi::AFTER_DRAIN) { E.fused(acc, cur, wr, wc, fr, fq, lds, wid, lane); S.done(cur); }
    PG8_STAMP();
    if (STAMP && wid == 0) { stamps[lane] = lane < nts ? (((unsigned long long)(unsigned)ts_hi << 32) | (unsigned)ts_lo) : 0ull;
        if (lane == 62) stamps[62] = rt_entry; if (lane == 63) stamps[63] = (unsigned long long)wall_clock64(); }
#undef PG8_STAMP
#undef PG8_SA
#undef PG8_SB
#undef PG8_STAGE
#undef PG8_LDA
#undef PG8_LDB
#undef PG8_MMA
#undef PG8_WAIT_V
#undef PG8_WAIT_L
#undef PG8_BAR
#undef PG8_SCHED
}
}
struct Params { const float* in[35]; float* out; unsigned char* ws; int pad0, pad1; };

constexpr size_t MB = 1u << 20;
constexpr size_t WS_WMIX  = 0;
constexpr size_t WMIX_B   = (size_t)3584 * 2048 * 2;
constexpr size_t WMIX_C   = WMIX_B + (size_t)5120 * 512 * 2;
constexpr size_t WS_WQ    = WS_WMIX + WMIX_C + (size_t)1024 * 1024 * 2;
constexpr size_t WS_WKV   = WS_WQ + (size_t)1024 * 1024 * 2;
constexpr size_t WS_WO    = WS_WKV + (size_t)2048 * 1024 * 2;
constexpr size_t WS_WGU   = WS_WO + (size_t)1024 * 1024 * 2;
constexpr size_t WS_WDN   = WS_WGU + (size_t)5632 * 1024 * 2;
constexpr size_t WS_MN    = WS_WDN + (size_t)1024 * 2816 * 2;
constexpr size_t WS_KV    = WS_MN + (size_t)4096 * 1024 * 2;
constexpr size_t WS_ROPE  = WS_KV + (size_t)4096 * 2048 * 2;
constexpr size_t WS_ARENA = WS_ROPE + (size_t)4096 * 16 * 4;
constexpr size_t AR_A = 0, AR_B = (size_t)TC * 8192, AR_C = (size_t)TC * 14336, AR_D = (size_t)TC * 24576, AR_END = (size_t)TC * 26624;
constexpr size_t WS_BAR = WS_ARENA + AR_END;
constexpr size_t WS_SS = WS_BAR + 16384;
constexpr size_t WS_END = WS_SS + (size_t)2 * TC * 8;

__device__ __forceinline__ int map_row(int n, int mode) {
    if (mode == 0) return n;
    const int up = n >= 2816, c = up ? n - 2816 : n;
    return (c >> 4) * 32 + ((c & 15) >> 2) * 8 + up * 4 + (c & 3);
}
__device__ __forceinline__ void tr_job(LAS unsigned char* lds, const float* __restrict__ src, int ld_src, int K, int N, u16* dst, int ld_dst, int col0, const float* __restrict__ s1, int mode, int rot) {
    LAS float* T = (LAS float*)lds;
    const int tid = ltid(), nkt = K >> 6, nnt = N >> 6, ntile = nkt * nnt;
    for (int t = (blockIdx.x + rot) % gridDim.x; t < ntile; t += gridDim.x) {
        const int kt = t / nnt, nt = t % nnt;
#pragma unroll
        for (int it = 0; it < 2; ++it) {
            const int kk = (tid >> 4) + it * 32, n4 = (tid & 15) * 4;
            f32x4 v = *(const f32x4*)(src + (size_t)(kt * 64 + kk) * ld_src + nt * 64 + n4);
            const float s = s1 ? s1[kt * 64 + kk] : 1.0f;
#pragma unroll
            for (int e = 0; e < 4; ++e) T[(n4 + e) * 65 + kk] = v[e] * s;
        }
        __syncthreads();
        {
            const int n = tid >> 3, k8 = (tid & 7) * 8; float f[8];
#pragma unroll
            for (int e = 0; e < 8; ++e) f[e] = T[n * 65 + k8 + e];
            u32x4 w; w.x = cvt_pk_bf16(f[0], f[1]); w.y = cvt_pk_bf16(f[2], f[3]); w.z = cvt_pk_bf16(f[4], f[5]); w.w = cvt_pk_bf16(f[6], f[7]);
            *(u32x4*)(dst + (size_t)map_row(nt * 64 + n, mode) * ld_dst + col0 + kt * 64 + k8) = w;
        }
        __syncthreads();
    }
}

__device__ __forceinline__ void norm_rows(const float* __restrict__ X, const float* __restrict__ g, u16* dst, int ld_dst, int nrows) {
    const int lane = ltid() & 63, gw = blockIdx.x * 8 + (ltid() >> 6), nw = gridDim.x * 8;
    f32x4 gv[4];
#pragma unroll
    for (int i = 0; i < 4; ++i) gv[i] = *(const f32x4*)(g + i * 256 + lane * 4);
    for (int r = gw; r < nrows; r += nw) {
        const float* xr = X + (size_t)r * 1024; f32x4 v[4]; float ss = 0.f;
#pragma unroll
        for (int i = 0; i < 4; ++i) { v[i] = *(const f32x4*)(xr + i * 256 + lane * 4); ss += v[i][0] * v[i][0] + v[i][1] * v[i][1] + v[i][2] * v[i][2] + v[i][3] * v[i][3]; }
        ss = wave_sum(ss); const float rs = rsqrtf(ss * (1.0f / 1024.0f) + 1e-6f);
#pragma unroll
        for (int i = 0; i < 4; ++i) { u32x2 w; w.x = cvt_pk_bf16(v[i][0] * rs * gv[i][0], v[i][1] * rs * gv[i][1]); w.y = cvt_pk_bf16(v[i][2] * rs * gv[i][2], v[i][3] * rs * gv[i][3]);
            *(u32x2*)(dst + (size_t)r * ld_dst + i * 256 + lane * 4) = w; }
    }
}
__device__ __forceinline__ void norm_final(float* X, const float* __restrict__ g, int nrows) {
    const int lane = ltid() & 63, gw = blockIdx.x * 8 + (ltid() >> 6), nw = gridDim.x * 8;
    f32x4 gv[4];
#pragma unroll
    for (int i = 0; i < 4; ++i) gv[i] = *(const f32x4*)(g + i * 256 + lane * 4);
    for (int r = gw; r < nrows; r += nw) {
        float* xr = X + (size_t)r * 1024; f32x4 v[4]; float ss = 0.f;
#pragma unroll
        for (int i = 0; i < 4; ++i) { v[i] = *(const f32x4*)(xr + i * 256 + lane * 4); ss += v[i][0] * v[i][0] + v[i][1] * v[i][1] + v[i][2] * v[i][2] + v[i][3] * v[i][3]; }
        ss = wave_sum(ss); const float rs = rsqrtf(ss * (1.0f / 1024.0f) + 1e-6f);
#pragma unroll
        for (int i = 0; i < 4; ++i) *(f32x4*)(xr + i * 256 + lane * 4) = v[i] * rs * gv[i];
    }
}
__device__ __forceinline__ void norm_shift(const float* __restrict__ X, const float* __restrict__ g, const float* __restrict__ mu, u16* XNX, u16* XM, int S) {
    const int lane = ltid() & 63, gw = blockIdx.x * 8 + (ltid() >> 6), nw = gridDim.x * 8;
    f32x4 gv[4], m0[4], m2[4], m3[4];
#pragma unroll
    for (int i = 0; i < 4; ++i) { gv[i] = *(const f32x4*)(g + i * 256 + lane * 4); m0[i] = *(const f32x4*)(mu + i * 256 + lane * 4); m2[i] = *(const f32x4*)(mu + 2048 + i * 256 + lane * 4); m3[i] = *(const f32x4*)(mu + 3072 + i * 256 + lane * 4); }
    for (int run = gw; run < TC / 8; run += nw) {
        const int r0 = run * 8;
        f32x4 xp[4], xc[4], xq[4];
#define NS_LOAD(dst, rr) do { const int r_ = (rr); const bool in_ = (r_ >= 0) && (r_ < TC) && ((r_ / S) == (r0 / S)); float ss_ = 0.f; \
            _Pragma("unroll") for (int i = 0; i < 4; ++i) { dst[i] = in_ ? *(const f32x4*)(X + (size_t)r_ * 1024 + i * 256 + lane * 4) : (f32x4){0.f, 0.f, 0.f, 0.f}; \
                ss_ += dst[i][0] * dst[i][0] + dst[i][1] * dst[i][1] + dst[i][2] * dst[i][2] + dst[i][3] * dst[i][3]; } \
            ss_ = wave_sum(ss_); const float rs_ = in_ ? rsqrtf(ss_ * (1.0f / 1024.0f) + 1e-6f) : 0.f; \
            _Pragma("unroll") for (int i = 0; i < 4; ++i) dst[i] = dst[i] * rs_ * gv[i]; } while (0)
        NS_LOAD(xp, r0 - 1); NS_LOAD(xc, r0);
#pragma unroll 1
        for (int k = 0; k < 8; ++k) {
            const int r = r0 + k;
            NS_LOAD(xq, r + 1);
#pragma unroll
            for (int i = 0; i < 4; ++i) { float xn[4], xx[4];
#pragma unroll
                for (int e = 0; e < 4; ++e) { xn[e] = xc[i][e]; xx[e] = 0.5f * (xp[i][e] + xq[i][e]) - xn[e]; }
                const size_t o = (size_t)r * 2048 + i * 256 + lane * 4, om = (size_t)r * 1024 + i * 256 + lane * 4;
                u32x2 w; w.x = cvt_pk_bf16(xn[0], xn[1]); w.y = cvt_pk_bf16(xn[2], xn[3]); *(u32x2*)(XNX + o) = w;
                u32x2 z; z.x = cvt_pk_bf16(xx[0], xx[1]); z.y = cvt_pk_bf16(xx[2], xx[3]); *(u32x2*)(XNX + o + 1024) = z;
                u32x2 a; a.x = cvt_pk_bf16(xn[0] + xx[0] * m0[i][0], xn[1] + xx[1] * m0[i][1]); a.y = cvt_pk_bf16(xn[2] + xx[2] * m0[i][2], xn[3] + xx[3] * m0[i][3]); *(u32x2*)(XM + om) = a;
                u32x2 b; b.x = cvt_pk_bf16(xn[0] + xx[0] * m2[i][0], xn[1] + xx[1] * m2[i][1]); b.y = cvt_pk_bf16(xn[2] + xx[2] * m2[i][2], xn[3] + xx[3] * m2[i][3]); *(u32x2*)(XM + (size_t)TC * 1024 + om) = b;
                u32x2 c; c.x = cvt_pk_bf16(xn[0] + xx[0] * m3[i][0], xn[1] + xx[1] * m3[i][1]); c.y = cvt_pk_bf16(xn[2] + xx[2] * m3[i][2], xn[3] + xx[3] * m3[i][3]); *(u32x2*)(XM + (size_t)2 * TC * 1024 + om) = c; }
#pragma unroll
            for (int i = 0; i < 4; ++i) { xp[i] = xc[i]; xc[i] = xq[i]; }
        }
#undef NS_LOAD
    }
}

__device__ __forceinline__ bf16x8 as_bf16x8(u32x4 v) { return __builtin_bit_cast(bf16x8, v); }
__device__ __forceinline__ u32x4 rot8(u32x4 mine, u32x4 partner, int c, const float* __restrict__ rope, float scale) {
    float cs[16];
#pragma unroll
    for (int i = 0; i < 4; ++i) { const f32x4 t = *(const f32x4*)(rope + 4 * i); cs[4 * i] = t[0]; cs[4 * i + 1] = t[1]; cs[4 * i + 2] = t[2]; cs[4 * i + 3] = t[3]; }
    float o[8];
#pragma unroll
    for (int i = 0; i < 4; ++i) {
        const unsigned mw = mine[i], pw = partner[i];
        const float m0 = bflo(mw), m1 = bfhi(mw), p0 = bflo(pw), p1 = bfhi(pw);
        const float c0 = cs[4 * i], s0 = cs[4 * i + 1], c1 = cs[4 * i + 2], s1 = cs[4 * i + 3];
        if (c == 0) { o[2 * i] = (m0 * c0 - p0 * s0) * scale; o[2 * i + 1] = (m1 * c1 - p1 * s1) * scale; }
        else        { o[2 * i] = (m0 * c0 + p0 * s0) * scale; o[2 * i + 1] = (m1 * c1 + p1 * s1) * scale; }
    }
    u32x4 r; r.x = cvt_pk_bf16(o[0], o[1]); r.y = cvt_pk_bf16(o[2], o[3]); r.z = cvt_pk_bf16(o[4], o[5]); r.w = cvt_pk_bf16(o[6], o[7]); return r;
}
__device__ __forceinline__ u32x4 scale8(u32x4 v, float scale) {
    u32x4 r;
#pragma unroll
    for (int i = 0; i < 4; ++i) r[i] = cvt_pk_bf16(bflo(v[i]) * scale, bfhi(v[i]) * scale);
    return r;
}

__device__ __forceinline__ void dil_attn_phase(LAS unsigned char* lds, const u16* __restrict__ Z, u16* PART, float* LSE, const float* __restrict__ ROPE, int S) {
    const int tid = ltid(), lane = tid & 63, w = tid >> 6, fr = lane & 15, fq = lane >> 4;
    LAS u16* Ks = (LAS u16*)lds;
    LAS u16* Vt = (LAS u16*)(lds + 272 * 144);
    const int upb = S >> 7, nunits = (TC / S) * 8 * 3 * upb;
    for (int u = blockIdx.x; u < nunits; u += gridDim.x) {
        const int sh = u / (3 * upb), rem = u % (3 * upb), g = rem / upb, idx = rem % upb, seq = sh >> 3, head = sh & 7;
        const int d = 1 << (2 * g), L = S / d, nb2 = upb / d, r = idx / nb2, pair = idx % nb2;
        const int seqbase = seq * S, kl0 = 128 * pair - 64;
        {
            const int c = tid & 7, klb = tid >> 3;
            u32x4 kv[5], pk[5], vv[5]; int sp[5];
#pragma unroll
            for (int i = 0; i < 5; ++i) {
                const int kl = klb + 64 * i, lp = kl0 + kl; const bool ok = (kl < 272) && (lp >= 0) && (lp < L);
                const int s = ok ? lp * d + r : 0; sp[i] = ok ? s : -1;
                const u16* row = Z + (size_t)(seqbase + s) * 3072 + head * 64;
                kv[i] = ok ? *(const u32x4*)(row + 512 + c * 8) : (u32x4){0u, 0u, 0u, 0u};
                pk[i] = (ok && c < 2) ? *(const u32x4*)(row + 512 + (c ^ 1) * 8) : (u32x4){0u, 0u, 0u, 0u};
                const int klv = lane + 64 * i, lpv = kl0 + klv; const bool okv = (klv < 272) && (lpv >= 0) && (lpv < L);
                const int sv = okv ? lpv * d + r : 0;
                vv[i] = okv ? *(const u32x4*)(Z + (size_t)(seqbase + sv) * 3072 + head * 64 + 1024 + w * 8) : (u32x4){0u, 0u, 0u, 0u};
            }
            __builtin_amdgcn_sched_barrier(0);
#pragma unroll
            for (int i = 0; i < 5; ++i) {
                const int kl = klb + 64 * i;
                if (kl < 272) { u32x4 kk = kv[i]; if (c < 2 && sp[i] >= 0) kk = rot8(kk, pk[i], c, ROPE + sp[i] * 16, 1.0f); *(LAS u32x4*)(Ks + kl * 72 + c * 8) = kk; }
                const int klv = lane + 64 * i;
                if (klv < 272) {
#pragma unroll
                    for (int e = 0; e < 4; ++e) { Vt[(w * 8 + 2 * e) * 280 + klv] = (u16)(vv[i][e] & 0xffffu); Vt[(w * 8 + 2 * e + 1) * 280 + klv] = (u16)(vv[i][e] >> 16); } }
            }
        }
        const int lq = 128 * pair + 16 * w + fr, sq = lq * d + r; const int tokq = seqbase + sq;
        bf16x8 qf[2];
        {
            const u16* row = Z + (size_t)tokq * 3072 + head * 64;
            u32x4 q0 = *(const u32x4*)(row + fq * 8), q1 = *(const u32x4*)(row + 32 + fq * 8);
            if (fq < 2) { const u32x4 pk = *(const u32x4*)(row + (fq ^ 1) * 8); q0 = rot8(q0, pk, fq, ROPE + sq * 16, 0.125f); } else q0 = scale8(q0, 0.125f);
            q1 = scale8(q1, 0.125f);
            qf[0] = as_bf16x8(q0); qf[1] = as_bf16x8(q1);
        }
        __syncthreads();
        f32x4 sacc[10];
#pragma unroll
        for (int kt = 0; kt < 10; ++kt) { sacc[kt] = (f32x4){0.f, 0.f, 0.f, 0.f};
#pragma unroll
            for (int sl = 0; sl < 2; ++sl) { const bf16x8 a = *(const LAS bf16x8*)(Ks + (16 * w + 16 * kt + fr) * 72 + sl * 32 + fq * 8); sacc[kt] = __builtin_amdgcn_mfma_f32_16x16x32_bf16(a, qf[sl], sacc[kt], 0, 0, 0); } }
        float mx = -3.0e38f;
#pragma unroll
        for (int kt = 0; kt < 10; ++kt)
#pragma unroll
            for (int j = 0; j < 4; ++j) { const int diff = 16 * kt + fq * 4 + j - 64 - fr, lp = lq + diff; const bool ok = (diff >= -64) && (diff <= 64) && (lp >= 0) && (lp < L);
                const float sv = ok ? sacc[kt][j] : -1.0e30f; sacc[kt][j] = sv; mx = fmaxf(mx, sv); }
        mx = fmaxf(mx, __shfl_xor(mx, 16)); mx = fmaxf(mx, __shfl_xor(mx, 32));
        float den = 0.f;
#pragma unroll
        for (int kt = 0; kt < 10; ++kt)
#pragma unroll
            for (int j = 0; j < 4; ++j) { const float sv = sacc[kt][j]; const float p = (sv > -1.0e29f) ? __expf(sv - mx) : 0.f; sacc[kt][j] = p; den += p; }
        den += __shfl_xor(den, 16); den += __shfl_xor(den, 32);
        bf16x8 pb[5];
#pragma unroll
        for (int uu = 0; uu < 5; ++uu) { u32x4 t; t.x = cvt_pk_bf16(sacc[2 * uu][0], sacc[2 * uu][1]); t.y = cvt_pk_bf16(sacc[2 * uu][2], sacc[2 * uu][3]);
            t.z = cvt_pk_bf16(sacc[2 * uu + 1][0], sacc[2 * uu + 1][1]); t.w = cvt_pk_bf16(sacc[2 * uu + 1][2], sacc[2 * uu + 1][3]); pb[uu] = as_bf16x8(t); }
        const float inv = 1.0f / den;
        u16* po = PART + ((size_t)g * TC + tokq) * 512 + head * 64 + fq * 4;
#pragma unroll
        for (int mt = 0; mt < 4; ++mt) { f32x4 o = (f32x4){0.f, 0.f, 0.f, 0.f};
#pragma unroll
            for (int uu = 0; uu < 5; ++uu) { const LAS u16* vp = Vt + (mt * 16 + fr) * 280 + 16 * w + 32 * uu + fq * 4;
                const u32x2 lo = *(const LAS u32x2*)vp, hi = *(const LAS u32x2*)(vp + 16); u32x4 t; t.x = lo.x; t.y = lo.y; t.z = hi.x; t.w = hi.y;
                o = __builtin_amdgcn_mfma_f32_16x16x32_bf16(as_bf16x8(t), pb[uu], o, 0, 0, 0); }
            u32x2 wv; wv.x = cvt_pk_bf16(o[0] * inv, o[1] * inv); wv.y = cvt_pk_bf16(o[2] * inv, o[3] * inv); *(u32x2*)(po + mt * 16) = wv; }
        if (fq == 0) LSE[((size_t)g * TC + tokq) * 8 + head] = mx + __logf(den);
        __syncthreads();
    }
}

__device__ __forceinline__ void merge_conv_phase(const u16* __restrict__ Z, const u16* __restrict__ PART, const float* __restrict__ LSE, const float* __restrict__ convw, u16* Y, int S) {
    const int lane = ltid() & 63, gw = blockIdx.x * 8 + (ltid() >> 6), nw = gridDim.x * 8;
    float cw[3][8];
#pragma unroll
    for (int j = 0; j < 3; ++j)
#pragma unroll
        for (int e = 0; e < 8; ++e) cw[j][e] = convw[j * 512 + lane * 8 + e];
    for (int t = gw; t < TC; t += nw) {
        const int s = t % S, head = lane >> 3;
        const float l0 = LSE[((size_t)0 * TC + t) * 8 + head], l1 = LSE[((size_t)1 * TC + t) * 8 + head], l2 = LSE[((size_t)2 * TC + t) * 8 + head];
        const float lm = fmaxf(l0, fmaxf(l1, l2)); float w0 = __expf(l0 - lm), w1 = __expf(l1 - lm), w2 = __expf(l2 - lm); const float wi = 1.0f / (w0 + w1 + w2); w0 *= wi; w1 *= wi; w2 *= wi;
        const u32x4 p0 = *(const u32x4*)(PART + ((size_t)0 * TC + t) * 512 + lane * 8), p1 = *(const u32x4*)(PART + ((size_t)1 * TC + t) * 512 + lane * 8), p2 = *(const u32x4*)(PART + ((size_t)2 * TC + t) * 512 + lane * 8);
        u32x4 ya;
#pragma unroll
        for (int i = 0; i < 4; ++i) ya[i] = cvt_pk_bf16(w0 * bflo(p0[i]) + w1 * bflo(p1[i]) + w2 * bflo(p2[i]), w0 * bfhi(p0[i]) + w1 * bfhi(p1[i]) + w2 * bfhi(p2[i]));
        *(u32x4*)(Y + (size_t)t * 1024 + lane * 8) = ya;
        const u16* zr = Z + (size_t)t * 3072;
        const u32x4 bg = *(const u32x4*)(zr + 1536 + lane * 8);
        float acc[8];
#pragma unroll
        for (int e = 0; e < 8; ++e) acc[e] = 0.f;
#pragma unroll
        for (int j = 0; j < 3; ++j) { const int sj = s + j - 1;
            if (sj >= 0 && sj < S) { const u16* zj = zr + (ptrdiff_t)(j - 1) * 3072; const u32x4 cg = *(const u32x4*)(zj + 2048 + lane * 8), hh = *(const u32x4*)(zj + 2560 + lane * 8);
#pragma unroll
                for (int i = 0; i < 4; ++i) { acc[2 * i] += cw[j][2 * i] * (bflo(cg[i]) * bflo(hh[i])); acc[2 * i + 1] += cw[j][2 * i + 1] * (bfhi(cg[i]) * bfhi(hh[i])); } } }
        u32x4 yb;
#pragma unroll
        for (int i = 0; i < 4; ++i) yb[i] = cvt_pk_bf16(bflo(bg[i]) * acc[2 * i], bfhi(bg[i]) * acc[2 * i + 1]);
        *(u32x4*)(Y + (size_t)t * 1024 + 512 + lane * 8) = yb;
    }
}

__device__ __forceinline__ void cross_attn_unit(LAS unsigned char* lds, const u16* __restrict__ Q, const u16* __restrict__ KV, int memrow0, u16* O, int S, int seq, int head, int qt) {
    const int tid = ltid(), lane = tid & 63, w = tid >> 6, fr = lane & 15, fq = lane >> 4;
    LAS u16* Ks = (LAS u16*)lds;
    {
        const u16* kvb = KV + (size_t)(memrow0 + seq * 256) * 2048 + head * 256;
        { u32x4 tmp[16];
#pragma unroll
          for (int i = 0; i < 16; ++i) { const int task = tid + i * NTHREADS, key = task >> 5, c = task & 31; tmp[i] = *(const u32x4*)(kvb + (size_t)key * 2048 + c * 8); }
#pragma unroll
          for (int i = 0; i < 16; ++i) { const int task = tid + i * NTHREADS, key = task >> 5, c = task & 31; *(LAS u32x4*)(Ks + key * 264 + c * 8) = tmp[i]; } }
        const int tokq = seq * S + qt * 128 + 16 * w + fr;
        bf16x8 qf[8];
        { const u16* row = Q + (size_t)tokq * 1024 + head * 256;
#pragma unroll
          for (int sl = 0; sl < 8; ++sl) qf[sl] = as_bf16x8(scale8(*(const u32x4*)(row + sl * 32 + fq * 8), 0.0625f)); }
        __syncthreads();
        f32x4 sacc[16];
#pragma unroll
        for (int kt = 0; kt < 16; ++kt) { sacc[kt] = (f32x4){0.f, 0.f, 0.f, 0.f};
#pragma unroll
            for (int sl = 0; sl < 8; ++sl) { const bf16x8 a = *(const LAS bf16x8*)(Ks + (16 * kt + fr) * 264 + sl * 32 + fq * 8); sacc[kt] = __builtin_amdgcn_mfma_f32_16x16x32_bf16(a, qf[sl], sacc[kt], 0, 0, 0); } }
        float mx = -3.0e38f;
#pragma unroll
        for (int kt = 0; kt < 16; ++kt)
#pragma unroll
            for (int j = 0; j < 4; ++j) mx = fmaxf(mx, sacc[kt][j]);
        mx = fmaxf(mx, __shfl_xor(mx, 16)); mx = fmaxf(mx, __shfl_xor(mx, 32));
        float den = 0.f;
#pragma unroll
        for (int kt = 0; kt < 16; ++kt)
#pragma unroll
            for (int j = 0; j < 4; ++j) { const float p = __expf(sacc[kt][j] - mx); sacc[kt][j] = p; den += p; }
        den += __shfl_xor(den, 16); den += __shfl_xor(den, 32);
        bf16x8 pb[8];
#pragma unroll
        for (int uu = 0; uu < 8; ++uu) { u32x4 t; t.x = cvt_pk_bf16(sacc[2 * uu][0], sacc[2 * uu][1]); t.y = cvt_pk_bf16(sacc[2 * uu][2], sacc[2 * uu][3]);
            t.z = cvt_pk_bf16(sacc[2 * uu + 1][0], sacc[2 * uu + 1][1]); t.w = cvt_pk_bf16(sacc[2 * uu + 1][2], sacc[2 * uu + 1][3]); pb[uu] = as_bf16x8(t); }
        __syncthreads();
        { u32x4 tmp[16]; const int key = (w & 3) * 64 + lane, cb = (w >> 2) * 16;
#pragma unroll
          for (int i = 0; i < 16; ++i) tmp[i] = *(const u32x4*)(kvb + 1024 + (size_t)key * 2048 + (cb + i) * 8);
#pragma unroll
          for (int i = 0; i < 16; ++i) {
#pragma unroll
            for (int e = 0; e < 4; ++e) { Ks[((cb + i) * 8 + 2 * e) * 264 + key] = (u16)(tmp[i][e] & 0xffffu); Ks[((cb + i) * 8 + 2 * e + 1) * 264 + key] = (u16)(tmp[i][e] >> 16); } } }
        __syncthreads();
        const float inv = 1.0f / den;
        u16* po = O + (size_t)tokq * 1024 + head * 256 + fq * 4;
#pragma unroll
        for (int mt = 0; mt < 16; ++mt) { f32x4 o = (f32x4){0.f, 0.f, 0.f, 0.f};
#pragma unroll
            for (int uu = 0; uu < 8; ++uu) { const LAS u16* vp = Ks + (mt * 16 + fr) * 264 + 32 * uu + fq * 4;
                const u32x2 lo = *(const LAS u32x2*)vp, hi = *(const LAS u32x2*)(vp + 16); u32x4 t; t.x = lo.x; t.y = lo.y; t.z = hi.x; t.w = hi.y;
                o = __builtin_amdgcn_mfma_f32_16x16x32_bf16(as_bf16x8(t), pb[uu], o, 0, 0, 0); }
            u32x2 wv; wv.x = cvt_pk_bf16(o[0] * inv, o[1] * inv); wv.y = cvt_pk_bf16(o[2] * inv, o[3] * inv); *(u32x2*)(po + mt * 16) = wv; }
        __syncthreads();
    }
}
__device__ __forceinline__ void cross_attn_phase(LAS unsigned char* lds, const u16* __restrict__ Q, const u16* __restrict__ KV, int memrow0, u16* O, int S) {
    const int qpb = S >> 7, nunits = (TC / S) * 4 * qpb;
    for (int u = blockIdx.x; u < nunits; u += gridDim.x) { const int sh = u / qpb, qt = u % qpb; cross_attn_unit(lds, Q, KV, memrow0, O, S, sh >> 2, sh & 3, qt); }
}
template <int CTRL> __device__ __forceinline__ float dpp_add(float v) { const int t = __builtin_amdgcn_update_dpp(__float_as_int(v), __float_as_int(v), CTRL, 0xf, 0xf, true); return v + __int_as_float(t); }
template <int L> __device__ __forceinline__ float row_reduce(float v) {
    v = dpp_add<0xB1>(v); v = dpp_add<0x4E>(v); v = dpp_add<0x141>(v);
    if (L == 16) v = dpp_add<0x140>(v);
    return v;
}
__device__ __forceinline__ void row_reduce2(float& a, float& b) {
    asm volatile("s_nop 1\n\t"
        "v_add_f32_dpp %0, %0, %0 quad_perm:[1,0,3,2] row_mask:0xf bank_mask:0xf bound_ctrl:1\n\t"
        "v_add_f32_dpp %1, %1, %1 quad_perm:[1,0,3,2] row_mask:0xf bank_mask:0xf bound_ctrl:1\n\t"
        "s_nop 0\n\t"
        "v_add_f32_dpp %0, %0, %0 quad_perm:[2,3,0,1] row_mask:0xf bank_mask:0xf bound_ctrl:1\n\t"
        "v_add_f32_dpp %1, %1, %1 quad_perm:[2,3,0,1] row_mask:0xf bank_mask:0xf bound_ctrl:1\n\t"
        "s_nop 0\n\t"
        "v_add_f32_dpp %0, %0, %0 row_half_mirror row_mask:0xf bank_mask:0xf bound_ctrl:1\n\t"
        "v_add_f32_dpp %1, %1, %1 row_half_mirror row_mask:0xf bank_mask:0xf bound_ctrl:1\n\t"
        "s_nop 0\n\t"
        "v_add_f32_dpp %0, %0, %0 row_mirror row_mask:0xf bank_mask:0xf bound_ctrl:1\n\t"
        "v_add_f32_dpp %1, %1, %1 row_mirror row_mask:0xf bank_mask:0xf bound_ctrl:1\n\t"
        "s_nop 1"
        : "+v"(a), "+v"(b));
}
__device__ __forceinline__ void half_reduce2(float& a, float& b) {
    asm volatile("s_nop 1\n\t"
        "v_add_f32_dpp %0, %0, %0 quad_perm:[1,0,3,2] row_mask:0xf bank_mask:0xf bound_ctrl:1\n\t"
        "v_add_f32_dpp %1, %1, %1 quad_perm:[1,0,3,2] row_mask:0xf bank_mask:0xf bound_ctrl:1\n\t"
        "s_nop 0\n\t"
        "v_add_f32_dpp %0, %0, %0 quad_perm:[2,3,0,1] row_mask:0xf bank_mask:0xf bound_ctrl:1\n\t"
        "v_add_f32_dpp %1, %1, %1 quad_perm:[2,3,0,1] row_mask:0xf bank_mask:0xf bound_ctrl:1\n\t"
        "s_nop 0\n\t"
        "v_add_f32_dpp %0, %0, %0 row_half_mirror row_mask:0xf bank_mask:0xf bound_ctrl:1\n\t"
        "v_add_f32_dpp %1, %1, %1 row_half_mirror row_mask:0xf bank_mask:0xf bound_ctrl:1\n\t"
        "s_nop 1"
        : "+v"(a), "+v"(b));
}
__device__ __forceinline__ void half_reduce1(float& a) {
    asm volatile("s_nop 1\n\t"
        "v_add_f32_dpp %0, %0, %0 quad_perm:[1,0,3,2] row_mask:0xf bank_mask:0xf bound_ctrl:1\n\t"
        "s_nop 1\n\t"
        "v_add_f32_dpp %0, %0, %0 quad_perm:[2,3,0,1] row_mask:0xf bank_mask:0xf bound_ctrl:1\n\t"
        "s_nop 1\n\t"
        "v_add_f32_dpp %0, %0, %0 row_half_mirror row_mask:0xf bank_mask:0xf bound_ctrl:1\n\t"
        "s_nop 1"
        : "+v"(a));
}
__device__ __forceinline__ void row_reduce4(float& a, float& b, float& c, float& d) {
#define RR4_STEP(ctl) "v_add_f32_dpp %0, %0, %0 " ctl " row_mask:0xf bank_mask:0xf bound_ctrl:1\n\t" "v_add_f32_dpp %1, %1, %1 " ctl " row_mask:0xf bank_mask:0xf bound_ctrl:1\n\t" \
                      "v_add_f32_dpp %2, %2, %2 " ctl " row_mask:0xf bank_mask:0xf bound_ctrl:1\n\t" "v_add_f32_dpp %3, %3, %3 " ctl " row_mask:0xf bank_mask:0xf bound_ctrl:1\n\t"
    asm volatile("s_nop 1\n\t" RR4_STEP("quad_perm:[1,0,3,2]") RR4_STEP("quad_perm:[2,3,0,1]") RR4_STEP("row_half_mirror") RR4_STEP("row_mirror") "s_nop 1"
        : "+v"(a), "+v"(b), "+v"(c), "+v"(d));
#undef RR4_STEP
}
__device__ __forceinline__ float wave_sum_fast(float v) { v = dpp_add<0xB1>(v); v = dpp_add<0x4E>(v); v = dpp_add<0x141>(v); v = dpp_add<0x140>(v); v += __shfl_xor(v, 16); v += __shfl_xor(v, 32); return v; }
constexpr int TS = 32;
struct ScanRaw { u16 r[8], k[8], v[8], e[8], a[8]; };
template <int RR, int J>
__device__ __forceinline__ void scan_item(LAS unsigned char* lds, const u16* __restrict__ RKV, const u16* __restrict__ Ed, const u16* __restrict__ Ad, const float* __restrict__ kkw, const float* __restrict__ kaw,
                          const float* __restrict__ rkw, u16* OD, float* BON, int S, int seqbase, int head, int dir, int rowbase) {
    constexpr int NACT = 4;
    const int tid = ltid(), lane = tid & 63, w = tid >> 6;
    constexpr int L = 64 / J, NRG = 64 / L;
    const int rg = lane / L, jg = lane % L, j0 = jg * J, row0 = rowbase + w * (NRG * RR) + rg * RR;
    const float kkc = kkw[head * 64 + lane], kac = kaw[head * 64 + lane], rkc = rkw[head * 64 + lane];
    f32x2 st_[RR][J / 2];
#pragma unroll
    for (int r = 0; r < RR; ++r)
#pragma unroll
        for (int q = 0; q < J / 2; ++q) st_[r][q] = (f32x2){0.f, 0.f};
    const int nch = S / TS;
    ScanRaw raw;
    constexpr int NPT = 8;
    const bool prep = (w >= 4); const int pw = w - 4;
#define SCAN_LOAD(ch) do { if (prep) { _Pragma("unroll") for (int q = 0; q < NPT; ++q) { const int i = (ch) * TS + pw * NPT + q; const int t = dir ? (S - 1 - i) : i; const size_t tok = (size_t)(seqbase + t); \
        raw.r[q] = RKV[tok * 3072 + head * 64 + lane]; raw.k[q] = RKV[tok * 3072 + 1024 + head * 64 + lane]; raw.v[q] = RKV[tok * 3072 + 2048 + head * 64 + lane]; \
        raw.e[q] = Ed[tok * 1024 + head * 64 + lane]; raw.a[q] = Ad[tok * 1024 + head * 64 + lane]; } } } while (0)
#define SCAN_PREP(buf, ch) do { if (prep) { LAS float* B_ = (LAS float*)(lds + (buf) * 49152); _Pragma("unroll") for (int q = 0; q < NPT; ++q) { const int ls = pw * NPT + q; \
        const float r_ = bf2f(raw.r[q]), k_ = bf2f(raw.k[q]), v_ = bf2f(raw.v[q]), a_ = bf2f(raw.a[q]); const float e_ = (float)__builtin_bit_cast(_Float16, raw.e[q]); \
        const float kr_ = k_ * kkc; const float ss_ = wave_sum_fast(kr_ * kr_); const float kk_ = kr_ * rsqrtf(fmaxf(ss_, 1e-24f)); \
        B_[(0 * TS + ls) * 64 + lane] = __expf(-e_); B_[(1 * TS + ls) * 64 + lane] = -kk_; B_[(2 * TS + ls) * 64 + lane] = kk_ * a_; \
        const float kd_ = k_ * (1.0f + (a_ - 1.0f) * kac); const float bn_ = wave_sum_fast(r_ * kd_ * rkc); \
        { const int i_ = (ch) * TS + ls; const int t_ = dir ? (S - 1 - i_) : i_; if (lane == 0) BON[((size_t)dir * TC + seqbase + t_) * 16 + head] = bn_; } \
        B_[(3 * TS + ls) * 64 + lane] = kd_; B_[(4 * TS + ls) * 64 + lane] = r_; B_[(5 * TS + ls) * 64 + lane] = v_; } } } while (0)
    SCAN_LOAD(0);
    SCAN_PREP(0, 0);
    __syncthreads();
    for (int ch = 0; ch < nch; ++ch) {
        if (ch + 1 < nch) SCAN_LOAD(ch + 1);
        if (w < NACT) {
            const LAS float* B = (const LAS float*)(lds + (ch & 1) * 49152);
            float os[RR];
#pragma unroll
            for (int r = 0; r < RR; ++r) os[r] = 0.f;
            f32x4 W[J / 4], A[J / 4], Bb[J / 4], K[J / 4], R[J / 4];
#pragma unroll
            for (int q = 0; q < J / 4; ++q) { W[q] = *(const LAS f32x4*)(B + (0 * TS) * 64 + j0 + 4 * q); A[q] = *(const LAS f32x4*)(B + (1 * TS) * 64 + j0 + 4 * q); Bb[q] = *(const LAS f32x4*)(B + (2 * TS) * 64 + j0 + 4 * q);
                K[q] = *(const LAS f32x4*)(B + (3 * TS) * 64 + j0 + 4 * q); R[q] = *(const LAS f32x4*)(B + (4 * TS) * 64 + j0 + 4 * q); }
            float V[RR];
#pragma unroll
            for (int r = 0; r < RR; ++r) V[r] = B[(5 * TS) * 64 + row0 + r];
#pragma unroll
            for (int ls = 0; ls < TS; ++ls) {
                f32x4 nW[J / 4], nA[J / 4], nB[J / 4], nK[J / 4], nR[J / 4]; float nV[RR];
#pragma unroll
                for (int q = 0; q < J / 4; ++q) { nW[q] = W[q]; nA[q] = A[q]; nB[q] = Bb[q]; nK[q] = K[q]; nR[q] = R[q]; }
#pragma unroll
                for (int r = 0; r < RR; ++r) nV[r] = V[r];
                if (ls + 1 < TS) {
#pragma unroll
                    for (int q = 0; q < J / 4; ++q) { nW[q] = *(const LAS f32x4*)(B + (0 * TS + ls + 1) * 64 + j0 + 4 * q); nA[q] = *(const LAS f32x4*)(B + (1 * TS + ls + 1) * 64 + j0 + 4 * q); nB[q] = *(const LAS f32x4*)(B + (2 * TS + ls + 1) * 64 + j0 + 4 * q);
                        nK[q] = *(const LAS f32x4*)(B + (3 * TS + ls + 1) * 64 + j0 + 4 * q); nR[q] = *(const LAS f32x4*)(B + (4 * TS + ls + 1) * 64 + j0 + 4 * q); }
                    if (RR == 1) nV[0] = B[(5 * TS + ls + 1) * 64 + row0];
                    else if (RR == 2) { const f32x2 t = *(const LAS f32x2*)(B + (5 * TS + ls + 1) * 64 + row0); nV[0] = t[0]; nV[RR - 1] = t[1]; }
                    else { const f32x4 t = *(const LAS f32x4*)(B + (5 * TS + ls + 1) * 64 + row0);
#pragma unroll
                        for (int r = 0; r < RR; ++r) nV[r] = t[r]; }
                }
                __builtin_amdgcn_sched_barrier(0);
                float sa[RR];
#pragma unroll
                for (int r = 0; r < RR; ++r) { f32x2 p = st_[r][0] * (f32x2){A[0][0], A[0][1]};
#pragma unroll
                    for (int q = 1; q < J / 2; ++q) p = st_[r][q] * (f32x2){A[q >> 1][(q & 1) * 2], A[q >> 1][(q & 1) * 2 + 1]} + p;
                    sa[r] = p[0] + p[1]; }
                if (J == 4) { if (RR == 2) row_reduce2(sa[0], sa[RR - 1]); else row_reduce4(sa[0], sa[RR > 1 ? 1 : 0], sa[RR > 1 ? RR - 2 : 0], sa[RR - 1]); } else if (RR == 1) half_reduce1(sa[0]); else half_reduce2(sa[0], sa[RR - 1]);
                float o[RR];
#pragma unroll
                for (int r = 0; r < RR; ++r) { const f32x2 sv = {sa[r], sa[r]}, vv = {V[r], V[r]}; f32x2 u = {0.f, 0.f};
#pragma unroll
                    for (int q = 0; q < J / 2; ++q) { const int qq = q >> 1, e = (q & 1) * 2;
                        st_[r][q] = st_[r][q] * (f32x2){W[qq][e], W[qq][e + 1]} + (sv * (f32x2){Bb[qq][e], Bb[qq][e + 1]} + vv * (f32x2){K[qq][e], K[qq][e + 1]});
                        u = st_[r][q] * (f32x2){R[qq][e], R[qq][e + 1]} + u; }
                    o[r] = u[0] + u[1]; }
                if (J == 4) { if (RR == 2) row_reduce2(o[0], o[RR - 1]); else row_reduce4(o[0], o[RR > 1 ? 1 : 0], o[RR > 1 ? RR - 2 : 0], o[RR - 1]); } else if (RR == 1) half_reduce1(o[0]); else half_reduce2(o[0], o[RR - 1]);
                const bool mine = (jg == (ls & (L - 1)));
#pragma unroll
                for (int r = 0; r < RR; ++r) os[r] = mine ? o[r] : os[r];
                if ((ls & (L - 1)) == L - 1) {
                    const int i = ch * TS + (ls - (L - 1)) + jg; const int t = dir ? (S - 1 - i) : i;
                    u16* op = OD + ((size_t)dir * TC + seqbase + t) * 1024 + head * 64 + row0;
                    if (RR == 1) *op = f2bf(os[0]);
                    else if (RR == 2) *(unsigned*)op = cvt_pk_bf16(os[0], os[RR - 1]);
                    else { u32x2 pk; pk.x = cvt_pk_bf16(os[0], os[RR > 1 ? 1 : 0]); pk.y = cvt_pk_bf16(os[RR - 2], os[RR - 1]); *(u32x2*)op = pk; }
                }
                __builtin_amdgcn_sched_barrier(0);
#pragma unroll
                for (int q = 0; q < J / 4; ++q) { W[q] = nW[q]; A[q] = nA[q]; Bb[q] = nB[q]; K[q] = nK[q]; R[q] = nR[q]; }
#pragma unroll
                for (int r = 0; r < RR; ++r) V[r] = nV[r];
            }
        }
        if (ch + 1 < nch) SCAN_PREP((ch + 1) & 1, ch + 1);
        __syncthreads();
    }
#undef SCAN_LOAD
#undef SCAN_PREP
}
__device__ __forceinline__ void scan_phase(LAS unsigned char* lds, const u16* RKV, const u16* EAG, const float* kkw, const float* kaw, const float* rkw, u16* OD, float* BON, int S) {
    for (int item = blockIdx.x; item < 256; item += gridDim.x) {
        if (S == 4096) { const int id = item >> 1, half = item & 1, seq = id >> 5, rem = id & 31, head = rem >> 1, dir = rem & 1;
            scan_item<2, 4>(lds, RKV, EAG + (size_t)dir * TC * 1024, EAG + (size_t)(2 + dir) * TC * 1024, kkw, kaw, rkw, OD, BON, S, seq * S, head, dir, half * 32);
        } else { const int seq = item >> 5, rem = item & 31, head = rem >> 1, dir = rem & 1;
            scan_item<2, 8>(lds, RKV, EAG + (size_t)dir * TC * 1024, EAG + (size_t)(2 + dir) * TC * 1024, kkw, kaw, rkw, OD, BON, S, seq * S, head, dir, 0);
        }
        __syncthreads();
    }
}
__device__ __forceinline__ float quad_sum(float v) { v = dpp_add<0xB1>(v); v = dpp_add<0x4E>(v); return v; }
__device__ __forceinline__ void rwkv_post_phase(const u16* __restrict__ OD, const float* __restrict__ BON, const u16* __restrict__ RKV, const u16* __restrict__ EAG,
                                const float* __restrict__ lnw, const float* __restrict__ lnb, u16* Y) {
    const int lane = ltid() & 63, gw = blockIdx.x * 8 + (ltid() >> 6), nw = gridDim.x * 8, c0 = lane * 16;
    float lw[16], lb[16];
#pragma unroll
    for (int i = 0; i < 4; ++i) { const f32x4 c = *(const f32x4*)(lnw + c0 + 4 * i), d = *(const f32x4*)(lnb + c0 + 4 * i);
#pragma unroll
        for (int e = 0; e < 4; ++e) { lw[4 * i + e] = c[e]; lb[4 * i + e] = d[e]; } }
    for (int t = gw; t < TC; t += nw) {
        u32x4 oa[2], ob[2], vv[2], gg[2];
#pragma unroll
        for (int i = 0; i < 2; ++i) { oa[i] = *(const u32x4*)(OD + (size_t)t * 1024 + c0 + 8 * i); ob[i] = *(const u32x4*)(OD + ((size_t)TC + t) * 1024 + c0 + 8 * i);
            vv[i] = *(const u32x4*)(RKV + (size_t)t * 3072 + 2048 + c0 + 8 * i); gg[i] = *(const u32x4*)(EAG + ((size_t)4 * TC + t) * 1024 + c0 + 8 * i); }
        const float bsum = BON[(size_t)t * 16 + (lane >> 2)] + BON[((size_t)TC + t) * 16 + (lane >> 2)];
        float y[16];
#pragma unroll
        for (int i = 0; i < 16; ++i) { const int w_ = (i & 7) >> 1; const bool hi = i & 1; y[i] = (hi ? bfhi(oa[i >> 3][w_]) : bflo(oa[i >> 3][w_])) + (hi ? bfhi(ob[i >> 3][w_]) : bflo(ob[i >> 3][w_])); }
        float sm = 0.f;
#pragma unroll
        for (int i = 0; i < 16; ++i) sm += y[i];
        const float mean = quad_sum(sm) * (1.0f / 64.0f);
        float sv = 0.f;
#pragma unroll
        for (int i = 0; i < 16; ++i) { y[i] -= mean; sv += y[i] * y[i]; }
        const float rstd = rsqrtf(quad_sum(sv) * (1.0f / 64.0f) + 64e-5f);
        float o[16];
#pragma unroll
        for (int i = 0; i < 16; ++i) { const int w_ = (i & 7) >> 1; const bool hi = i & 1;
            const float v = hi ? bfhi(vv[i >> 3][w_]) : bflo(vv[i >> 3][w_]), g = hi ? bfhi(gg[i >> 3][w_]) : bflo(gg[i >> 3][w_]);
            o[i] = (y[i] * rstd * lw[i] + lb[i] + bsum * v) * g; }
#pragma unroll
        for (int i = 0; i < 2; ++i) { u32x4 w; w.x = cvt_pk_bf16(o[8 * i], o[8 * i + 1]); w.y = cvt_pk_bf16(o[8 * i + 2], o[8 * i + 3]); w.z = cvt_pk_bf16(o[8 * i + 4], o[8 * i + 5]); w.w = cvt_pk_bf16(o[8 * i + 6], o[8 * i + 7]);
            *(u32x4*)(Y + (size_t)t * 1024 + c0 + 8 * i) = w; }
    }
}
__device__ __forceinline__ void build_w2comb(u16* W2, const float* __restrict__ w2, const float* __restrict__ a2, const float* __restrict__ g2) {
    const size_t total = (size_t)384 * 5120, stride = (size_t)gridDim.x * NTHREADS;
    for (size_t idx = (size_t)blockIdx.x * NTHREADS + ltid(); idx < total; idx += stride) {
        const int k = (int)(idx / 5120), n = (int)(idx % 5120), sel = n >> 10, nn = n & 1023; float v = 0.f;
        if (sel == 0 && k < 64) v = w2[(size_t)k * 1024 + nn];
        else if (sel == 1 && k >= 64 && k < 128) v = w2[(size_t)(64 + (k - 64)) * 1024 + nn];
        else if (sel == 2 && k >= 128 && k < 192) v = a2[(size_t)(k - 128) * 1024 + nn];
        else if (sel == 3 && k >= 192 && k < 256) v = a2[(size_t)(64 + (k - 192)) * 1024 + nn];
        else if (sel == 4 && k >= 256 && k < 384) v = g2[(size_t)(k - 256) * 1024 + nn];
        W2[(size_t)n * 384 + k] = f2bf(v);
    }
}

namespace pg8 {
struct EpiAny {
    static constexpr bool PERM = true, AFTER_DRAIN = false;
    int mode; u16* o16; u16* o16b; float* x; const float* b0; const float* b1; int ldc; int M; unsigned long long* ssw; const unsigned long long* ssr; const float* xin;
    __device__ __forceinline__ void operator()(const f32x4 (&acc)[2][2][4][2], const Unit& u, int wr, int wc, int fr, int fq) const {
        if (mode == 0) EpiStore16{o16, ldc, ssr}(acc, u, wr, wc, fr, fq);
        else if (mode == 1) EpiResid{x, xin, o16, ssw}(acc, u, wr, wc, fr, fq);
        else if (mode == 2) EpiSwiglu{o16, ssr}(acc, u, wr, wc, fr, fq);
        else if (mode == 3) EpiRwkv{o16}(acc, u, wr, wc, fr, fq);
        else EpiLora2{o16, b0, b1, M}(acc, u, wr, wc, fr, fq);
    }
};
}

__global__ void __launch_bounds__(NTHREADS, 2) mega(Params p) {
    extern __shared__ __attribute__((aligned(16))) unsigned char lds_raw[];
    LAS unsigned char* lds = (LAS unsigned char*)lds_raw;
    ltid_setup();
    cg::grid_group grid = cg::this_grid();
    unsigned char* const ws = p.ws;
    float* const X = p.out;
    const size_t gstride = (size_t)gridDim.x * NTHREADS;

    {
        float* const ROPE = (float*)(ws + WS_ROPE);
        for (size_t i = (size_t)blockIdx.x * NTHREADS + ltid(); i < 4096 * 8; i += gstride) { const int pos = (int)(i >> 3), fi = (int)(i & 7);
            const float inv = powf(500000.0f, -2.0f * (float)fi / 16.0f); const float ang = (float)pos * inv;
            ROPE[i * 2] = (float)cos((double)ang); ROPE[i * 2 + 1] = (float)sin((double)ang); }
    }
    if (blockIdx.x == 0) for (int i = ltid(); i < XCD_BAR_WORDS; i += NTHREADS) ((unsigned*)(ws + WS_BAR))[i] = 0u;
    __syncthreads();
    grid.sync();
    volatile LAS unsigned* xst = (volatile LAS unsigned*)(lds + LDS_BYTES - 16);
    if (ltid() == 0) { xst[0] = 0u; xst[1] = 0u; }
    __syncthreads();
    XcdBarrier xbar = xcd_barrier_post((unsigned*)(ws + WS_BAR), xst);
#ifndef DUP_MISC
#define DUP_MISC 1
#endif
#ifndef DUP_SYNC
#define DUP_SYNC 1
#endif
#ifndef DUP_STEP
#define DUP_STEP -1
#define DUP_PAR -1
#endif
#ifndef DUP_SCAN
#define DUP_SCAN 1
#endif
    for (int ph = 0; ph < 4 * NCHUNK * 15; ++ph) {
        const int l = ph / (NCHUNK * 15), c = (ph / 15) % NCHUNK, s = ph % 15;
        const int e = l >> 1; const bool odd = (l & 1) != 0;
        if (s < 3 && c != 0) continue;
        if (s == 6 && !odd) continue;
        if (s == 8 || s == 12 || s == 10) continue;
        const int S = c < 2 ? 4096 : 2048;
        float* const Xc = X + (size_t)c * TC * 1024;
        const float* const Xin0 = c < 2 ? p.in[0] + (size_t)c * TC * 1024 : p.in[1];
        unsigned char* const AR = ws + WS_ARENA;
        u16* const XN = (u16*)(AR + AR_A); u16* const BUFB = (u16*)(AR + AR_B); u16* const BUFC = (u16*)(AR + AR_C); u16* const Y = (u16*)(AR + AR_D);
        bool do_gemm = false; const u16* gA = nullptr; const u16* gB = nullptr; int gM = TC, gN = 1024, gK = 1024; size_t g_grp = 0; int g_shift = 0, ngemm = 1;
        pg8::EpiAny E{0, nullptr, nullptr, nullptr, nullptr, nullptr, 0, TC, nullptr, nullptr, nullptr};
        unsigned long long* const SSC = (unsigned long long*)(ws + WS_SS); unsigned long long* const SSF = SSC + TC;
        for (int dup = 0; dup < ((s == 5 && odd) ? DUP_SCAN : ((s == DUP_STEP && (DUP_PAR < 0 || (int)odd == DUP_PAR)) ? 2 : DUP_MISC)); ++dup) {
        if (s == 0) {
            const float* mu = p.in[12] + (size_t)e * 6 * 1024;
            u16* const WMIX = (u16*)(ws + WS_WMIX);
            for (int j = 0; j < 22; ++j) {
                const float* src = nullptr; int ld_src = 1024, K = 1024, N = 1024, ld_dst = 1024, col0 = 0, mode = 0; u16* dst = nullptr; const float* s1 = nullptr;
                if (j < 17) {
                    if (!odd) {
                        if (j == 0) { src = p.in[9] + (size_t)e * 1024 * 3072; ld_src = 3072; N = 3072; dst = WMIX; }
                        else if (j == 1) { src = p.in[10] + (size_t)e * 1024 * 1024; dst = WMIX + (size_t)3072 * 1024; }
                        else continue;
                    } else {
                        const int half = j & 1, q = j >> 1;
                        u16* const WL1 = WMIX + (size_t)3072 * 1024;
                        if (q < 3) { if (half) continue; src = p.in[13 + q] + (size_t)e * 1024 * 1024; dst = WMIX + (size_t)q * 1024 * 1024; }
                        else if (q < 5) { const int d = q - 3; src = p.in[18] + ((size_t)e * 2 + d) * 1024 * 64; ld_src = 64; N = 64; dst = WL1 + (size_t)(d * 64) * 2048; ld_dst = 2048; col0 = half * 1024; if (half) s1 = mu + 1 * 1024; }
                        else if (q < 7) { const int d = q - 5; src = p.in[21] + ((size_t)e * 2 + d) * 1024 * 64; ld_src = 64; N = 64; dst = WL1 + (size_t)(128 + d * 64) * 2048; ld_dst = 2048; col0 = half * 1024; if (half) s1 = mu + 4 * 1024; }
                        else if (q == 7) { src = p.in[23] + (size_t)e * 1024 * 128; ld_src = 128; N = 128; dst = WL1 + (size_t)256 * 2048; ld_dst = 2048; col0 = half * 1024; if (half) s1 = mu + 5 * 1024; }
                        else { if (half) continue; src = p.in[16] + (size_t)e * 1024 * 1024; dst = (u16*)(ws + WS_WMIX + WMIX_C); }
                    }
                } else if (j == 17) { src = p.in[30] + (size_t)l * 1024 * 1024; dst = (u16*)(ws + WS_WQ); s1 = p.in[5] + l * 1024; }
                else if (j == 18) { src = p.in[31] + (size_t)l * 1024 * 2048; ld_src = 2048; N = 2048; dst = (u16*)(ws + WS_WKV); }
                else if (j == 19) { src = p.in[32] + (size_t)l * 1024 * 1024; dst = (u16*)(ws + WS_WO); }
                else if (j == 20) { src = p.in[33] + (size_t)l * 1024 * 5632; ld_src = 5632; N = 5632; dst = (u16*)(ws + WS_WGU); mode = 1; s1 = p.in[7] + l * 1024; }
                else { src = p.in[34] + (size_t)l * 2816 * 1024; K = 2816; dst = (u16*)(ws + WS_WDN); ld_dst = 2816; }
                tr_job(lds, src, ld_src, K, N, dst, ld_dst, col0, s1, mode, j * 37);
            }
            if (odd) {
                for (size_t i = (size_t)blockIdx.x * NTHREADS + ltid(); i < (size_t)128 * 2048 / 8; i += gstride) ((u32x4*)(WMIX + (size_t)3072 * 1024 + (size_t)384 * 2048))[i] = (u32x4){0u, 0u, 0u, 0u};
                build_w2comb((u16*)(ws + WS_WMIX + WMIX_B), p.in[19] + (size_t)e * 2 * 64 * 1024, p.in[22] + (size_t)e * 2 * 64 * 1024, p.in[24] + (size_t)e * 128 * 1024);
            }
        }
        if (s == 0) {
            for (int rep = 0; rep < 2; ++rep) norm_rows(p.in[2 + rep], p.in[6] + l * 1024, (u16*)(ws + WS_MN) + (size_t)rep * 2048 * 1024, 1024, 2048);
        }
        else if (s == 1) { do_gemm = true; gA = (u16*)(ws + WS_MN); gB = (u16*)(ws + WS_WKV); gM = 4096; gN = 2048; E.o16 = (u16*)(ws + WS_KV); E.ldc = 2048; }
        else if (s == 3) { do_gemm = true; gB = (u16*)(ws + WS_WMIX);
            if (!odd) { gA = XN; gN = 3072; E.o16 = BUFB; E.ldc = 3072; }
            else { gA = BUFC; gN = 3072; E.o16 = BUFB; E.ldc = 3072; g_grp = (size_t)TC * 1024 * 2; g_shift = 2; ngemm = 2; } }
        else if (s == 4) {
            if (!odd) dil_attn_phase(lds, BUFB, BUFC, (float*)(AR + AR_C + (size_t)3 * TC * 512 * 2), (const float*)(ws + WS_ROPE), S);
            else { do_gemm = true; gA = (u16*)(AR + AR_A + (size_t)TC * 4096); gB = (u16*)(ws + WS_WMIX + WMIX_B); gN = 5120; gK = 384; E.mode = 4; E.o16 = BUFC; E.b0 = p.in[17] + (size_t)e * 2048; E.b1 = p.in[20] + (size_t)e * 2048; }
        }
        else if (s == 5) {
            if (!odd) merge_conv_phase(BUFB, BUFC, (const float*)(AR + AR_C + (size_t)3 * TC * 512 * 2), p.in[11] + (size_t)e * 3 * 512, Y, S);
            else scan_phase(lds, BUFB, BUFC, p.in[25] + (size_t)e * 1024, p.in[26] + (size_t)e * 1024, p.in[27] + (size_t)e * 1024, (u16*)(AR + AR_A), (float*)(AR + AR_A + (size_t)TC * 4096), S);
        }
        else if (s == 6) rwkv_post_phase((const u16*)(AR + AR_A), (const float*)(AR + AR_A + (size_t)TC * 4096), BUFB, BUFC, p.in[28] + (size_t)e * 1024, p.in[29] + (size_t)e * 1024, Y);
        else if (s == 7) { do_gemm = true; gA = Y; gB = odd ? (u16*)(ws + WS_WMIX + WMIX_C) : (u16*)(ws + WS_WMIX) + (size_t)3072 * 1024; E.mode = 1; E.x = Xc; E.xin = (l == 0) ? Xin0 : Xc; E.o16 = XN; E.ssw = SSC; }
        else if (s == 9) { do_gemm = true; gA = XN; gB = (u16*)(ws + WS_WQ); E.o16 = BUFB; E.ldc = 1024; E.ssr = SSC; }
        else if (s == 11) { do_gemm = true; gA = BUFC; gB = (u16*)(ws + WS_WO); E.mode = 1; E.x = Xc; E.xin = Xc; E.o16 = XN; E.ssw = SSF; }
        else if (s == 13) { do_gemm = true; gA = XN; gB = (u16*)(ws + WS_WGU); gN = 5632; E.mode = 2; E.o16 = BUFB; E.ssr = SSF; }
        else if (s == 14) { do_gemm = true; gA = BUFB; gB = (u16*)(ws + WS_WDN); gK = 2816; E.mode = 1; E.x = Xc; E.xin = Xc; }
        }
        if (do_gemm) {
            for (int gi = 0; gi < ngemm; ++gi) {
                if (gi == 1) { gA = XN; gB = (u16*)(ws + WS_WMIX) + (size_t)3072 * 1024; gN = 512; gK = 2048; g_grp = 0; g_shift = 0; E.mode = 3; E.o16 = (u16*)(AR + AR_A + (size_t)TC * 4096); }
                pg8::Gemm g{gA, gB, gM, gN, gK, g_grp, g_shift}; pg8::StaticOrder SO; SO.init(gM, gN, (int)gridDim.x, (int)blockIdx.x);
                pg8::gemm_phase<pg8::EpiAny, pg8::StaticOrder, false>(lds, g, SO, E, nullptr);
            }
        }
        if (s == 9) {
            pg8::StaticOrder SO2; SO2.init(TC, 1024, (int)gridDim.x, (int)blockIdx.x); pg8::Unit u;
            for (int it = 0; SO2.next(it >> 1, u); ++it) { const int t0 = u.pm * 256, seq = t0 / S, qt = ((t0 % S) >> 7) + (it & 1);
                cross_attn_unit(lds, BUFB, (const u16*)(ws + WS_KV), c < 2 ? c * 1024 : 2048, BUFC, S, seq, u.pn, qt); }
        }
        {
            const int nc = (s == 2 && c == 0) ? 0 : ((s == 14 && c < 2) ? c + 1 : -1);
            if (nc >= 0) {
                const int Sn = nc < 2 ? 4096 : 2048;
                const float* xs = (l == 0) ? (nc < 2 ? p.in[0] + (size_t)nc * TC * 1024 : p.in[1]) : X + (size_t)nc * TC * 1024;
                for (size_t i = (size_t)blockIdx.x * NTHREADS + ltid(); i < (size_t)2 * TC; i += gstride) SSC[i] = 0ull;
                if (odd) norm_shift(xs, p.in[4] + l * 1024, p.in[12] + (size_t)e * 6 * 1024, XN, BUFC, Sn);
                else norm_rows(xs, p.in[4] + l * 1024, XN, 1024, TC);
            }
        }
        if (s == 1) continue;
        for (int dup = 0; dup < DUP_SYNC; ++dup) xcd_barrier(xbar);
    }
    norm_final(X, p.in[8], 49152);
}

extern "C" void kernel_launch(void* const* d_in, const int* in_sizes, int n_in, void* d_out, int out_size, void* d_ws, size_t ws_size, hipStream_t stream) {
    static int grid_blocks = 0;
    if (!grid_blocks) {
        int dev = 0, cus = 0, per_cu = 0;
        if (n_in != 35 || out_size != 49152 * 1024 || ws_size < WS_END) { fprintf(stderr, "kernel_launch: unexpected problem (n_in %d out %d ws %zu need %zu)\n", n_in, out_size, ws_size, (size_t)WS_END); grid_blocks = -1; return; }
        (void)hipGetDevice(&dev);
        (void)hipDeviceGetAttribute(&cus, hipDeviceAttributeMultiprocessorCount, dev);
        (void)hipFuncSetAttribute((const void*)mega, hipFuncAttributeMaxDynamicSharedMemorySize, LDS_BYTES);
        (void)hipOccupancyMaxActiveBlocksPerMultiprocessor(&per_cu, (const void*)mega, NTHREADS, LDS_BYTES);
        if (per_cu < 1) { fprintf(stderr, "kernel_launch: occupancy query says %d blocks per CU\n", per_cu); }
        grid_blocks = cus > 0 ? cus : 256;
    }
    if (grid_blocks < 0) return;
    Params p{};
    for (int i = 0; i < 35; ++i) p.in[i] = (const float*)d_in[i];
    p.out = (float*)d_out; p.ws = (unsigned char*)d_ws;
    void* args[] = {&p};
    hipError_t err = hipLaunchCooperativeKernel((void*)mega, dim3(grid_blocks), dim3(NTHREADS), args, LDS_BYTES, stream);
    if (err != hipSuccess) fprintf(stderr, "cooperative launch failed: %s (grid %d)\n", hipGetErrorString(err), grid_blocks);
}
```

```cpp
#include <hip/hip_runtime.h>
#include <hip/hip_cooperative_groups.h>
#include <cstdio>
namespace cg = cooperative_groups;

#define LAS __attribute__((address_space(3)))
typedef unsigned short u16;
typedef short bf16x8 __attribute__((ext_vector_type(8)));
typedef float f32x4 __attribute__((ext_vector_type(4)));
typedef float f32x2 __attribute__((ext_vector_type(2)));
typedef unsigned u32x4 __attribute__((ext_vector_type(4)));
typedef unsigned u32x2 __attribute__((ext_vector_type(2)));

constexpr int DM = 1024;
constexpr int TC = 16384;
constexpr int NCHUNK = 3;
constexpr int NTHREADS = 512;
constexpr int LDS_BYTES = 139264;

__device__ __forceinline__ unsigned cvt_pk_bf16(float lo, float hi) { unsigned r; asm volatile("v_cvt_pk_bf16_f32 %0, %1, %2" : "=v"(r) : "v"(lo), "v"(hi)); return r; }
__device__ __forceinline__ u16 f2bf(float x) { return (u16)(cvt_pk_bf16(x, 0.f) & 0xffffu); }
__device__ __forceinline__ float bf2f(u16 b) { return __uint_as_float(((unsigned)b) << 16); }
__device__ __forceinline__ float bflo(unsigned w) { return __uint_as_float(w << 16); }
__device__ __forceinline__ float bfhi(unsigned w) { return __uint_as_float(w & 0xffff0000u); }
__device__ __forceinline__ float sigmoidf_(float x) { return 1.0f / (1.0f + __expf(-x)); }
__device__ __forceinline__ float wave_sum(float v) {
#pragma unroll
    for (int o = 32; o >= 1; o >>= 1) v += __shfl_xor(v, o);
    return v;
}
constexpr int WVMAP_OFF = LDS_BYTES - 16 - 256;
__device__ __forceinline__ unsigned hw_slot() { return (unsigned)__builtin_amdgcn_s_getreg((5 << 11) | 4) & 63u; }
__device__ __forceinline__ int ltid() {
    extern __shared__ __attribute__((aligned(16))) unsigned char lds_dyn_[];
    const int wv = __builtin_amdgcn_readfirstlane(*(const volatile LAS int*)((LAS unsigned char*)lds_dyn_ + WVMAP_OFF + hw_slot() * 4));
    int lane; asm volatile("v_mbcnt_lo_u32_b32 %0, -1, 0\n\tv_mbcnt_hi_u32_b32 %0, -1, %0" : "=v"(lane));
    return (wv << 6) | lane;
}
__device__ __forceinline__ void ltid_setup() {
    extern __shared__ __attribute__((aligned(16))) unsigned char lds_dyn_[];
    if ((threadIdx.x & 63) == 0) *(volatile LAS int*)((LAS unsigned char*)lds_dyn_ + WVMAP_OFF + hw_slot() * 4) = (int)(threadIdx.x >> 6);
    __syncthreads();
}
#define XB_TMO      128
#define XB_XCNT(j)  (256  + 64 * (j))
#define XB_XSUB(j)  (1280 + 64 * (j))
#define XB_XGEN(j)  (2304 + 64 * (j))
#define XB_TOP      3328
#define XB_TOPGEN   3392
#define XCD_BAR_WORDS 3456
#define XB_SPIN_CAP (1u << 18)

__device__ __forceinline__ unsigned xb_ld(unsigned* p)              { return __hip_atomic_load(p, __ATOMIC_RELAXED, __HIP_MEMORY_SCOPE_AGENT); }
__device__ __forceinline__ unsigned xb_add(unsigned* p, unsigned v) { return __hip_atomic_fetch_add(p, v, __ATOMIC_RELAXED, __HIP_MEMORY_SCOPE_AGENT); }
__device__ __forceinline__ unsigned xb_xcc_id() { return (unsigned)__builtin_amdgcn_s_getreg((3 << 11) | 20) & 0xFu; }
#define XB_SPIN(cond, bar) do { unsigned _sp = 0; while (cond) { __builtin_amdgcn_s_sleep(1); \
    if ((++_sp & 255u) == 0u) { if (xb_ld(&(bar)[XB_TMO])) break; if (_sp > XB_SPIN_CAP) { atomicAdd(&(bar)[XB_TMO], 1u); break; } } } } while (0)

struct XcdBarrier {
    unsigned* bar; unsigned x;
    volatile LAS unsigned* st;
};

__device__ __forceinline__ XcdBarrier xcd_barrier_post(unsigned* bar, volatile LAS unsigned* st) {
    XcdBarrier b; b.bar = bar; b.x = xb_xcc_id(); b.st = st;
    if (ltid() == 0) (void)xb_add(&bar[XB_XCNT(b.x)], 1u);
    return b;
}
__device__ __forceinline__ void xcd_barrier_complete(unsigned* bar, unsigned x, unsigned& nloc, unsigned& nx) {
    const unsigned G = gridDim.x * gridDim.y * gridDim.z;
    unsigned sum, cnt, mine, sp = 0u;
    for (;;) {
        sum = 0u; cnt = 0u; mine = 0u;
#pragma unroll
        for (unsigned j = 0; j < 16; ++j) { const unsigned c = xb_ld(&bar[XB_XCNT(j)]); sum += c; cnt += (c > 0u) ? 1u : 0u; mine = (j == x) ? c : mine; }
        if (sum == G) break;
        __builtin_amdgcn_s_sleep(1);
        if ((++sp & 255u) == 0u) { if (xb_ld(&bar[XB_TMO])) break; if (sp > XB_SPIN_CAP) { atomicAdd(&bar[XB_TMO], 1u); break; } }
    }
    nloc = mine > 0u ? mine : 1u; nx = cnt > 0u ? cnt : 1u;
}

__device__ __forceinline__ void xcd_barrier(const XcdBarrier& b) {
    asm volatile("s_waitcnt vmcnt(0)" ::: "memory");
    __syncthreads();
    if (ltid() == 0) {
        unsigned* bar = b.bar;
        __builtin_amdgcn_s_waitcnt(0);
        unsigned nloc = b.st[0], nx = b.st[1];
        if (nloc == 0u) { xcd_barrier_complete(bar, b.x, nloc, nx); b.st[0] = nloc; b.st[1] = nx; }
        const unsigned old = xb_add(&bar[XB_XSUB(b.x)], 1u);
        const unsigned gen = old / nloc;
        if (old + 1u == (gen + 1u) * nloc) {
            __builtin_amdgcn_fence(__ATOMIC_RELEASE, "agent");
            asm volatile("s_waitcnt vmcnt(0)" ::: "memory");
            const unsigned og = xb_add(&bar[XB_TOP], 1u);
            const unsigned tg = og / nx;
            if (og + 1u == (tg + 1u) * nx) xb_add(&bar[XB_TOPGEN], 1u);
            else XB_SPIN(xb_ld(&bar[XB_TOPGEN]) == tg, bar);
            __builtin_amdgcn_fence(__ATOMIC_ACQUIRE, "agent");
            xb_add(&bar[XB_XGEN(b.x)], 1u);
            asm volatile("s_waitcnt vmcnt(0)" ::: "memory");
        } else {
            XB_SPIN(xb_ld(&bar[XB_XGEN(b.x)]) == gen, bar);
            __builtin_amdgcn_fence(__ATOMIC_ACQUIRE, "agent");
            asm volatile("s_waitcnt vmcnt(0)" ::: "memory");
        }
    }
    __syncthreads();
}
namespace pg8 {
#define PG8_LAS __attribute__((address_space(3)))
typedef unsigned short bf16_t;
typedef short bf16x8 __attribute__((ext_vector_type(8)));
typedef float f32x4 __attribute__((ext_vector_type(4)));
typedef unsigned u32x4 __attribute__((ext_vector_type(4)));
constexpr int BM = 256, BK = 64, HALF = 128, HTB = HALF * BK * 2  , STAGE_BYTES = 8 * HTB, NXCD = 8, WGM = 8;

__host__ __device__ __forceinline__ int lds_byte(int r, int c) { const int st = (r >> 4) * 2 + (c >> 5), rr = r & 15, cc = c & 31, ob = rr * 64 + cc * 2; return st * 1024 + (ob ^ (((ob >> 9) & 1) << 5)); }
__host__ __device__ __forceinline__ void stage_rc(int b, int& R, int& C) { const int st = b / 1024, sb = b % 1024, swz = sb ^ (((sb >> 9) & 1) << 5); R = (st >> 1) * 16 + swz / 64; C = (st & 1) * 32 + (swz % 64) / 2; }
__host__ __device__ __forceinline__ int perm32(int rho) { const int n = rho >> 4, i = rho & 15; return 8 * (i >> 2) + 4 * n + (i & 3); }

struct Unit { int pm, pn; };
struct Gemm { const bf16_t* A; const bf16_t* Bt; int M, N, K; size_t a_grp_bytes; int a_grp_shift; };

struct StaticOrder {
    int nM, nN, nwg, G, c;
    __host__ __device__ __forceinline__ void init(int M, int N, int G_, int c_) { nM = M / BM; nN = N / BM; nwg = nM * nN; G = G_; c = c_; }
    __host__ __device__ __forceinline__ bool next(int i, Unit& u) const {
        const long L = (long)i * G + c; if (L >= nwg) return false;
        int wgid = (int)L; { const int q = nwg / NXCD, r = nwg % NXCD, xcd = wgid % NXCD, off = wgid / NXCD; wgid = (xcd < r ? xcd * (q + 1) : r * (q + 1) + (xcd - r) * q) + off; }
        const int nig = WGM * nN, gid = wgid / nig, fm = gid * WGM, gsz = (nM - fm) < WGM ? (nM - fm) : WGM;
        u.pm = fm + ((wgid % nig) % gsz); u.pn = (wgid % nig) / gsz; return true;
    }
    __device__ __forceinline__ void a_ready(const Unit&) const {}
    __device__ __forceinline__ void done(const Unit&) const {}
};
struct EpiStore16 {
    static constexpr bool PERM = true, AFTER_DRAIN = false;
    u16* O; int ldc; const unsigned long long* SS;
    __device__ __forceinline__ void operator()(const f32x4 (&acc)[2][2][4][2], const Unit& u, int wr, int wc, int fr, int fq) const {
        const int row0 = u.pm * BM + wr * 64 + fr, col0 = u.pn * BM + wc * 32 + 8 * fq;
#pragma unroll
        for (int ai = 0; ai < 2; ++ai)
#pragma unroll
            for (int m = 0; m < 4; ++m) { const int row = row0 + ai * HALF + m * 16; u16* rowp = O + (size_t)row * ldc + col0;
                const float rs = SS ? rsqrtf((float)SS[row] * (1.0f / (1024.0f * 1048576.0f)) + 1e-6f) : 1.0f;
#pragma unroll
                for (int bj = 0; bj < 2; ++bj) { const f32x4 v0 = acc[ai][bj][m][0] * rs, v1 = acc[ai][bj][m][1] * rs; u32x4 w; w.x = cvt_pk_bf16(v0[0], v0[1]); w.y = cvt_pk_bf16(v0[2], v0[3]); w.z = cvt_pk_bf16(v1[0], v1[1]); w.w = cvt_pk_bf16(v1[2], v1[3]);
                    *(u32x4*)(rowp + bj * HALF) = w; } }
    }
};
struct EpiResid {
    static constexpr bool PERM = true, AFTER_DRAIN = false;
    u16* Xb; const float* Xin32; unsigned long long* SS;
    __device__ __forceinline__ void operator()(const f32x4 (&acc)[2][2][4][2], const Unit& u, int wr, int wc, int fr, int fq) const {
        const int row0 = u.pm * BM + wr * 64 + fr, col0 = u.pn * BM + wc * 32 + 8 * fq;
#pragma unroll
        for (int ai = 0; ai < 2; ++ai)
#pragma unroll
            for (int m = 0; m < 4; ++m) { const int row = row0 + ai * HALF + m * 16; const unsigned off = (unsigned)(row * 1024 + col0); float ss = 0.f;
#pragma unroll
                for (int bj = 0; bj < 2; ++bj) { const unsigned o = off + bj * HALF; f32x4 x0, x1;
                    if (Xin32) { x0 = *(const f32x4*)(Xin32 + o); x1 = *(const f32x4*)(Xin32 + o + 4); }
                    else { const u32x4 h = *(const u32x4*)(Xb + o); x0 = (f32x4){bflo(h.x), bfhi(h.x), bflo(h.y), bfhi(h.y)}; x1 = (f32x4){bflo(h.z), bfhi(h.z), bflo(h.w), bfhi(h.w)}; }
                    const f32x4 v0 = x0 + acc[ai][bj][m][0], v1 = x1 + acc[ai][bj][m][1];
                    u32x4 w; w.x = cvt_pk_bf16(v0[0], v0[1]); w.y = cvt_pk_bf16(v0[2], v0[3]); w.z = cvt_pk_bf16(v1[0], v1[1]); w.w = cvt_pk_bf16(v1[2], v1[3]);
                    *(u32x4*)(Xb + o) = w;
                    if (SS) ss += (v0[0] * v0[0] + v0[1] * v0[1]) + (v0[2] * v0[2] + v0[3] * v0[3]) + (v1[0] * v1[0] + v1[1] * v1[1]) + (v1[2] * v1[2] + v1[3] * v1[3]); }
                if (SS) { ss += __shfl_xor(ss, 16); ss += __shfl_xor(ss, 32); if (fq == 0) atomicAdd(SS + row, (unsigned long long)(ss * 1048576.0f)); } }
    }
};
struct EpiSwiglu {
    static constexpr bool PERM = true, AFTER_DRAIN = false;
    u16* H; const unsigned long long* SS;
    __device__ __forceinline__ void operator()(const f32x4 (&acc)[2][2][4][2], const Unit& u, int wr, int wc, int fr, int fq) const {
        const int row0 = u.pm * BM + wr * 64 + fr, col0 = u.pn * 128 + wc * 16 + 4 * fq;
#pragma unroll
        for (int ai = 0; ai < 2; ++ai)
#pragma unroll
            for (int m = 0; m < 4; ++m) { const int row = row0 + ai * HALF + m * 16; u16* rowp = H + (size_t)row * 2816 + col0;
                const float rs = rsqrtf((float)SS[row] * (1.0f / (1024.0f * 1048576.0f)) + 1e-6f);
#pragma unroll
                for (int bj = 0; bj < 2; ++bj) { const f32x4 g = acc[ai][bj][m][0] * rs, up = acc[ai][bj][m][1] * rs; float h[4];
#pragma unroll
                    for (int j = 0; j < 4; ++j) h[j] = g[j] / (1.0f + __expf(-g[j])) * up[j];
                    u32x2 w; w.x = cvt_pk_bf16(h[0], h[1]); w.y = cvt_pk_bf16(h[2], h[3]); *(u32x2*)(rowp + bj * 64) = w; } }
    }
};
struct EpiRwkv {
    static constexpr bool PERM = true, AFTER_DRAIN = false;
    u16* L1;
    __device__ __forceinline__ void operator()(const f32x4 (&acc)[2][2][4][2], const Unit& u, int wr, int wc, int fr, int fq) const {
        const int row0 = u.pm * BM + wr * 64 + fr;
        const int col0 = u.pn * BM + wc * 32 + 8 * fq; const int t = u.pn;
#pragma unroll
        for (int ai = 0; ai < 2; ++ai)
#pragma unroll
            for (int m = 0; m < 4; ++m) { u16* rowp = L1 + (size_t)(row0 + ai * HALF + m * 16) * 384 + col0;
#pragma unroll
                for (int bj = 0; bj < 2; ++bj) if (!(t == 1 && bj == 1)) {
#pragma unroll
                    for (int n = 0; n < 2; ++n) { f32x4 v = acc[ai][bj][m][n];
#pragma unroll
                        for (int j = 0; j < 4; ++j) { float x = v[j]; if (t == 1) x = sigmoidf_(x); else if (bj == 0) x = tanhf(x); v[j] = x; }
                        u32x2 w; w.x = cvt_pk_bf16(v[0], v[1]); w.y = cvt_pk_bf16(v[2], v[3]); *(u32x2*)(rowp + bj * HALF + n * 4) = w; } } }
    }
};
struct EpiLora2 {
    static constexpr bool PERM = true, AFTER_DRAIN = false;
    u16* EAG; const float* w0; const float* a0; int M;
    __device__ __forceinline__ void operator()(const f32x4 (&acc)[2][2][4][2], const Unit& u, int wr, int wc, int fr, int fq) const {
        const int row0 = u.pm * BM + wr * 64 + fr; const int sel = u.pn >> 2; const int col0 = (u.pn & 3) * BM + wc * 32 + 8 * fq;
        u16* base = EAG + (size_t)sel * M * 1024;
        const float* bias = sel < 2 ? (w0 + sel * 1024) : (a0 + ((sel - 2) & 1) * 1024);
        f32x4 bv[2][2];
#pragma unroll
        for (int bj = 0; bj < 2; ++bj)
#pragma unroll
            for (int n = 0; n < 2; ++n) bv[bj][n] = (sel < 4) ? *(const f32x4*)(bias + col0 + bj * HALF + n * 4) : (f32x4){0.f, 0.f, 0.f, 0.f};
#pragma unroll
        for (int ai = 0; ai < 2; ++ai)
#pragma unroll
            for (int m = 0; m < 4; ++m) { u16* rowp = base + (size_t)(row0 + ai * HALF + m * 16) * 1024 + col0;
#pragma unroll
                for (int bj = 0; bj < 2; ++bj)
#pragma unroll
                    for (int n = 0; n < 2; ++n) { const f32x4 v = acc[ai][bj][m][n] + bv[bj][n]; u32x2 w;
                        if (sel < 2) { _Float16 h[4];
#pragma unroll
                            for (int j = 0; j < 4; ++j) h[j] = (_Float16)(0.60653066f * sigmoidf_(v[j]));
                            w.x = (unsigned)__builtin_bit_cast(u16, h[0]) | ((unsigned)__builtin_bit_cast(u16, h[1]) << 16);
                            w.y = (unsigned)__builtin_bit_cast(u16, h[2]) | ((unsigned)__builtin_bit_cast(u16, h[3]) << 16);
                        } else if (sel < 4) { w.x = cvt_pk_bf16(sigmoidf_(v[0]), sigmoidf_(v[1])); w.y = cvt_pk_bf16(sigmoidf_(v[2]), sigmoidf_(v[3]));
                        } else { w.x = cvt_pk_bf16(v[0], v[1]); w.y = cvt_pk_bf16(v[2], v[3]); }
                        *(u32x2*)(rowp + bj * HALF + n * 4) = w; } }
    }
};
template <class Epi, class Sched, bool STAMP = false>
__device__ __forceinline__ void gemm_phase(PG8_LAS unsigned char* lds, const Gemm g, const Sched& S, const Epi& E, unsigned long long* stamps) {
    const int tid = ltid(), wid = __builtin_amdgcn_readfirstlane(tid >> 6), lane = tid & 63, wr = wid >> 2, wc = wid & 3, fr = lane & 15, fq = lane >> 4;
    const int K = g.K, nt = K / BK;
    int ts_lo = 0, ts_hi = 0, nts = 0; const unsigned long long rt_entry = STAMP ? (unsigned long long)wall_clock64() : 0ull;
#define PG8_STAMP() do { if (STAMP && wid == 0 && nts < 64) { const unsigned long long _c = (unsigned long long)clock64(); \
        ts_lo = (lane == nts) ? (int)(unsigned)_c : ts_lo; ts_hi = (lane == nts) ? (int)(unsigned)(_c >> 32) : ts_hi; ++nts; } } while (0)
    PG8_STAMP();
    unsigned voffA[2], voffB[2];
#pragma unroll
    for (int i = 0; i < 2; ++i) { int R, C; stage_rc(tid * 16 + i * 8192, R, C); const int Rb = Epi::PERM ? ((R & ~31) + perm32(R & 31)) : R;
        voffA[i] = (unsigned)(R * K + C) * 2u; voffB[i] = (unsigned)(Rb * K + C) * 2u; }
    const size_t kstep = (size_t)(BK * 2);
    const size_t hstep = (size_t)HALF * K * 2;
    const size_t tstep = 2 * hstep;
    const unsigned ldsw = (unsigned)wid * 1024u;
    const int aoff = lds_byte(wr * 64 + fr, fq * 8), boff = lds_byte(wc * 32 + fr, fq * 8);
#define PG8_SA(b, h) (((b) * 2 + (h)) * HTB)
#define PG8_SB(b, h) ((4 + (b) * 2 + (h)) * HTB)
#define PG8_STAGE(bufoff, gbase, voff) do { _Pragma("unroll") for (int _i = 0; _i < 2; ++_i) \
        __builtin_amdgcn_global_load_lds((const unsigned*)((const char*)(gbase) + (voff)[_i]), (PG8_LAS unsigned*)(lds + (bufoff) + ldsw + _i * 8192), 16, 0, 0); } while (0)
#define PG8_LDA(dst, b, h) do { _Pragma("unroll") for (int m = 0; m < 4; ++m) _Pragma("unroll") for (int k = 0; k < 2; ++k) dst[m][k] = *(const PG8_LAS bf16x8*)(lds + PG8_SA(b, h) + aoff + m * 2048 + k * 1024); } while (0)
#define PG8_LDB(dst, b, h) do { _Pragma("unroll") for (int n = 0; n < 2; ++n) _Pragma("unroll") for (int k = 0; k < 2; ++k) dst[n][k] = *(const PG8_LAS bf16x8*)(lds + PG8_SB(b, h) + boff + n * 2048 + k * 1024); } while (0)
#define PG8_MMA(ai, bj, At, Bt) do { __builtin_amdgcn_s_setprio(1); _Pragma("unroll") for (int m = 0; m < 4; ++m) _Pragma("unroll") for (int n = 0; n < 2; ++n) _Pragma("unroll") for (int k = 0; k < 2; ++k) \
        acc[ai][bj][m][n] = __builtin_amdgcn_mfma_f32_16x16x32_bf16(Bt[n][k], At[m][k], acc[ai][bj][m][n], 0, 0, 0); __builtin_amdgcn_s_setprio(0); } while (0)
#define PG8_WAIT_V(n) asm volatile("s_waitcnt vmcnt(" #n ")" ::: "memory")
#define PG8_WAIT_L(n) asm volatile("s_waitcnt lgkmcnt(" #n ")" ::: "memory")
#define PG8_BAR __builtin_amdgcn_s_barrier()
#define PG8_SCHED __builtin_amdgcn_sched_barrier(0)
    Unit cur, nxt; int ui = 0;
    if (!S.next(0, cur)) return;
    f32x4 acc[2][2][4][2];
#pragma unroll
    for (int a = 0; a < 2; ++a)
#pragma unroll
        for (int b = 0; b < 2; ++b)
#pragma unroll
            for (int m = 0; m < 4; ++m)
#pragma unroll
                for (int n = 0; n < 2; ++n) acc[a][b][m][n] = (f32x4){0.f, 0.f, 0.f, 0.f};
    bf16x8 At[4][2], B0[2][2], B1[2][2];
    const char* cA = (const char*)g.A + (size_t)cur.pm * tstep + (size_t)(cur.pn >> g.a_grp_shift) * g.a_grp_bytes; const char* cB = (const char*)g.Bt + (size_t)cur.pn * tstep;
    S.a_ready(cur);
    PG8_STAGE(PG8_SB(0, 0), cB, voffB); PG8_STAGE(PG8_SA(0, 0), cA, voffA); PG8_STAGE(PG8_SB(0, 1), cB + hstep, voffB); PG8_STAGE(PG8_SA(0, 1), cA + hstep, voffA);
    if (wr == 1) PG8_BAR;
    PG8_WAIT_V(4); PG8_BAR;
    PG8_STAGE(PG8_SB(1, 0), cB + kstep, voffB); PG8_STAGE(PG8_SA(1, 0), cA + kstep, voffA); PG8_STAGE(PG8_SB(1, 1), cB + hstep + kstep, voffB);
    PG8_WAIT_V(6); PG8_BAR;
    PG8_STAMP();
    for (;;) {
        const bool has_next = S.next(ui + 1, nxt);
        const char* nA = has_next ? (const char*)g.A + (size_t)nxt.pm * tstep + (size_t)(nxt.pn >> g.a_grp_shift) * g.a_grp_bytes : cA; const char* nB = has_next ? (const char*)g.Bt + (size_t)nxt.pn * tstep : cB;
        for (int t = 0; t < nt; t += 2) {
            const bool last = (t == nt - 2);
            const char* a1 = cA + (size_t)(t + 1) * kstep;
            const char* a2 = last ? nA : cA + (size_t)(t + 2) * kstep; const char* b2 = last ? nB : cB + (size_t)(t + 2) * kstep;
            const char* a3 = a2 + kstep; const char* b3 = b2 + kstep;
            if (last && has_next) S.a_ready(nxt);
            PG8_LDB(B0, 0, 0); PG8_SCHED; PG8_LDA(At, 0, 0); PG8_STAGE(PG8_SA(1, 1), a1 + hstep, voffA);
            PG8_WAIT_L(8); PG8_BAR; PG8_WAIT_L(0); PG8_MMA(0, 0, At, B0); PG8_BAR; PG8_SCHED;
            PG8_LDB(B1, 0, 1); PG8_STAGE(PG8_SB(0, 0), b2, voffB);
            PG8_BAR; PG8_WAIT_L(0); PG8_MMA(0, 1, At, B1); PG8_BAR;
            PG8_LDA(At, 0, 1); PG8_STAGE(PG8_SA(0, 0), a2, voffA);
            PG8_BAR; PG8_WAIT_L(0); PG8_MMA(1, 0, At, B0); PG8_BAR; PG8_SCHED;
            PG8_STAGE(PG8_SB(0, 1), b2 + hstep, voffB);
            PG8_WAIT_V(6); PG8_BAR; PG8_MMA(1, 1, At, B1); PG8_BAR;
            PG8_LDB(B0, 1, 0); PG8_SCHED; PG8_LDA(At, 1, 0); PG8_STAGE(PG8_SA(0, 1), a2 + hstep, voffA);
            PG8_WAIT_L(8); PG8_BAR; PG8_WAIT_L(0); PG8_MMA(0, 0, At, B0); PG8_BAR; PG8_SCHED;
            PG8_LDB(B1, 1, 1); PG8_STAGE(PG8_SB(1, 0), b3, voffB);
            PG8_BAR; PG8_WAIT_L(0); PG8_MMA(0, 1, At, B1); PG8_BAR;
            PG8_LDA(At, 1, 1); PG8_STAGE(PG8_SA(1, 0), a3, voffA);
            PG8_BAR; PG8_WAIT_L(0); PG8_MMA(1, 0, At, B0); PG8_BAR; PG8_SCHED;
            PG8_STAGE(PG8_SB(1, 1), b3 + hstep, voffB);
            PG8_WAIT_V(6); PG8_BAR; PG8_MMA(1, 1, At, B1); PG8_BAR;
        }
        PG8_STAMP();
        if constexpr (!Epi::AFTER_DRAIN) { E(acc, cur, wr, wc, fr, fq); S.done(cur); }
        PG8_STAMP();
        if (!has_next) break;
#pragma unroll
        for (int a = 0; a < 2; ++a)
#pragma unroll
            for (int b = 0; b < 2; ++b)
#pragma unroll
                for (int m = 0; m < 4; ++m)
#pragma unroll
                    for (int n = 0; n < 2; ++n) acc[a][b][m][n] = (f32x4){0.f, 0.f, 0.f, 0.f};
        cur = nxt; cA = nA; cB = nB; ++ui;
    }
    PG8_WAIT_V(0);
    if (wr == 0) PG8_BAR;
    PG8_BAR;
    if constexpr (Epi::AFTER_DRAIN) { E.fused(acc, cur, wr, wc, fr, fq, lds, wid, lane); S.done(cur); }
    PG8_STAMP();
    if (STAMP && wid == 0) { stamps[lane] = lane < nts ? (((unsigned long long)(unsigned)ts_hi << 32) | (unsigned)ts_lo) : 0ull;
        if (lane == 62) stamps[62] = rt_entry; if (lane == 63) stamps[63] = (unsigned long long)wall_clock64(); }
#undef PG8_STAMP
#undef PG8_SA
#undef PG8_SB
#undef PG8_STAGE
#undef PG8_LDA
#undef PG8_LDB
#undef PG8_MMA
#undef PG8_WAIT_V
#undef PG8_WAIT_L
#undef PG8_BAR
#undef PG8_SCHED
}
}
struct Params { const float* in[35]; float* out; unsigned char* ws; int pad0, pad1; };

constexpr size_t MB = 1u << 20;
constexpr size_t WS_WMIX  = 0;
constexpr size_t WMIX_B   = (size_t)3584 * 2048 * 2;
constexpr size_t WMIX_C   = WMIX_B + (size_t)5120 * 512 * 2;
constexpr size_t WS_WQ    = WS_WMIX + WMIX_C + (size_t)1024 * 1024 * 2;
constexpr size_t WS_WKV   = WS_WQ + (size_t)1024 * 1024 * 2;
constexpr size_t WS_WO    = WS_WKV + (size_t)2048 * 1024 * 2;
constexpr size_t WS_WGU   = WS_WO + (size_t)1024 * 1024 * 2;
constexpr size_t WS_WDN   = WS_WGU + (size_t)5632 * 1024 * 2;
constexpr size_t WS_MN    = WS_WDN + (size_t)1024 * 2816 * 2;
constexpr size_t WS_KV    = WS_MN + (size_t)4096 * 1024 * 2;
constexpr size_t WS_ROPE  = WS_KV + (size_t)4096 * 2048 * 2;
constexpr size_t WS_ARENA = WS_ROPE + (size_t)4096 * 16 * 4;
constexpr size_t AR_A = 0, AR_B = (size_t)TC * 8192, AR_C = (size_t)TC * 14336, AR_D = (size_t)TC * 24576, AR_END = (size_t)TC * 26624;
constexpr size_t WS_BAR = WS_ARENA + AR_END;
constexpr size_t WS_SS = WS_BAR + 16384;
constexpr size_t WS_END = WS_SS + (size_t)2 * TC * 8;

__device__ __forceinline__ int map_row(int n, int mode) {
    if (mode == 0) return n;
    const int up = n >= 2816, c = up ? n - 2816 : n;
    return (c >> 4) * 32 + ((c & 15) >> 2) * 8 + up * 4 + (c & 3);
}
__device__ __forceinline__ void tr_job(LAS unsigned char* lds, const float* __restrict__ src, int ld_src, int K, int N, u16* dst, int ld_dst, int col0, const float* __restrict__ s1, int mode, int rot) {
    LAS float* T = (LAS float*)lds;
    const int tid = ltid(), nkt = K >> 6, nnt = N >> 6, ntile = nkt * nnt;
    for (int t = (blockIdx.x + rot) % gridDim.x; t < ntile; t += gridDim.x) {
        const int kt = t / nnt, nt = t % nnt;
#pragma unroll
        for (int it = 0; it < 2; ++it) {
            const int kk = (tid >> 4) + it * 32, n4 = (tid & 15) * 4;
            f32x4 v = *(const f32x4*)(src + (size_t)(kt * 64 + kk) * ld_src + nt * 64 + n4);
            const float s = s1 ? s1[kt * 64 + kk] : 1.0f;
#pragma unroll
            for (int e = 0; e < 4; ++e) T[(n4 + e) * 65 + kk] = v[e] * s;
        }
        __syncthreads();
        {
            const int n = tid >> 3, k8 = (tid & 7) * 8; float f[8];
#pragma unroll
            for (int e = 0; e < 8; ++e) f[e] = T[n * 65 + k8 + e];
            u32x4 w; w.x = cvt_pk_bf16(f[0], f[1]); w.y = cvt_pk_bf16(f[2], f[3]); w.z = cvt_pk_bf16(f[4], f[5]); w.w = cvt_pk_bf16(f[6], f[7]);
            *(u32x4*)(dst + (size_t)map_row(nt * 64 + n, mode) * ld_dst + col0 + kt * 64 + k8) = w;
        }
        __syncthreads();
    }
}

__device__ __forceinline__ void norm_rows(const float* __restrict__ X, const u16* __restrict__ Xh, const float* __restrict__ g, u16* dst, int ld_dst, int nrows) {
    const int lane = ltid() & 63, gw = blockIdx.x * 8 + (ltid() >> 6), nw = gridDim.x * 8;
    f32x4 gv[4];
#pragma unroll
    for (int i = 0; i < 4; ++i) gv[i] = *(const f32x4*)(g + i * 256 + lane * 4);
    for (int r = gw; r < nrows; r += nw) {
        f32x4 v[4]; float ss = 0.f;
#pragma unroll
        for (int i = 0; i < 4; ++i) {
            if (Xh) { const u32x2 h = *(const u32x2*)(Xh + (size_t)r * 1024 + i * 256 + lane * 4); v[i] = (f32x4){bflo(h.x), bfhi(h.x), bflo(h.y), bfhi(h.y)}; }
            else v[i] = *(const f32x4*)(X + (size_t)r * 1024 + i * 256 + lane * 4);
            ss += v[i][0] * v[i][0] + v[i][1] * v[i][1] + v[i][2] * v[i][2] + v[i][3] * v[i][3]; }
        ss = wave_sum(ss); const float rs = rsqrtf(ss * (1.0f / 1024.0f) + 1e-6f);
#pragma unroll
        for (int i = 0; i < 4; ++i) { u32x2 w; w.x = cvt_pk_bf16(v[i][0] * rs * gv[i][0], v[i][1] * rs * gv[i][1]); w.y = cvt_pk_bf16(v[i][2] * rs * gv[i][2], v[i][3] * rs * gv[i][3]);
            *(u32x2*)(dst + (size_t)r * ld_dst + i * 256 + lane * 4) = w; }
    }
}
__device__ __forceinline__ void norm_final(const u16* __restrict__ Xh, float* out, const float* __restrict__ g, int nrows) {
    const int lane = ltid() & 63, gw = blockIdx.x * 8 + (ltid() >> 6), nw = gridDim.x * 8;
    f32x4 gv[4];
#pragma unroll
    for (int i = 0; i < 4; ++i) gv[i] = *(const f32x4*)(g + i * 256 + lane * 4);
    for (int r = gw; r < nrows; r += nw) {
        f32x4 v[4]; float ss = 0.f;
#pragma unroll
        for (int i = 0; i < 4; ++i) { const u32x2 h = *(const u32x2*)(Xh + (size_t)r * 1024 + i * 256 + lane * 4); v[i] = (f32x4){bflo(h.x), bfhi(h.x), bflo(h.y), bfhi(h.y)};
            ss += v[i][0] * v[i][0] + v[i][1] * v[i][1] + v[i][2] * v[i][2] + v[i][3] * v[i][3]; }
        ss = wave_sum(ss); const float rs = rsqrtf(ss * (1.0f / 1024.0f) + 1e-6f);
#pragma unroll
        for (int i = 0; i < 4; ++i) *(f32x4*)(out + (size_t)r * 1024 + i * 256 + lane * 4) = v[i] * rs * gv[i];
    }
}
__device__ __forceinline__ void norm_shift(const float* __restrict__ X, const u16* __restrict__ Xh, const float* __restrict__ g, const float* __restrict__ mu, u16* XNX, u16* XM, int S) {
    const int lane = ltid() & 63, gw = blockIdx.x * 8 + (ltid() >> 6), nw = gridDim.x * 8;
    f32x4 gv[4], m0[4], m2[4], m3[4];
#pragma unroll
    for (int i = 0; i < 4; ++i) { gv[i] = *(const f32x4*)(g + i * 256 + lane * 4); m0[i] = *(const f32x4*)(mu + i * 256 + lane * 4); m2[i] = *(const f32x4*)(mu + 2048 + i * 256 + lane * 4); m3[i] = *(const f32x4*)(mu + 3072 + i * 256 + lane * 4); }
    for (int run = gw; run < TC / 8; run += nw) {
        const int r0 = run * 8;
        f32x4 xp[4], xc[4], xq[4];
#define NS_LOAD(dst, rr) do { const int r_ = (rr); const bool in_ = (r_ >= 0) && (r_ < TC) && ((r_ / S) == (r0 / S)); float ss_ = 0.f; \
            _Pragma("unroll") for (int i = 0; i < 4; ++i) { if (!in_) dst[i] = (f32x4){0.f, 0.f, 0.f, 0.f}; \
                else if (Xh) { const u32x2 h_ = *(const u32x2*)(Xh + (size_t)r_ * 1024 + i * 256 + lane * 4); dst[i] = (f32x4){bflo(h_.x), bfhi(h_.x), bflo(h_.y), bfhi(h_.y)}; } \
                else dst[i] = *(const f32x4*)(X + (size_t)r_ * 1024 + i * 256 + lane * 4); \
                ss_ += dst[i][0] * dst[i][0] + dst[i][1] * dst[i][1] + dst[i][2] * dst[i][2] + dst[i][3] * dst[i][3]; } \
            ss_ = wave_sum(ss_); const float rs_ = in_ ? rsqrtf(ss_ * (1.0f / 1024.0f) + 1e-6f) : 0.f; \
            _Pragma("unroll") for (int i = 0; i < 4; ++i) dst[i] = dst[i] * rs_ * gv[i]; } while (0)
        NS_LOAD(xp, r0 - 1); NS_LOAD(xc, r0);
#pragma unroll 1
        for (int k = 0; k < 8; ++k) {
            const int r = r0 + k;
            NS_LOAD(xq, r + 1);
#pragma unroll
            for (int i = 0; i < 4; ++i) { float xn[4], xx[4];
#pragma unroll
                for (int e = 0; e < 4; ++e) { xn[e] = xc[i][e]; xx[e] = 0.5f * (xp[i][e] + xq[i][e]) - xn[e]; }
                const size_t o = (size_t)r * 2048 + i * 256 + lane * 4, om = (size_t)r * 1024 + i * 256 + lane * 4;
                u32x2 w; w.x = cvt_pk_bf16(xn[0], xn[1]); w.y = cvt_pk_bf16(xn[2], xn[3]); *(u32x2*)(XNX + o) = w;
                u32x2 z; z.x = cvt_pk_bf16(xx[0], xx[1]); z.y = cvt_pk_bf16(xx[2], xx[3]); *(u32x2*)(XNX + o + 1024) = z;
                u32x2 a; a.x = cvt_pk_bf16(xn[0] + xx[0] * m0[i][0], xn[1] + xx[1] * m0[i][1]); a.y = cvt_pk_bf16(xn[2] + xx[2] * m0[i][2], xn[3] + xx[3] * m0[i][3]); *(u32x2*)(XM + om) = a;
                u32x2 b; b.x = cvt_pk_bf16(xn[0] + xx[0] * m2[i][0], xn[1] + xx[1] * m2[i][1]); b.y = cvt_pk_bf16(xn[2] + xx[2] * m2[i][2], xn[3] + xx[3] * m2[i][3]); *(u32x2*)(XM + (size_t)TC * 1024 + om) = b;
                u32x2 c; c.x = cvt_pk_bf16(xn[0] + xx[0] * m3[i][0], xn[1] + xx[1] * m3[i][1]); c.y = cvt_pk_bf16(xn[2] + xx[2] * m3[i][2], xn[3] + xx[3] * m3[i][3]); *(u32x2*)(XM + (size_t)2 * TC * 1024 + om) = c; }
#pragma unroll
            for (int i = 0; i < 4; ++i) { xp[i] = xc[i]; xc[i] = xq[i]; }
        }
#undef NS_LOAD
    }
}

__device__ __forceinline__ bf16x8 as_bf16x8(u32x4 v) { return __builtin_bit_cast(bf16x8, v); }
__device__ __forceinline__ u32x4 rot8(u32x4 mine, u32x4 partner, int c, const float* __restrict__ rope, float scale) {
    float cs[16];
#pragma unroll
    for (int i = 0; i < 4; ++i) { const f32x4 t = *(const f32x4*)(rope + 4 * i); cs[4 * i] = t[0]; cs[4 * i + 1] = t[1]; cs[4 * i + 2] = t[2]; cs[4 * i + 3] = t[3]; }
    float o[8];
#pragma unroll
    for (int i = 0; i < 4; ++i) {
        const unsigned mw = mine[i], pw = partner[i];
        const float m0 = bflo(mw), m1 = bfhi(mw), p0 = bflo(pw), p1 = bfhi(pw);
        const float c0 = cs[4 * i], s0 = cs[4 * i + 1], c1 = cs[4 * i + 2], s1 = cs[4 * i + 3];
        if (c == 0) { o[2 * i] = (m0 * c0 - p0 * s0) * scale; o[2 * i + 1] = (m1 * c1 - p1 * s1) * scale; }
        else        { o[2 * i] = (m0 * c0 + p0 * s0) * scale; o[2 * i + 1] = (m1 * c1 + p1 * s1) * scale; }
    }
    u32x4 r; r.x = cvt_pk_bf16(o[0], o[1]); r.y = cvt_pk_bf16(o[2], o[3]); r.z = cvt_pk_bf16(o[4], o[5]); r.w = cvt_pk_bf16(o[6], o[7]); return r;
}
__device__ __forceinline__ u32x4 scale8(u32x4 v, float scale) {
    u32x4 r;
#pragma unroll
    for (int i = 0; i < 4; ++i) r[i] = cvt_pk_bf16(bflo(v[i]) * scale, bfhi(v[i]) * scale);
    return r;
}

__device__ __forceinline__ void dil_attn_phase(LAS unsigned char* lds, const u16* __restrict__ Z, u16* PART, float* LSE, const float* __restrict__ ROPE, int S) {
    const int tid = ltid(), lane = tid & 63, w = tid >> 6, fr = lane & 15, fq = lane >> 4;
    LAS u16* Ks = (LAS u16*)lds;
    LAS u16* Vt = (LAS u16*)(lds + 272 * 144);
    const int upb = S >> 7, nunits = (TC / S) * 8 * 3 * upb;
    for (int u = blockIdx.x; u < nunits; u += gridDim.x) {
        const int sh = u / (3 * upb), rem = u % (3 * upb), g = rem / upb, idx = rem % upb, seq = sh >> 3, head = sh & 7;
        const int d = 1 << (2 * g), L = S / d, nb2 = upb / d, r = idx / nb2, pair = idx % nb2;
        const int seqbase = seq * S, kl0 = 128 * pair - 64;
        {
            const int c = tid & 7, klb = tid >> 3;
            u32x4 kv[5], pk[5], vv[5]; int sp[5];
#pragma unroll
            for (int i = 0; i < 5; ++i) {
                const int kl = klb + 64 * i, lp = kl0 + kl; const bool ok = (kl < 272) && (lp >= 0) && (lp < L);
                const int s = ok ? lp * d + r : 0; sp[i] = ok ? s : -1;
                const u16* row = Z + (size_t)(seqbase + s) * 3072 + head * 64;
                kv[i] = ok ? *(const u32x4*)(row + 512 + c * 8) : (u32x4){0u, 0u, 0u, 0u};
                pk[i] = (ok && c < 2) ? *(const u32x4*)(row + 512 + (c ^ 1) * 8) : (u32x4){0u, 0u, 0u, 0u};
                const int klv = lane + 64 * i, lpv = kl0 + klv; const bool okv = (klv < 272) && (lpv >= 0) && (lpv < L);
                const int sv = okv ? lpv * d + r : 0;
                vv[i] = okv ? *(const u32x4*)(Z + (size_t)(seqbase + sv) * 3072 + head * 64 + 1024 + w * 8) : (u32x4){0u, 0u, 0u, 0u};
            }
            __builtin_amdgcn_sched_barrier(0);
#pragma unroll
            for (int i = 0; i < 5; ++i) {
                const int kl = klb + 64 * i;
                if (kl < 272) { u32x4 kk = kv[i]; if (c < 2 && sp[i] >= 0) kk = rot8(kk, pk[i], c, ROPE + sp[i] * 16, 1.0f); *(LAS u32x4*)(Ks + kl * 72 + c * 8) = kk; }
                const int klv = lane + 64 * i;
                if (klv < 272) {
#pragma unroll
                    for (int e = 0; e < 4; ++e) { Vt[(w * 8 + 2 * e) * 280 + klv] = (u16)(vv[i][e] & 0xffffu); Vt[(w * 8 + 2 * e + 1) * 280 + klv] = (u16)(vv[i][e] >> 16); } }
            }
        }
        const int lq = 128 * pair + 16 * w + fr, sq = lq * d + r; const int tokq = seqbase + sq;
        bf16x8 qf[2];
        {
            const u16* row = Z + (size_t)tokq * 3072 + head * 64;
            u32x4 q0 = *(const u32x4*)(row + fq * 8), q1 = *(const u32x4*)(row + 32 + fq * 8);
            if (fq < 2) { const u32x4 pk = *(const u32x4*)(row + (fq ^ 1) * 8); q0 = rot8(q0, pk, fq, ROPE + sq * 16, 0.125f); } else q0 = scale8(q0, 0.125f);
            q1 = scale8(q1, 0.125f);
            qf[0] = as_bf16x8(q0); qf[1] = as_bf16x8(q1);
        }
        __syncthreads();
        f32x4 sacc[10];
#pragma unroll
        for (int kt = 0; kt < 10; ++kt) { sacc[kt] = (f32x4){0.f, 0.f, 0.f, 0.f};
#pragma unroll
            for (int sl = 0; sl < 2; ++sl) { const bf16x8 a = *(const LAS bf16x8*)(Ks + (16 * w + 16 * kt + fr) * 72 + sl * 32 + fq * 8); sacc[kt] = __builtin_amdgcn_mfma_f32_16x16x32_bf16(a, qf[sl], sacc[kt], 0, 0, 0); } }
        float mx = -3.0e38f;
#pragma unroll
        for (int kt = 0; kt < 10; ++kt)
#pragma unroll
            for (int j = 0; j < 4; ++j) { const int diff = 16 * kt + fq * 4 + j - 64 - fr, lp = lq + diff; const bool ok = (diff >= -64) && (diff <= 64) && (lp >= 0) && (lp < L);
                const float sv = ok ? sacc[kt][j] : -1.0e30f; sacc[kt][j] = sv; mx = fmaxf(mx, sv); }
        mx = fmaxf(mx, __shfl_xor(mx, 16)); mx = fmaxf(mx, __shfl_xor(mx, 32));
        float den = 0.f;
#pragma unroll
        for (int kt = 0; kt < 10; ++kt)
#pragma unroll
            for (int j = 0; j < 4; ++j) { const float sv = sacc[kt][j]; const float p = (sv > -1.0e29f) ? __expf(sv - mx) : 0.f; sacc[kt][j] = p; den += p; }
        den += __shfl_xor(den, 16); den += __shfl_xor(den, 32);
        bf16x8 pb[5];
#pragma unroll
        for (int uu = 0; uu < 5; ++uu) { u32x4 t; t.x = cvt_pk_bf16(sacc[2 * uu][0], sacc[2 * uu][1]); t.y = cvt_pk_bf16(sacc[2 * uu][2], sacc[2 * uu][3]);
            t.z = cvt_pk_bf16(sacc[2 * uu + 1][0], sacc[2 * uu + 1][1]); t.w = cvt_pk_bf16(sacc[2 * uu + 1][2], sacc[2 * uu + 1][3]); pb[uu] = as_bf16x8(t); }
        const float inv = 1.0f / den;
        u16* po = PART + ((size_t)g * TC + tokq) * 512 + head * 64 + fq * 4;
#pragma unroll
        for (int mt = 0; mt < 4; ++mt) { f32x4 o = (f32x4){0.f, 0.f, 0.f, 0.f};
#pragma unroll
            for (int uu = 0; uu < 5; ++uu) { const LAS u16* vp = Vt + (mt * 16 + fr) * 280 + 16 * w + 32 * uu + fq * 4;
                const u32x2 lo = *(const LAS u32x2*)vp, hi = *(const LAS u32x2*)(vp + 16); u32x4 t; t.x = lo.x; t.y = lo.y; t.z = hi.x; t.w = hi.y;
                o = __builtin_amdgcn_mfma_f32_16x16x32_bf16(as_bf16x8(t), pb[uu], o, 0, 0, 0); }
            u32x2 wv; wv.x = cvt_pk_bf16(o[0] * inv, o[1] * inv); wv.y = cvt_pk_bf16(o[2] * inv, o[3] * inv); *(u32x2*)(po + mt * 16) = wv; }
        if (fq == 0) LSE[((size_t)g * TC + tokq) * 8 + head] = mx + __logf(den);
        __syncthreads();
    }
}

__device__ __forceinline__ void merge_conv_phase(const u16* __restrict__ Z, const u16* __restrict__ PART, const float* __restrict__ LSE, const float* __restrict__ convw, u16* Y, int S) {
    const int lane = ltid() & 63, gw = blockIdx.x * 8 + (ltid() >> 6), nw = gridDim.x * 8;
    float cw[3][8];
#pragma unroll
    for (int j = 0; j < 3; ++j)
#pragma unroll
        for (int e = 0; e < 8; ++e) cw[j][e] = convw[j * 512 + lane * 8 + e];
    for (int t = gw; t < TC; t += nw) {
        const int s = t % S, head = lane >> 3;
        const float l0 = LSE[((size_t)0 * TC + t) * 8 + head], l1 = LSE[((size_t)1 * TC + t) * 8 + head], l2 = LSE[((size_t)2 * TC + t) * 8 + head];
        const float lm = fmaxf(l0, fmaxf(l1, l2)); float w0 = __expf(l0 - lm), w1 = __expf(l1 - lm), w2 = __expf(l2 - lm); const float wi = 1.0f / (w0 + w1 + w2); w0 *= wi; w1 *= wi; w2 *= wi;
        const u32x4 p0 = *(const u32x4*)(PART + ((size_t)0 * TC + t) * 512 + lane * 8), p1 = *(const u32x4*)(PART + ((size_t)1 * TC + t) * 512 + lane * 8), p2 = *(const u32x4*)(PART + ((size_t)2 * TC + t) * 512 + lane * 8);
        u32x4 ya;
#pragma unroll
        for (int i = 0; i < 4; ++i) ya[i] = cvt_pk_bf16(w0 * bflo(p0[i]) + w1 * bflo(p1[i]) + w2 * bflo(p2[i]), w0 * bfhi(p0[i]) + w1 * bfhi(p1[i]) + w2 * bfhi(p2[i]));
        *(u32x4*)(Y + (size_t)t * 1024 + lane * 8) = ya;
        const u16* zr = Z + (size_t)t * 3072;
        const u32x4 bg = *(const u32x4*)(zr + 1536 + lane * 8);
        float acc[8];
#pragma unroll
        for (int e = 0; e < 8; ++e) acc[e] = 0.f;
#pragma unroll
        for (int j = 0; j < 3; ++j) { const int sj = s + j - 1;
            if (sj >= 0 && sj < S) { const u16* zj = zr + (ptrdiff_t)(j - 1) * 3072; const u32x4 cg = *(const u32x4*)(zj + 2048 + lane * 8), hh = *(const u32x4*)(zj + 2560 + lane * 8);
#pragma unroll
                for (int i = 0; i < 4; ++i) { acc[2 * i] += cw[j][2 * i] * (bflo(cg[i]) * bflo(hh[i])); acc[2 * i + 1] += cw[j][2 * i + 1] * (bfhi(cg[i]) * bfhi(hh[i])); } } }
        u32x4 yb;
#pragma unroll
        for (int i = 0; i < 4; ++i) yb[i] = cvt_pk_bf16(bflo(bg[i]) * acc[2 * i], bfhi(bg[i]) * acc[2 * i + 1]);
        *(u32x4*)(Y + (size_t)t * 1024 + 512 + lane * 8) = yb;
    }
}

__device__ __forceinline__ void cross_attn_unit(LAS unsigned char* lds, const u16* __restrict__ Q, const u16* __restrict__ KV, int memrow0, u16* O, int S, int seq, int head, int qt) {
    const int tid = ltid(), lane = tid & 63, w = tid >> 6, fr = lane & 15, fq = lane >> 4;
    LAS u16* Ks = (LAS u16*)lds;
    {
        const u16* kvb = KV + (size_t)(memrow0 + seq * 256) * 2048 + head * 256;
        { u32x4 tmp[16];
#pragma unroll
          for (int i = 0; i < 16; ++i) { const int task = tid + i * NTHREADS, key = task >> 5, c = task & 31; tmp[i] = *(const u32x4*)(kvb + (size_t)key * 2048 + c * 8); }
#pragma unroll
          for (int i = 0; i < 16; ++i) { const int task = tid + i * NTHREADS, key = task >> 5, c = task & 31; *(LAS u32x4*)(Ks + key * 264 + c * 8) = tmp[i]; } }
        const int tokq = seq * S + qt * 128 + 16 * w + fr;
        bf16x8 qf[8];
        { const u16* row = Q + (size_t)tokq * 1024 + head * 256;
#pragma unroll
          for (int sl = 0; sl < 8; ++sl) qf[sl] = as_bf16x8(scale8(*(const u32x4*)(row + sl * 32 + fq * 8), 0.0625f)); }
        __syncthreads();
        f32x4 sacc[16];
#pragma unroll
        for (int kt = 0; kt < 16; ++kt) { sacc[kt] = (f32x4){0.f, 0.f, 0.f, 0.f};
#pragma unroll
            for (int sl = 0; sl < 8; ++sl) { const bf16x8 a = *(const LAS bf16x8*)(Ks + (16 * kt + fr) * 264 + sl * 32 + fq * 8); sacc[kt] = __builtin_amdgcn_mfma_f32_16x16x32_bf16(a, qf[sl], sacc[kt], 0, 0, 0); } }
        float mx = -3.0e38f;
#pragma unroll
        for (int kt = 0; kt < 16; ++kt)
#pragma unroll
            for (int j = 0; j < 4; ++j) mx = fmaxf(mx, sacc[kt][j]);
        mx = fmaxf(mx, __shfl_xor(mx, 16)); mx = fmaxf(mx, __shfl_xor(mx, 32));
        float den = 0.f;
#pragma unroll
        for (int kt = 0; kt < 16; ++kt)
#pragma unroll
            for (int j = 0; j < 4; ++j) { const float p = __expf(sacc[kt][j] - mx); sacc[kt][j] = p; den += p; }
        den += __shfl_xor(den, 16); den += __shfl_xor(den, 32);
        bf16x8 pb[8];
#pragma unroll
        for (int uu = 0; uu < 8; ++uu) { u32x4 t; t.x = cvt_pk_bf16(sacc[2 * uu][0], sacc[2 * uu][1]); t.y = cvt_pk_bf16(sacc[2 * uu][2], sacc[2 * uu][3]);
            t.z = cvt_pk_bf16(sacc[2 * uu + 1][0], sacc[2 * uu + 1][1]); t.w = cvt_pk_bf16(sacc[2 * uu + 1][2], sacc[2 * uu + 1][3]); pb[uu] = as_bf16x8(t); }
        __syncthreads();
        { u32x4 tmp[16]; const int key = (w & 3) * 64 + lane, cb = (w >> 2) * 16;
#pragma unroll
          for (int i = 0; i < 16; ++i) tmp[i] = *(const u32x4*)(kvb + 1024 + (size_t)key * 2048 + (cb + i) * 8);
#pragma unroll
          for (int i = 0; i < 16; ++i) {
#pragma unroll
            for (int e = 0; e < 4; ++e) { Ks[((cb + i) * 8 + 2 * e) * 264 + key] = (u16)(tmp[i][e] & 0xffffu); Ks[((cb + i) * 8 + 2 * e + 1) * 264 + key] = (u16)(tmp[i][e] >> 16); } } }
        __syncthreads();
        const float inv = 1.0f / den;
        u16* po = O + (size_t)tokq * 1024 + head * 256 + fq * 4;
#pragma unroll
        for (int mt = 0; mt < 16; ++mt) { f32x4 o = (f32x4){0.f, 0.f, 0.f, 0.f};
#pragma unroll
            for (int uu = 0; uu < 8; ++uu) { const LAS u16* vp = Ks + (mt * 16 + fr) * 264 + 32 * uu + fq * 4;
                const u32x2 lo = *(const LAS u32x2*)vp, hi = *(const LAS u32x2*)(vp + 16); u32x4 t; t.x = lo.x; t.y = lo.y; t.z = hi.x; t.w = hi.y;
                o = __builtin_amdgcn_mfma_f32_16x16x32_bf16(as_bf16x8(t), pb[uu], o, 0, 0, 0); }
            u32x2 wv; wv.x = cvt_pk_bf16(o[0] * inv, o[1] * inv); wv.y = cvt_pk_bf16(o[2] * inv, o[3] * inv); *(u32x2*)(po + mt * 16) = wv; }
        __syncthreads();
    }
}
__device__ __forceinline__ void cross_attn_phase(LAS unsigned char* lds, const u16* __restrict__ Q, const u16* __restrict__ KV, int memrow0, u16* O, int S) {
    const int qpb = S >> 7, nunits = (TC / S) * 4 * qpb;
    for (int u = blockIdx.x; u < nunits; u += gridDim.x) { const int sh = u / qpb, qt = u % qpb; cross_attn_unit(lds, Q, KV, memrow0, O, S, sh >> 2, sh & 3, qt); }
}
template <int CTRL> __device__ __forceinline__ float dpp_add(float v) { const int t = __builtin_amdgcn_update_dpp(__float_as_int(v), __float_as_int(v), CTRL, 0xf, 0xf, true); return v + __int_as_float(t); }
template <int L> __device__ __forceinline__ float row_reduce(float v) {
    v = dpp_add<0xB1>(v); v = dpp_add<0x4E>(v); v = dpp_add<0x141>(v);
    if (L == 16) v = dpp_add<0x140>(v);
    return v;
}
__device__ __forceinline__ void row_reduce2(float& a, float& b) {
    asm volatile("s_nop 1\n\t"
        "v_add_f32_dpp %0, %0, %0 quad_perm:[1,0,3,2] row_mask:0xf bank_mask:0xf bound_ctrl:1\n\t"
        "v_add_f32_dpp %1, %1, %1 quad_perm:[1,0,3,2] row_mask:0xf bank_mask:0xf bound_ctrl:1\n\t"
        "s_nop 0\n\t"
        "v_add_f32_dpp %0, %0, %0 quad_perm:[2,3,0,1] row_mask:0xf bank_mask:0xf bound_ctrl:1\n\t"
        "v_add_f32_dpp %1, %1, %1 quad_perm:[2,3,0,1] row_mask:0xf bank_mask:0xf bound_ctrl:1\n\t"
        "s_nop 0\n\t"
        "v_add_f32_dpp %0, %0, %0 row_half_mirror row_mask:0xf bank_mask:0xf bound_ctrl:1\n\t"
        "v_add_f32_dpp %1, %1, %1 row_half_mirror row_mask:0xf bank_mask:0xf bound_ctrl:1\n\t"
        "s_nop 0\n\t"
        "v_add_f32_dpp %0, %0, %0 row_mirror row_mask:0xf bank_mask:0xf bound_ctrl:1\n\t"
        "v_add_f32_dpp %1, %1, %1 row_mirror row_mask:0xf bank_mask:0xf bound_ctrl:1\n\t"
        "s_nop 1"
        : "+v"(a), "+v"(b));
}
__device__ __forceinline__ void half_reduce2(float& a, float& b) {
    asm volatile("s_nop 1\n\t"
        "v_add_f32_dpp %0, %0, %0 quad_perm:[1,0,3,2] row_mask:0xf bank_mask:0xf bound_ctrl:1\n\t"
        "v_add_f32_dpp %1, %1, %1 quad_perm:[1,0,3,2] row_mask:0xf bank_mask:0xf bound_ctrl:1\n\t"
        "s_nop 0\n\t"
        "v_add_f32_dpp %0, %0, %0 quad_perm:[2,3,0,1] row_mask:0xf bank_mask:0xf bound_ctrl:1\n\t"
        "v_add_f32_dpp %1, %1, %1 quad_perm:[2,3,0,1] row_mask:0xf bank_mask:0xf bound_ctrl:1\n\t"
        "s_nop 0\n\t"
        "v_add_f32_dpp %0, %0, %0 row_half_mirror row_mask:0xf bank_mask:0xf bound_ctrl:1\n\t"
        "v_add_f32_dpp %1, %1, %1 row_half_mirror row_mask:0xf bank_mask:0xf bound_ctrl:1\n\t"
        "s_nop 1"
        : "+v"(a), "+v"(b));
}
__device__ __forceinline__ void half_reduce1(float& a) {
    asm volatile("s_nop 1\n\t"
        "v_add_f32_dpp %0, %0, %0 quad_perm:[1,0,3,2] row_mask:0xf bank_mask:0xf bound_ctrl:1\n\t"
        "s_nop 1\n\t"
        "v_add_f32_dpp %0, %0, %0 quad_perm:[2,3,0,1] row_mask:0xf bank_mask:0xf bound_ctrl:1\n\t"
        "s_nop 1\n\t"
        "v_add_f32_dpp %0, %0, %0 row_half_mirror row_mask:0xf bank_mask:0xf bound_ctrl:1\n\t"
        "s_nop 1"
        : "+v"(a));
}
__device__ __forceinline__ void row_reduce4(float& a, float& b, float& c, float& d) {
#define RR4_STEP(ctl) "v_add_f32_dpp %0, %0, %0 " ctl " row_mask:0xf bank_mask:0xf bound_ctrl:1\n\t" "v_add_f32_dpp %1, %1, %1 " ctl " row_mask:0xf bank_mask:0xf bound_ctrl:1\n\t" \
                      "v_add_f32_dpp %2, %2, %2 " ctl " row_mask:0xf bank_mask:0xf bound_ctrl:1\n\t" "v_add_f32_dpp %3, %3, %3 " ctl " row_mask:0xf bank_mask:0xf bound_ctrl:1\n\t"
    asm volatile("s_nop 1\n\t" RR4_STEP("quad_perm:[1,0,3,2]") RR4_STEP("quad_perm:[2,3,0,1]") RR4_STEP("row_half_mirror") RR4_STEP("row_mirror") "s_nop 1"
        : "+v"(a), "+v"(b), "+v"(c), "+v"(d));
#undef RR4_STEP
}
__device__ __forceinline__ float wave_sum_fast(float v) { v = dpp_add<0xB1>(v); v = dpp_add<0x4E>(v); v = dpp_add<0x141>(v); v = dpp_add<0x140>(v); v += __shfl_xor(v, 16); v += __shfl_xor(v, 32); return v; }
constexpr int TS = 32;
struct ScanRaw { u16 r[8], k[8], v[8], e[8], a[8]; };
template <int RR, int J>
__device__ __forceinline__ void scan_item(LAS unsigned char* lds, const u16* __restrict__ RKV, const u16* __restrict__ Ed, const u16* __restrict__ Ad, const float* __restrict__ kkw, const float* __restrict__ kaw,
                          const float* __restrict__ rkw, u16* OD, float* BON, int S, int seqbase, int head, int dir, int rowbase) {
    constexpr int NACT = 4;
    const int tid = ltid(), lane = tid & 63, w = tid >> 6;
    constexpr int L = 64 / J, NRG = 64 / L;
    const int rg = lane / L, jg = lane % L, j0 = jg * J, row0 = rowbase + w * (NRG * RR) + rg * RR;
    const float kkc = kkw[head * 64 + lane], kac = kaw[head * 64 + lane], rkc = rkw[head * 64 + lane];
    f32x2 st_[RR][J / 2];
#pragma unroll
    for (int r = 0; r < RR; ++r)
#pragma unroll
        for (int q = 0; q < J / 2; ++q) st_[r][q] = (f32x2){0.f, 0.f};
    const int nch = S / TS;
    ScanRaw raw;
    constexpr int NPT = 8;
    const bool prep = (w >= 4); const int pw = w - 4;
#define SCAN_LOAD(ch) do { if (prep) { _Pragma("unroll") for (int q = 0; q < NPT; ++q) { const int i = (ch) * TS + pw * NPT + q; const int t = dir ? (S - 1 - i) : i; const size_t tok = (size_t)(seqbase + t); \
        raw.r[q] = RKV[tok * 3072 + head * 64 + lane]; raw.k[q] = RKV[tok * 3072 + 1024 + head * 64 + lane]; raw.v[q] = RKV[tok * 3072 + 2048 + head * 64 + lane]; \
        raw.e[q] = Ed[tok * 1024 + head * 64 + lane]; raw.a[q] = Ad[tok * 1024 + head * 64 + lane]; } } } while (0)
#define SCAN_PREP(buf, ch) do { if (prep) { LAS float* B_ = (LAS float*)(lds + (buf) * 49152); _Pragma("unroll") for (int q = 0; q < NPT; ++q) { const int ls = pw * NPT + q; \
        const float r_ = bf2f(raw.r[q]), k_ = bf2f(raw.k[q]), v_ = bf2f(raw.v[q]), a_ = bf2f(raw.a[q]); const float e_ = (float)__builtin_bit_cast(_Float16, raw.e[q]); \
        const float kr_ = k_ * kkc; const float ss_ = wave_sum_fast(kr_ * kr_); const float kk_ = kr_ * rsqrtf(fmaxf(ss_, 1e-24f)); \
        B_[(0 * TS + ls) * 64 + lane] = __expf(-e_); B_[(1 * TS + ls) * 64 + lane] = -kk_; B_[(2 * TS + ls) * 64 + lane] = kk_ * a_; \
        const float kd_ = k_ * (1.0f + (a_ - 1.0f) * kac); const float bn_ = wave_sum_fast(r_ * kd_ * rkc); \
        { const int i_ = (ch) * TS + ls; const int t_ = dir ? (S - 1 - i_) : i_; if (lane == 0) BON[((size_t)dir * TC + seqbase + t_) * 16 + head] = bn_; } \
        B_[(3 * TS + ls) * 64 + lane] = kd_; B_[(4 * TS + ls) * 64 + lane] = r_; B_[(5 * TS + ls) * 64 + lane] = v_; } } } while (0)
    SCAN_LOAD(0);
    SCAN_PREP(0, 0);
    __syncthreads();
    for (int ch = 0; ch < nch; ++ch) {
        if (ch + 1 < nch) SCAN_LOAD(ch + 1);
        if (w < NACT) {
            const LAS float* B = (const LAS float*)(lds + (ch & 1) * 49152);
            float os[RR];
#pragma unroll
            for (int r = 0; r < RR; ++r) os[r] = 0.f;
            f32x4 W[J / 4], A[J / 4], Bb[J / 4], K[J / 4], R[J / 4];
#pragma unroll
            for (int q = 0; q < J / 4; ++q) { W[q] = *(const LAS f32x4*)(B + (0 * TS) * 64 + j0 + 4 * q); A[q] = *(const LAS f32x4*)(B + (1 * TS) * 64 + j0 + 4 * q); Bb[q] = *(const LAS f32x4*)(B + (2 * TS) * 64 + j0 + 4 * q);
                K[q] = *(const LAS f32x4*)(B + (3 * TS) * 64 + j0 + 4 * q); R[q] = *(const LAS f32x4*)(B + (4 * TS) * 64 + j0 + 4 * q); }
            float V[RR];
#pragma unroll
            for (int r = 0; r < RR; ++r) V[r] = B[(5 * TS) * 64 + row0 + r];
#pragma unroll
            for (int ls = 0; ls < TS; ++ls) {
                f32x4 nW[J / 4], nA[J / 4], nB[J / 4], nK[J / 4], nR[J / 4]; float nV[RR];
#pragma unroll
                for (int q = 0; q < J / 4; ++q) { nW[q] = W[q]; nA[q] = A[q]; nB[q] = Bb[q]; nK[q] = K[q]; nR[q] = R[q]; }
#pragma unroll
                for (int r = 0; r < RR; ++r) nV[r] = V[r];
                if (ls + 1 < TS) {
#pragma unroll
                    for (int q = 0; q < J / 4; ++q) { nW[q] = *(const LAS f32x4*)(B + (0 * TS + ls + 1) * 64 + j0 + 4 * q); nA[q] = *(const LAS f32x4*)(B + (1 * TS + ls + 1) * 64 + j0 + 4 * q); nB[q] = *(const LAS f32x4*)(B + (2 * TS + ls + 1) * 64 + j0 + 4 * q);
                        nK[q] = *(const LAS f32x4*)(B + (3 * TS + ls + 1) * 64 + j0 + 4 * q); nR[q] = *(const LAS f32x4*)(B + (4 * TS + ls + 1) * 64 + j0 + 4 * q); }
                    if (RR == 1) nV[0] = B[(5 * TS + ls + 1) * 64 + row0];
                    else if (RR == 2) { const f32x2 t = *(const LAS f32x2*)(B + (5 * TS + ls + 1) * 64 + row0); nV[0] = t[0]; nV[RR - 1] = t[1]; }
                    else { const f32x4 t = *(const LAS f32x4*)(B + (5 * TS + ls + 1) * 64 + row0);
#pragma unroll
                        for (int r = 0; r < RR; ++r) nV[r] = t[r]; }
                }
                __builtin_amdgcn_sched_barrier(0);
                float sa[RR];
#pragma unroll
                for (int r = 0; r < RR; ++r) { f32x2 p = st_[r][0] * (f32x2){A[0][0], A[0][1]};
#pragma unroll
                    for (int q = 1; q < J / 2; ++q) p = st_[r][q] * (f32x2){A[q >> 1][(q & 1) * 2], A[q >> 1][(q & 1) * 2 + 1]} + p;
                    sa[r] = p[0] + p[1]; }
                if (J == 4) { if (RR == 2) row_reduce2(sa[0], sa[RR - 1]); else row_reduce4(sa[0], sa[RR > 1 ? 1 : 0], sa[RR > 1 ? RR - 2 : 0], sa[RR - 1]); } else if (RR == 1) half_reduce1(sa[0]); else half_reduce2(sa[0], sa[RR - 1]);
                float o[RR];
#pragma unroll
                for (int r = 0; r < RR; ++r) { const f32x2 sv = {sa[r], sa[r]}, vv = {V[r], V[r]}; f32x2 u = {0.f, 0.f};
#pragma unroll
                    for (int q = 0; q < J / 2; ++q) { const int qq = q >> 1, e = (q & 1) * 2;
                        st_[r][q] = st_[r][q] * (f32x2){W[qq][e], W[qq][e + 1]} + (sv * (f32x2){Bb[qq][e], Bb[qq][e + 1]} + vv * (f32x2){K[qq][e], K[qq][e + 1]});
                        u = st_[r][q] * (f32x2){R[qq][e], R[qq][e + 1]} + u; }
                    o[r] = u[0] + u[1]; }
                if (J == 4) { if (RR == 2) row_reduce2(o[0], o[RR - 1]); else row_reduce4(o[0], o[RR > 1 ? 1 : 0], o[RR > 1 ? RR - 2 : 0], o[RR - 1]); } else if (RR == 1) half_reduce1(o[0]); else half_reduce2(o[0], o[RR - 1]);
                const bool mine = (jg == (ls & (L - 1)));
#pragma unroll
                for (int r = 0; r < RR; ++r) os[r] = mine ? o[r] : os[r];
                if ((ls & (L - 1)) == L - 1) {
                    const int i = ch * TS + (ls - (L - 1)) + jg; const int t = dir ? (S - 1 - i) : i;
                    u16* op = OD + ((size_t)dir * TC + seqbase + t) * 1024 + head * 64 + row0;
                    if (RR == 1) *op = f2bf(os[0]);
                    else if (RR == 2) *(unsigned*)op = cvt_pk_bf16(os[0], os[RR - 1]);
                    else { u32x2 pk; pk.x = cvt_pk_bf16(os[0], os[RR > 1 ? 1 : 0]); pk.y = cvt_pk_bf16(os[RR - 2], os[RR - 1]); *(u32x2*)op = pk; }
                }
                __builtin_amdgcn_sched_barrier(0);
#pragma unroll
                for (int q = 0; q < J / 4; ++q) { W[q] = nW[q]; A[q] = nA[q]; Bb[q] = nB[q]; K[q] = nK[q]; R[q] = nR[q]; }
#pragma unroll
                for (int r = 0; r < RR; ++r) V[r] = nV[r];
            }
        }
        if (ch + 1 < nch) SCAN_PREP((ch + 1) & 1, ch + 1);
        __syncthreads();
    }
#undef SCAN_LOAD
#undef SCAN_PREP
}
__device__ __forceinline__ void scan_phase(LAS unsigned char* lds, const u16* RKV, const u16* EAG, const float* kkw, const float* kaw, const float* rkw, u16* OD, float* BON, int S) {
    for (int item = blockIdx.x; item < 256; item += gridDim.x) {
        if (S == 4096) { const int id = item >> 1, half = item & 1, seq = id >> 5, rem = id & 31, head = rem >> 1, dir = rem & 1;
            scan_item<2, 4>(lds, RKV, EAG + (size_t)dir * TC * 1024, EAG + (size_t)(2 + dir) * TC * 1024, kkw, kaw, rkw, OD, BON, S, seq * S, head, dir, half * 32);
        } else { const int seq = item >> 5, rem = item & 31, head = rem >> 1, dir = rem & 1;
            scan_item<2, 8>(lds, RKV, EAG + (size_t)dir * TC * 1024, EAG + (size_t)(2 + dir) * TC * 1024, kkw, kaw, rkw, OD, BON, S, seq * S, head, dir, 0);
        }
        __syncthreads();
    }
}
__device__ __forceinline__ float quad_sum(float v) { v = dpp_add<0xB1>(v); v = dpp_add<0x4E>(v); return v; }
__device__ __forceinline__ void rwkv_post_phase(const u16* __restrict__ OD, const float* __restrict__ BON, const u16* __restrict__ RKV, const u16* __restrict__ EAG,
                                const float* __restrict__ lnw, const float* __restrict__ lnb, u16* Y) {
    const int lane = ltid() & 63, gw = blockIdx.x * 8 + (ltid() >> 6), nw = gridDim.x * 8, c0 = lane * 16;
    float lw[16], lb[16];
#pragma unroll
    for (int i = 0; i < 4; ++i) { const f32x4 c = *(const f32x4*)(lnw + c0 + 4 * i), d = *(const f32x4*)(lnb + c0 + 4 * i);
#pragma unroll
        for (int e = 0; e < 4; ++e) { lw[4 * i + e] = c[e]; lb[4 * i + e] = d[e]; } }
    for (int t = gw; t < TC; t += nw) {
        u32x4 oa[2], ob[2], vv[2], gg[2];
#pragma unroll
        for (int i = 0; i < 2; ++i) { oa[i] = *(const u32x4*)(OD + (size_t)t * 1024 + c0 + 8 * i); ob[i] = *(const u32x4*)(OD + ((size_t)TC + t) * 1024 + c0 + 8 * i);
            vv[i] = *(const u32x4*)(RKV + (size_t)t * 3072 + 2048 + c0 + 8 * i); gg[i] = *(const u32x4*)(EAG + ((size_t)4 * TC + t) * 1024 + c0 + 8 * i); }
        const float bsum = BON[(size_t)t * 16 + (lane >> 2)] + BON[((size_t)TC + t) * 16 + (lane >> 2)];
        float y[16];
#pragma unroll
        for (int i = 0; i < 16; ++i) { const int w_ = (i & 7) >> 1; const bool hi = i & 1; y[i] = (hi ? bfhi(oa[i >> 3][w_]) : bflo(oa[i >> 3][w_])) + (hi ? bfhi(ob[i >> 3][w_]) : bflo(ob[i >> 3][w_])); }
        float sm = 0.f;
#pragma unroll
        for (int i = 0; i < 16; ++i) sm += y[i];
        const float mean = quad_sum(sm) * (1.0f / 64.0f);
        float sv = 0.f;
#pragma unroll
        for (int i = 0; i < 16; ++i) { y[i] -= mean; sv += y[i] * y[i]; }
        const float rstd = rsqrtf(quad_sum(sv) * (1.0f / 64.0f) + 64e-5f);
        float o[16];
#pragma unroll
        for (int i = 0; i < 16; ++i) { const int w_ = (i & 7) >> 1; const bool hi = i & 1;
            const float v = hi ? bfhi(vv[i >> 3][w_]) : bflo(vv[i >> 3][w_]), g = hi ? bfhi(gg[i >> 3][w_]) : bflo(gg[i >> 3][w_]);
            o[i] = (y[i] * rstd * lw[i] + lb[i] + bsum * v) * g; }
#pragma unroll
        for (int i = 0; i < 2; ++i) { u32x4 w; w.x = cvt_pk_bf16(o[8 * i], o[8 * i + 1]); w.y = cvt_pk_bf16(o[8 * i + 2], o[8 * i + 3]); w.z = cvt_pk_bf16(o[8 * i + 4], o[8 * i + 5]); w.w = cvt_pk_bf16(o[8 * i + 6], o[8 * i + 7]);
            *(u32x4*)(Y + (size_t)t * 1024 + c0 + 8 * i) = w; }
    }
}
__device__ __forceinline__ void build_w2comb(u16* W2, const float* __restrict__ w2, const float* __restrict__ a2, const float* __restrict__ g2) {
    const size_t total = (size_t)384 * 5120, stride = (size_t)gridDim.x * NTHREADS;
    for (size_t idx = (size_t)blockIdx.x * NTHREADS + ltid(); idx < total; idx += stride) {
        const int k = (int)(idx / 5120), n = (int)(idx % 5120), sel = n >> 10, nn = n & 1023; float v = 0.f;
        if (sel == 0 && k < 64) v = w2[(size_t)k * 1024 + nn];
        else if (sel == 1 && k >= 64 && k < 128) v = w2[(size_t)(64 + (k - 64)) * 1024 + nn];
        else if (sel == 2 && k >= 128 && k < 192) v = a2[(size_t)(k - 128) * 1024 + nn];
        else if (sel == 3 && k >= 192 && k < 256) v = a2[(size_t)(64 + (k - 192)) * 1024 + nn];
        else if (sel == 4 && k >= 256 && k < 384) v = g2[(size_t)(k - 256) * 1024 + nn];
        W2[(size_t)n * 384 + k] = f2bf(v);
    }
}

namespace pg8 {
struct EpiAny {
    static constexpr bool PERM = true, AFTER_DRAIN = false;
    int mode; u16* o16; u16* o16b; u16* x; const float* b0; const float* b1; int ldc; int M; unsigned long long* ssw; const unsigned long long* ssr; const float* xin;
    __device__ __forceinline__ void operator()(const f32x4 (&acc)[2][2][4][2], const Unit& u, int wr, int wc, int fr, int fq) const {
        if (mode == 0) EpiStore16{o16, ldc, ssr}(acc, u, wr, wc, fr, fq);
        else if (mode == 1) EpiResid{x, xin, ssw}(acc, u, wr, wc, fr, fq);
        else if (mode == 2) EpiSwiglu{o16, ssr}(acc, u, wr, wc, fr, fq);
        else if (mode == 3) EpiRwkv{o16}(acc, u, wr, wc, fr, fq);
        else EpiLora2{o16, b0, b1, M}(acc, u, wr, wc, fr, fq);
    }
};
}

__global__ void __launch_bounds__(NTHREADS, 2) mega(Params p) {
    extern __shared__ __attribute__((aligned(16))) unsigned char lds_raw[];
    LAS unsigned char* lds = (LAS unsigned char*)lds_raw;
    ltid_setup();
    cg::grid_group grid = cg::this_grid();
    unsigned char* const ws = p.ws;
    u16* const Xb = (u16*)(ws + WS_ARENA + AR_A);
    unsigned char* const RA = (unsigned char*)p.out;
    const size_t gstride = (size_t)gridDim.x * NTHREADS;

    {
        float* const ROPE = (float*)(ws + WS_ROPE);
        for (size_t i = (size_t)blockIdx.x * NTHREADS + ltid(); i < 4096 * 8; i += gstride) { const int pos = (int)(i >> 3), fi = (int)(i & 7);
            const float inv = powf(500000.0f, -2.0f * (float)fi / 16.0f); const float ang = (float)pos * inv;
            ROPE[i * 2] = (float)cos((double)ang); ROPE[i * 2 + 1] = (float)sin((double)ang); }
    }
    if (blockIdx.x == 0) for (int i = ltid(); i < XCD_BAR_WORDS; i += NTHREADS) ((unsigned*)(ws + WS_BAR))[i] = 0u;
    __syncthreads();
    grid.sync();
    volatile LAS unsigned* xst = (volatile LAS unsigned*)(lds + LDS_BYTES - 16);
    if (ltid() == 0) { xst[0] = 0u; xst[1] = 0u; }
    __syncthreads();
    XcdBarrier xbar = xcd_barrier_post((unsigned*)(ws + WS_BAR), xst);
#ifndef DUP_MISC
#define DUP_MISC 1
#endif
#ifndef DUP_SYNC
#define DUP_SYNC 1
#endif
#ifndef DUP_STEP
#define DUP_STEP -1
#define DUP_PAR -1
#endif
#ifndef DUP_SCAN
#define DUP_SCAN 1
#endif
    for (int ph = 0; ph < 4 * NCHUNK * 15; ++ph) {
        const int l = ph / (NCHUNK * 15), c = (ph / 15) % NCHUNK, s = ph % 15;
        const int e = l >> 1; const bool odd = (l & 1) != 0;
        if (s < 3 && c != 0) continue;
        if (s == 6 && !odd) continue;
        if (s == 8 || s == 12 || s == 10) continue;
        const int S = c < 2 ? 4096 : 2048;
        u16* const Xc = Xb + (size_t)c * TC * 1024;
        const float* const Xin0 = c < 2 ? p.in[0] + (size_t)c * TC * 1024 : p.in[1];
        unsigned char* const AR = ws + WS_ARENA;
        u16* const XN = (u16*)RA; u16* const BUFB = (u16*)(AR + AR_B); u16* const BUFC = (u16*)(AR + AR_C); u16* const Y = (u16*)(AR + AR_D);
        bool do_gemm = false; const u16* gA = nullptr; const u16* gB = nullptr; int gM = TC, gN = 1024, gK = 1024; size_t g_grp = 0; int g_shift = 0, ngemm = 1;
        pg8::EpiAny E{0, nullptr, nullptr, nullptr, nullptr, nullptr, 0, TC, nullptr, nullptr, nullptr};
        unsigned long long* const SSC = (unsigned long long*)(ws + WS_SS); unsigned long long* const SSF = SSC + TC;
        for (int dup = 0; dup < ((s == 5 && odd) ? DUP_SCAN : ((s == DUP_STEP && (DUP_PAR < 0 || (int)odd == DUP_PAR)) ? 2 : DUP_MISC)); ++dup) {
        if (s == 0) {
            const float* mu = p.in[12] + (size_t)e * 6 * 1024;
            u16* const WMIX = (u16*)(ws + WS_WMIX);
            for (int j = 0; j < 22; ++j) {
                const float* src = nullptr; int ld_src = 1024, K = 1024, N = 1024, ld_dst = 1024, col0 = 0, mode = 0; u16* dst = nullptr; const float* s1 = nullptr;
                if (j < 17) {
                    if (!odd) {
                        if (j == 0) { src = p.in[9] + (size_t)e * 1024 * 3072; ld_src = 3072; N = 3072; dst = WMIX; }
                        else if (j == 1) { src = p.in[10] + (size_t)e * 1024 * 1024; dst = WMIX + (size_t)3072 * 1024; }
                        else continue;
                    } else {
                        const int half = j & 1, q = j >> 1;
                        u16* const WL1 = WMIX + (size_t)3072 * 1024;
                        if (q < 3) { if (half) continue; src = p.in[13 + q] + (size_t)e * 1024 * 1024; dst = WMIX + (size_t)q * 1024 * 1024; }
                        else if (q < 5) { const int d = q - 3; src = p.in[18] + ((size_t)e * 2 + d) * 1024 * 64; ld_src = 64; N = 64; dst = WL1 + (size_t)(d * 64) * 2048; ld_dst = 2048; col0 = half * 1024; if (half) s1 = mu + 1 * 1024; }
                        else if (q < 7) { const int d = q - 5; src = p.in[21] + ((size_t)e * 2 + d) * 1024 * 64; ld_src = 64; N = 64; dst = WL1 + (size_t)(128 + d * 64) * 2048; ld_dst = 2048; col0 = half * 1024; if (half) s1 = mu + 4 * 1024; }
                        else if (q == 7) { src = p.in[23] + (size_t)e * 1024 * 128; ld_src = 128; N = 128; dst = WL1 + (size_t)256 * 2048; ld_dst = 2048; col0 = half * 1024; if (half) s1 = mu + 5 * 1024; }
                        else { if (half) continue; src = p.in[16] + (size_t)e * 1024 * 1024; dst = (u16*)(ws + WS_WMIX + WMIX_C); }
                    }
                } else if (j == 17) { src = p.in[30] + (size_t)l * 1024 * 1024; dst = (u16*)(ws + WS_WQ); s1 = p.in[5] + l * 1024; }
                else if (j == 18) { src = p.in[31] + (size_t)l * 1024 * 2048; ld_src = 2048; N = 2048; dst = (u16*)(ws + WS_WKV); }
                else if (j == 19) { src = p.in[32] + (size_t)l * 1024 * 1024; dst = (u16*)(ws + WS_WO); }
                else if (j == 20) { src = p.in[33] + (size_t)l * 1024 * 5632; ld_src = 5632; N = 5632; dst = (u16*)(ws + WS_WGU); mode = 1; s1 = p.in[7] + l * 1024; }
                else { src = p.in[34] + (size_t)l * 2816 * 1024; K = 2816; dst = (u16*)(ws + WS_WDN); ld_dst = 2816; }
                tr_job(lds, src, ld_src, K, N, dst, ld_dst, col0, s1, mode, j * 37);
            }
            if (odd) {
                for (size_t i = (size_t)blockIdx.x * NTHREADS + ltid(); i < (size_t)128 * 2048 / 8; i += gstride) ((u32x4*)(WMIX + (size_t)3072 * 1024 + (size_t)384 * 2048))[i] = (u32x4){0u, 0u, 0u, 0u};
                build_w2comb((u16*)(ws + WS_WMIX + WMIX_B), p.in[19] + (size_t)e * 2 * 64 * 1024, p.in[22] + (size_t)e * 2 * 64 * 1024, p.in[24] + (size_t)e * 128 * 1024);
            }
        }
        if (s == 0) {
            for (int rep = 0; rep < 2; ++rep) norm_rows(p.in[2 + rep], nullptr, p.in[6] + l * 1024, (u16*)(ws + WS_MN) + (size_t)rep * 2048 * 1024, 1024, 2048);
        }
        else if (s == 1) { do_gemm = true; gA = (u16*)(ws + WS_MN); gB = (u16*)(ws + WS_WKV); gM = 4096; gN = 2048; E.o16 = (u16*)(ws + WS_KV); E.ldc = 2048; }
        else if (s == 3) { do_gemm = true; gB = (u16*)(ws + WS_WMIX);
            if (!odd) { gA = XN; gN = 3072; E.o16 = BUFB; E.ldc = 3072; }
            else { gA = BUFC; gN = 3072; E.o16 = BUFB; E.ldc = 3072; g_grp = (size_t)TC * 1024 * 2; g_shift = 2; ngemm = 2; } }
        else if (s == 4) {
            if (!odd) dil_attn_phase(lds, BUFB, BUFC, (float*)(AR + AR_C + (size_t)3 * TC * 512 * 2), (const float*)(ws + WS_ROPE), S);
            else { do_gemm = true; gA = (u16*)(RA + (size_t)TC * 4096); gB = (u16*)(ws + WS_WMIX + WMIX_B); gN = 5120; gK = 384; E.mode = 4; E.o16 = BUFC; E.b0 = p.in[17] + (size_t)e * 2048; E.b1 = p.in[20] + (size_t)e * 2048; }
        }
        else if (s == 5) {
            if (!odd) merge_conv_phase(BUFB, BUFC, (const float*)(AR + AR_C + (size_t)3 * TC * 512 * 2), p.in[11] + (size_t)e * 3 * 512, Y, S);
            else scan_phase(lds, BUFB, BUFC, p.in[25] + (size_t)e * 1024, p.in[26] + (size_t)e * 1024, p.in[27] + (size_t)e * 1024, (u16*)RA, (float*)(RA + (size_t)TC * 4096), S);
        }
        else if (s == 6) rwkv_post_phase((const u16*)RA, (const float*)(RA + (size_t)TC * 4096), BUFB, BUFC, p.in[28] + (size_t)e * 1024, p.in[29] + (size_t)e * 1024, Y);
        else if (s == 7) { do_gemm = true; gA = Y; gB = odd ? (u16*)(ws + WS_WMIX + WMIX_C) : (u16*)(ws + WS_WMIX) + (size_t)3072 * 1024; E.mode = 1; E.x = Xc; E.xin = (l == 0) ? Xin0 : nullptr; E.ssw = SSC; }
        else if (s == 9) { do_gemm = true; gA = Xc; gB = (u16*)(ws + WS_WQ); E.o16 = BUFB; E.ldc = 1024; E.ssr = SSC; }
        else if (s == 11) { do_gemm = true; gA = BUFC; gB = (u16*)(ws + WS_WO); E.mode = 1; E.x = Xc; E.xin = nullptr; E.ssw = SSF; }
        else if (s == 13) { do_gemm = true; gA = Xc; gB = (u16*)(ws + WS_WGU); gN = 5632; E.mode = 2; E.o16 = BUFB; E.ssr = SSF; }
        else if (s == 14) { do_gemm = true; gA = BUFB; gB = (u16*)(ws + WS_WDN); gK = 2816; E.mode = 1; E.x = Xc; E.xin = nullptr; }
        }
        if (do_gemm) {
            for (int gi = 0; gi < ngemm; ++gi) {
                if (gi == 1) { gA = XN; gB = (u16*)(ws + WS_WMIX) + (size_t)3072 * 1024; gN = 512; gK = 2048; g_grp = 0; g_shift = 0; E.mode = 3; E.o16 = (u16*)(RA + (size_t)TC * 4096); }
                pg8::Gemm g{gA, gB, gM, gN, gK, g_grp, g_shift}; pg8::StaticOrder SO; SO.init(gM, gN, (int)gridDim.x, (int)blockIdx.x);
                pg8::gemm_phase<pg8::EpiAny, pg8::StaticOrder, false>(lds, g, SO, E, nullptr);
            }
        }
        if (s == 9) {
            pg8::StaticOrder SO2; SO2.init(TC, 1024, (int)gridDim.x, (int)blockIdx.x); pg8::Unit u;
            for (int it = 0; SO2.next(it >> 1, u); ++it) { const int t0 = u.pm * 256, seq = t0 / S, qt = ((t0 % S) >> 7) + (it & 1);
                cross_attn_unit(lds, BUFB, (const u16*)(ws + WS_KV), c < 2 ? c * 1024 : 2048, BUFC, S, seq, u.pn, qt); }
        }
        {
            const int nc = (s == 2 && c == 0) ? 0 : ((s == 14 && c < 2) ? c + 1 : -1);
            if (nc >= 0) {
                const int Sn = nc < 2 ? 4096 : 2048;
                const float* xs = (nc < 2 ? p.in[0] + (size_t)nc * TC * 1024 : p.in[1]);
                const u16* xh = (l == 0) ? nullptr : Xb + (size_t)nc * TC * 1024;
                for (size_t i = (size_t)blockIdx.x * NTHREADS + ltid(); i < (size_t)2 * TC; i += gstride) SSC[i] = 0ull;
                if (odd) norm_shift(xs, xh, p.in[4] + l * 1024, p.in[12] + (size_t)e * 6 * 1024, XN, BUFC, Sn);
                else norm_rows(xs, xh, p.in[4] + l * 1024, XN, 1024, TC);
            }
        }
        if (s == 1) continue;
        for (int dup = 0; dup < DUP_SYNC; ++dup) xcd_barrier(xbar);
    }
    norm_final(Xb, p.out, p.in[8], 49152);
}

extern "C" void kernel_launch(void* const* d_in, const int* in_sizes, int n_in, void* d_out, int out_size, void* d_ws, size_t ws_size, hipStream_t stream) {
    static int grid_blocks = 0;
    if (!grid_blocks) {
        int dev = 0, cus = 0, per_cu = 0;
        if (n_in != 35 || out_size != 49152 * 1024 || ws_size < WS_END) { fprintf(stderr, "kernel_launch: unexpected problem (n_in %d out %d ws %zu need %zu)\n", n_in, out_size, ws_size, (size_t)WS_END); grid_blocks = -1; return; }
        (void)hipGetDevice(&dev);
        (void)hipDeviceGetAttribute(&cus, hipDeviceAttributeMultiprocessorCount, dev);
        (void)hipFuncSetAttribute((const void*)mega, hipFuncAttributeMaxDynamicSharedMemorySize, LDS_BYTES);
        (void)hipOccupancyMaxActiveBlocksPerMultiprocessor(&per_cu, (const void*)mega, NTHREADS, LDS_BYTES);
        if (per_cu < 1) { fprintf(stderr, "kernel_launch: occupancy query says %d blocks per CU\n", per_cu); }
        grid_blocks = cus > 0 ? cus : 256;
    }
    if (grid_blocks < 0) return;
    Params p{};
    for (int i = 0; i < 35; ++i) p.in[i] = (const float*)d_in[i];
    p.out = (float*)d_out; p.ws = (unsigned char*)d_ws;
    void* args[] = {&p};
    hipError_t err = hipLaunchCooperativeKernel((void*)mega, dim3(grid_blocks), dim3(NTHREADS), args, LDS_BYTES, stream);
    if (err != hipSuccess) fprintf(stderr, "cooperative launch failed: %s (grid %d)\n", hipGetErrorString(err), grid_blocks);
}
```

```cpp
#include <hip/hip_runtime.h>
#include <hip/hip_cooperative_groups.h>
#include <cstdio>
namespace cg = cooperative_groups;

#define LAS __attribute__((address_space(3)))
typedef unsigned short u16;
typedef short bf16x8 __attribute__((ext_vector_type(8)));
typedef float f32x4 __attribute__((ext_vector_type(4)));
typedef float f32x2 __attribute__((ext_vector_type(2)));
typedef unsigned u32x4 __attribute__((ext_vector_type(4)));
typedef unsigned u32x2 __attribute__((ext_vector_type(2)));

constexpr int DM = 1024;
constexpr int TC = 16384;
constexpr int NCHUNK = 3;
constexpr int NTHREADS = 512;
constexpr int LDS_BYTES = 139264;

__device__ __forceinline__ unsigned cvt_pk_bf16(float lo, float hi) { unsigned r; asm volatile("v_cvt_pk_bf16_f32 %0, %1, %2" : "=v"(r) : "v"(lo), "v"(hi)); return r; }
__device__ __forceinline__ u16 f2bf(float x) { return (u16)(cvt_pk_bf16(x, 0.f) & 0xffffu); }
__device__ __forceinline__ float bf2f(u16 b) { return __uint_as_float(((unsigned)b) << 16); }
__device__ __forceinline__ float bflo(unsigned w) { return __uint_as_float(w << 16); }
__device__ __forceinline__ float bfhi(unsigned w) { return __uint_as_float(w & 0xffff0000u); }
__device__ __forceinline__ float sigmoidf_(float x) { return 1.0f / (1.0f + __expf(-x)); }
__device__ __forceinline__ float wave_sum(float v) {
#pragma unroll
    for (int o = 32; o >= 1; o >>= 1) v += __shfl_xor(v, o);
    return v;
}
constexpr int WVMAP_OFF = LDS_BYTES - 16 - 256;
__device__ __forceinline__ unsigned hw_slot() { return (unsigned)__builtin_amdgcn_s_getreg((5 << 11) | 4) & 63u; }
__device__ __forceinline__ int ltid() {
    extern __shared__ __attribute__((aligned(16))) unsigned char lds_dyn_[];
    const int wv = __builtin_amdgcn_readfirstlane(*(const volatile LAS int*)((LAS unsigned char*)lds_dyn_ + WVMAP_OFF + hw_slot() * 4));
    int lane; asm volatile("v_mbcnt_lo_u32_b32 %0, -1, 0\n\tv_mbcnt_hi_u32_b32 %0, -1, %0" : "=v"(lane));
    return (wv << 6) | lane;
}
__device__ __forceinline__ void ltid_setup() {
    extern __shared__ __attribute__((aligned(16))) unsigned char lds_dyn_[];
    if ((threadIdx.x & 63) == 0) *(volatile LAS int*)((LAS unsigned char*)lds_dyn_ + WVMAP_OFF + hw_slot() * 4) = (int)(threadIdx.x >> 6);
    __syncthreads();
}
#define XB_TMO      128
#define XB_XCNT(j)  (256  + 64 * (j))
#define XB_XSUB(j)  (1280 + 64 * (j))
#define XB_XGEN(j)  (2304 + 64 * (j))
#define XB_TOP      3328
#define XB_TOPGEN   3392
#define XCD_BAR_WORDS 3456
#define XB_SPIN_CAP (1u << 18)

__device__ __forceinline__ unsigned xb_ld(unsigned* p)              { return __hip_atomic_load(p, __ATOMIC_RELAXED, __HIP_MEMORY_SCOPE_AGENT); }
__device__ __forceinline__ unsigned xb_add(unsigned* p, unsigned v) { return __hip_atomic_fetch_add(p, v, __ATOMIC_RELAXED, __HIP_MEMORY_SCOPE_AGENT); }
__device__ __forceinline__ unsigned xb_xcc_id() { return (unsigned)__builtin_amdgcn_s_getreg((3 << 11) | 20) & 0xFu; }
#define XB_SPIN(cond, bar) do { unsigned _sp = 0; while (cond) { __builtin_amdgcn_s_sleep(1); \
    if ((++_sp & 255u) == 0u) { if (xb_ld(&(bar)[XB_TMO])) break; if (_sp > XB_SPIN_CAP) { atomicAdd(&(bar)[XB_TMO], 1u); break; } } } } while (0)

struct XcdBarrier {
    unsigned* bar; unsigned x;
    volatile LAS unsigned* st;
};

__device__ __forceinline__ XcdBarrier xcd_barrier_post(unsigned* bar, volatile LAS unsigned* st) {
    XcdBarrier b; b.bar = bar; b.x = xb_xcc_id(); b.st = st;
    if (ltid() == 0) (void)xb_add(&bar[XB_XCNT(b.x)], 1u);
    return b;
}
__device__ __forceinline__ void xcd_barrier_complete(unsigned* bar, unsigned x, unsigned& nloc, unsigned& nx) {
    const unsigned G = gridDim.x * gridDim.y * gridDim.z;
    unsigned sum, cnt, mine, sp = 0u;
    for (;;) {
        sum = 0u; cnt = 0u; mine = 0u;
#pragma unroll
        for (unsigned j = 0; j < 16; ++j) { const unsigned c = xb_ld(&bar[XB_XCNT(j)]); sum += c; cnt += (c > 0u) ? 1u : 0u; mine = (j == x) ? c : mine; }
        if (sum == G) break;
        __builtin_amdgcn_s_sleep(1);
        if ((++sp & 255u) == 0u) { if (xb_ld(&bar[XB_TMO])) break; if (sp > XB_SPIN_CAP) { atomicAdd(&bar[XB_TMO], 1u); break; } }
    }
    nloc = mine > 0u ? mine : 1u; nx = cnt > 0u ? cnt : 1u;
}

__device__ __forceinline__ void xcd_barrier(const XcdBarrier& b) {
    asm volatile("s_waitcnt vmcnt(0)" ::: "memory");
    __syncthreads();
    if (ltid() == 0) {
        unsigned* bar = b.bar;
        __builtin_amdgcn_s_waitcnt(0);
        unsigned nloc = b.st[0], nx = b.st[1];
        if (nloc == 0u) { xcd_barrier_complete(bar, b.x, nloc, nx); b.st[0] = nloc; b.st[1] = nx; }
        const unsigned old = xb_add(&bar[XB_XSUB(b.x)], 1u);
        const unsigned gen = old / nloc;
        if (old + 1u == (gen + 1u) * nloc) {
            __builtin_amdgcn_fence(__ATOMIC_RELEASE, "agent");
            asm volatile("s_waitcnt vmcnt(0)" ::: "memory");
            const unsigned og = xb_add(&bar[XB_TOP], 1u);
            const unsigned tg = og / nx;
            if (og + 1u == (tg + 1u) * nx) xb_add(&bar[XB_TOPGEN], 1u);
            else XB_SPIN(xb_ld(&bar[XB_TOPGEN]) == tg, bar);
            __builtin_amdgcn_fence(__ATOMIC_ACQUIRE, "agent");
            xb_add(&bar[XB_XGEN(b.x)], 1u);
            asm volatile("s_waitcnt vmcnt(0)" ::: "memory");
        } else {
            XB_SPIN(xb_ld(&bar[XB_XGEN(b.x)]) == gen, bar);
            __builtin_amdgcn_fence(__ATOMIC_ACQUIRE, "agent");
            asm volatile("s_waitcnt vmcnt(0)" ::: "memory");
        }
    }
    __syncthreads();
}
namespace pg8 {
#define PG8_LAS __attribute__((address_space(3)))
typedef unsigned short bf16_t;
typedef short bf16x8 __attribute__((ext_vector_type(8)));
typedef float f32x4 __attribute__((ext_vector_type(4)));
typedef unsigned u32x4 __attribute__((ext_vector_type(4)));
constexpr int BM = 256, BK = 64, HALF = 128, HTB = HALF * BK * 2  , STAGE_BYTES = 8 * HTB, NXCD = 8, WGM = 8;

__host__ __device__ __forceinline__ int lds_byte(int r, int c) { const int st = (r >> 4) * 2 + (c >> 5), rr = r & 15, cc = c & 31, ob = rr * 64 + cc * 2; return st * 1024 + (ob ^ (((ob >> 9) & 1) << 5)); }
__host__ __device__ __forceinline__ void stage_rc(int b, int& R, int& C) { const int st = b / 1024, sb = b % 1024, swz = sb ^ (((sb >> 9) & 1) << 5); R = (st >> 1) * 16 + swz / 64; C = (st & 1) * 32 + (swz % 64) / 2; }
__host__ __device__ __forceinline__ int perm32(int rho) { const int n = rho >> 4, i = rho & 15; return 8 * (i >> 2) + 4 * n + (i & 3); }

struct Unit { int pm, pn; };
struct Gemm { const bf16_t* A; const bf16_t* Bt; int M, N, K; size_t a_grp_bytes; int a_grp_shift; };

struct StaticOrder {
    int nM, nN, nwg, G, c;
    __host__ __device__ __forceinline__ void init(int M, int N, int G_, int c_) { nM = M / BM; nN = N / BM; nwg = nM * nN; G = G_; c = c_; }
    __host__ __device__ __forceinline__ bool next(int i, Unit& u) const {
        const long L = (long)i * G + c; if (L >= nwg) return false;
        int wgid = (int)L; { const int q = nwg / NXCD, r = nwg % NXCD, xcd = wgid % NXCD, off = wgid / NXCD; wgid = (xcd < r ? xcd * (q + 1) : r * (q + 1) + (xcd - r) * q) + off; }
        const int nig = WGM * nN, gid = wgid / nig, fm = gid * WGM, gsz = (nM - fm) < WGM ? (nM - fm) : WGM;
        u.pm = fm + ((wgid % nig) % gsz); u.pn = (wgid % nig) / gsz; return true;
    }
    __device__ __forceinline__ void a_ready(const Unit&) const {}
    __device__ __forceinline__ void done(const Unit&) const {}
};
struct EpiStore16 {
    static constexpr bool PERM = true, AFTER_DRAIN = false;
    u16* O; int ldc; const unsigned long long* SS;
    __device__ __forceinline__ void operator()(const f32x4 (&acc)[2][2][4][2], const Unit& u, int wr, int wc, int fr, int fq) const {
        const int row0 = u.pm * BM + wr * 64 + fr, col0 = u.pn * BM + wc * 32 + 8 * fq;
#pragma unroll
        for (int ai = 0; ai < 2; ++ai)
#pragma unroll
            for (int m = 0; m < 4; ++m) { const int row = row0 + ai * HALF + m * 16; u16* rowp = O + (size_t)row * ldc + col0;
                const float rs = SS ? rsqrtf((float)SS[row] * (1.0f / (1024.0f * 1048576.0f)) + 1e-6f) : 1.0f;
#pragma unroll
                for (int bj = 0; bj < 2; ++bj) { const f32x4 v0 = acc[ai][bj][m][0] * rs, v1 = acc[ai][bj][m][1] * rs; u32x4 w; w.x = cvt_pk_bf16(v0[0], v0[1]); w.y = cvt_pk_bf16(v0[2], v0[3]); w.z = cvt_pk_bf16(v1[0], v1[1]); w.w = cvt_pk_bf16(v1[2], v1[3]);
                    *(u32x4*)(rowp + bj * HALF) = w; } }
    }
};
struct EpiResid {
    static constexpr bool PERM = true, AFTER_DRAIN = false;
    u16* Xb; const float* Xin32; unsigned long long* SS;
    __device__ __forceinline__ void operator()(const f32x4 (&acc)[2][2][4][2], const Unit& u, int wr, int wc, int fr, int fq) const {
        const int row0 = u.pm * BM + wr * 64 + fr, col0 = u.pn * BM + wc * 32 + 8 * fq;
#pragma unroll
        for (int ai = 0; ai < 2; ++ai)
#pragma unroll
            for (int m = 0; m < 4; ++m) { const int row = row0 + ai * HALF + m * 16; const unsigned off = (unsigned)(row * 1024 + col0); float ss = 0.f;
#pragma unroll
                for (int bj = 0; bj < 2; ++bj) { const unsigned o = off + bj * HALF; f32x4 x0, x1;
                    if (Xin32) { x0 = *(const f32x4*)(Xin32 + o); x1 = *(const f32x4*)(Xin32 + o + 4); }
                    else { const u32x4 h = *(const u32x4*)(Xb + o); x0 = (f32x4){bflo(h.x), bfhi(h.x), bflo(h.y), bfhi(h.y)}; x1 = (f32x4){bflo(h.z), bfhi(h.z), bflo(h.w), bfhi(h.w)}; }
                    const f32x4 v0 = x0 + acc[ai][bj][m][0], v1 = x1 + acc[ai][bj][m][1];
                    u32x4 w; w.x = cvt_pk_bf16(v0[0], v0[1]); w.y = cvt_pk_bf16(v0[2], v0[3]); w.z = cvt_pk_bf16(v1[0], v1[1]); w.w = cvt_pk_bf16(v1[2], v1[3]);
                    *(u32x4*)(Xb + o) = w;
                    if (SS) ss += (v0[0] * v0[0] + v0[1] * v0[1]) + (v0[2] * v0[2] + v0[3] * v0[3]) + (v1[0] * v1[0] + v1[1] * v1[1]) + (v1[2] * v1[2] + v1[3] * v1[3]); }
                if (SS) { ss += __shfl_xor(ss, 16); ss += __shfl_xor(ss, 32); if (fq == 0) atomicAdd(SS + row, (unsigned long long)(ss * 1048576.0f)); } }
    }
};
struct EpiSwiglu {
    static constexpr bool PERM = true, AFTER_DRAIN = false;
    u16* H; const unsigned long long* SS;
    __device__ __forceinline__ void operator()(const f32x4 (&acc)[2][2][4][2], const Unit& u, int wr, int wc, int fr, int fq) const {
        const int row0 = u.pm * BM + wr * 64 + fr, col0 = u.pn * 128 + wc * 16 + 4 * fq;
#pragma unroll
        for (int ai = 0; ai < 2; ++ai)
#pragma unroll
            for (int m = 0; m < 4; ++m) { const int row = row0 + ai * HALF + m * 16; u16* rowp = H + (size_t)row * 2816 + col0;
                const float rs = rsqrtf((float)SS[row] * (1.0f / (1024.0f * 1048576.0f)) + 1e-6f);
#pragma unroll
                for (int bj = 0; bj < 2; ++bj) { const f32x4 g = acc[ai][bj][m][0] * rs, up = acc[ai][bj][m][1] * rs; float h[4];
#pragma unroll
                    for (int j = 0; j < 4; ++j) h[j] = g[j] / (1.0f + __expf(-g[j])) * up[j];
                    u32x2 w; w.x = cvt_pk_bf16(h[0], h[1]); w.y = cvt_pk_bf16(h[2], h[3]); *(u32x2*)(rowp + bj * 64) = w; } }
    }
};
struct EpiRwkv {
    static constexpr bool PERM = true, AFTER_DRAIN = false;
    u16* L1;
    __device__ __forceinline__ void operator()(const f32x4 (&acc)[2][2][4][2], const Unit& u, int wr, int wc, int fr, int fq) const {
        const int row0 = u.pm * BM + wr * 64 + fr;
        const int col0 = u.pn * BM + wc * 32 + 8 * fq; const int t = u.pn;
#pragma unroll
        for (int ai = 0; ai < 2; ++ai)
#pragma unroll
            for (int m = 0; m < 4; ++m) { u16* rowp = L1 + (size_t)(row0 + ai * HALF + m * 16) * 384 + col0;
#pragma unroll
                for (int bj = 0; bj < 2; ++bj) if (!(t == 1 && bj == 1)) {
#pragma unroll
                    for (int n = 0; n < 2; ++n) { f32x4 v = acc[ai][bj][m][n];
#pragma unroll
                        for (int j = 0; j < 4; ++j) { float x = v[j]; if (t == 1) x = sigmoidf_(x); else if (bj == 0) x = tanhf(x); v[j] = x; }
                        u32x2 w; w.x = cvt_pk_bf16(v[0], v[1]); w.y = cvt_pk_bf16(v[2], v[3]); *(u32x2*)(rowp + bj * HALF + n * 4) = w; } } }
    }
};
struct EpiLora2 {
    static constexpr bool PERM = true, AFTER_DRAIN = false;
    u16* EAG; const float* w0; const float* a0; int M;
    __device__ __forceinline__ void operator()(const f32x4 (&acc)[2][2][4][2], const Unit& u, int wr, int wc, int fr, int fq) const {
        const int row0 = u.pm * BM + wr * 64 + fr; const int sel = u.pn >> 2; const int col0 = (u.pn & 3) * BM + wc * 32 + 8 * fq;
        u16* base = EAG + (size_t)sel * M * 1024;
        const float* bias = sel < 2 ? (w0 + sel * 1024) : (a0 + ((sel - 2) & 1) * 1024);
        f32x4 bv[2][2];
#pragma unroll
        for (int bj = 0; bj < 2; ++bj)
#pragma unroll
            for (int n = 0; n < 2; ++n) bv[bj][n] = (sel < 4) ? *(const f32x4*)(bias + col0 + bj * HALF + n * 4) : (f32x4){0.f, 0.f, 0.f, 0.f};
#pragma unroll
        for (int ai = 0; ai < 2; ++ai)
#pragma unroll
            for (int m = 0; m < 4; ++m) { u16* rowp = base + (size_t)(row0 + ai * HALF + m * 16) * 1024 + col0;
#pragma unroll
                for (int bj = 0; bj < 2; ++bj)
#pragma unroll
                    for (int n = 0; n < 2; ++n) { const f32x4 v = acc[ai][bj][m][n] + bv[bj][n]; u32x2 w;
                        if (sel < 2) { _Float16 h[4];
#pragma unroll
                            for (int j = 0; j < 4; ++j) h[j] = (_Float16)(0.60653066f * sigmoidf_(v[j]));
                            w.x = (unsigned)__builtin_bit_cast(u16, h[0]) | ((unsigned)__builtin_bit_cast(u16, h[1]) << 16);
                            w.y = (unsigned)__builtin_bit_cast(u16, h[2]) | ((unsigned)__builtin_bit_cast(u16, h[3]) << 16);
                        } else if (sel < 4) { w.x = cvt_pk_bf16(sigmoidf_(v[0]), sigmoidf_(v[1])); w.y = cvt_pk_bf16(sigmoidf_(v[2]), sigmoidf_(v[3]));
                        } else { w.x = cvt_pk_bf16(v[0], v[1]); w.y = cvt_pk_bf16(v[2], v[3]); }
                        *(u32x2*)(rowp + bj * HALF + n * 4) = w; } }
    }
};
template <class Epi, class Sched, bool STAMP = false>
__device__ __forceinline__ void gemm_phase(PG8_LAS unsigned char* lds, const Gemm g, const Sched& S, const Epi& E, unsigned long long* stamps) {
    const int tid = ltid(), wid = __builtin_amdgcn_readfirstlane(tid >> 6), lane = tid & 63, wr = wid >> 2, wc = wid & 3, fr = lane & 15, fq = lane >> 4;
    const int K = g.K, nt = K / BK;
    int ts_lo = 0, ts_hi = 0, nts = 0; const unsigned long long rt_entry = STAMP ? (unsigned long long)wall_clock64() : 0ull;
#define PG8_STAMP() do { if (STAMP && wid == 0 && nts < 64) { const unsigned long long _c = (unsigned long long)clock64(); \
        ts_lo = (lane == nts) ? (int)(unsigned)_c : ts_lo; ts_hi = (lane == nts) ? (int)(unsigned)(_c >> 32) : ts_hi; ++nts; } } while (0)
    PG8_STAMP();
    unsigned voffA[2], voffB[2];
#pragma unroll
    for (int i = 0; i < 2; ++i) { int R, C; stage_rc(tid * 16 + i * 8192, R, C); const int Rb = Epi::PERM ? ((R & ~31) + perm32(R & 31)) : R;
        voffA[i] = (unsigned)(R * K + C) * 2u; voffB[i] = (unsigned)(Rb * K + C) * 2u; }
    const size_t kstep = (size_t)(BK * 2);
    const size_t hstep = (size_t)HALF * K * 2;
    const size_t tstep = 2 * hstep;
    const unsigned ldsw = (unsigned)wid * 1024u;
    const int aoff = lds_byte(wr * 64 + fr, fq * 8), boff = lds_byte(wc * 32 + fr, fq * 8);
#define PG8_SA(b, h) (((b) * 2 + (h)) * HTB)
#define PG8_SB(b, h) ((4 + (b) * 2 + (h)) * HTB)
#define PG8_STAGE(bufoff, gbase, voff) do { _Pragma("unroll") for (int _i = 0; _i < 2; ++_i) \
        __builtin_amdgcn_global_load_lds((const unsigned*)((const char*)(gbase) + (voff)[_i]), (PG8_LAS unsigned*)(lds + (bufoff) + ldsw + _i * 8192), 16, 0, 0); } while (0)
#define PG8_LDA(dst, b, h) do { _Pragma("unroll") for (int m = 0; m < 4; ++m) _Pragma("unroll") for (int k = 0; k < 2; ++k) dst[m][k] = *(const PG8_LAS bf16x8*)(lds + PG8_SA(b, h) + aoff + m * 2048 + k * 1024); } while (0)
#define PG8_LDB(dst, b, h) do { _Pragma("unroll") for (int n = 0; n < 2; ++n) _Pragma("unroll") for (int k = 0; k < 2; ++k) dst[n][k] = *(const PG8_LAS bf16x8*)(lds + PG8_SB(b, h) + boff + n * 2048 + k * 1024); } while (0)
#define PG8_MMA(ai, bj, At, Bt) do { __builtin_amdgcn_s_setprio(1); _Pragma("unroll") for (int m = 0; m < 4; ++m) _Pragma("unroll") for (int n = 0; n < 2; ++n) _Pragma("unroll") for (int k = 0; k < 2; ++k) \
        acc[ai][bj][m][n] = __builtin_amdgcn_mfma_f32_16x16x32_bf16(Bt[n][k], At[m][k], acc[ai][bj][m][n], 0, 0, 0); __builtin_amdgcn_s_setprio(0); } while (0)
#define PG8_WAIT_V(n) asm volatile("s_waitcnt vmcnt(" #n ")" ::: "memory")
#define PG8_WAIT_L(n) asm volatile("s_waitcnt lgkmcnt(" #n ")" ::: "memory")
#define PG8_BAR __builtin_amdgcn_s_barrier()
#define PG8_SCHED __builtin_amdgcn_sched_barrier(0)
    Unit cur, nxt; int ui = 0;
    if (!S.next(0, cur)) return;
    f32x4 acc[2][2][4][2];
#pragma unroll
    for (int a = 0; a < 2; ++a)
#pragma unroll
        for (int b = 0; b < 2; ++b)
#pragma unroll
            for (int m = 0; m < 4; ++m)
#pragma unroll
                for (int n = 0; n < 2; ++n) acc[a][b][m][n] = (f32x4){0.f, 0.f, 0.f, 0.f};
    bf16x8 At[4][2], B0[2][2], B1[2][2];
    const char* cA = (const char*)g.A + (size_t)cur.pm * tstep + (size_t)(cur.pn >> g.a_grp_shift) * g.a_grp_bytes; const char* cB = (const char*)g.Bt + (size_t)cur.pn * tstep;
    S.a_ready(cur);
    PG8_STAGE(PG8_SB(0, 0), cB, voffB); PG8_STAGE(PG8_SA(0, 0), cA, voffA); PG8_STAGE(PG8_SB(0, 1), cB + hstep, voffB); PG8_STAGE(PG8_SA(0, 1), cA + hstep, voffA);
    if (wr == 1) PG8_BAR;
    PG8_WAIT_V(4); PG8_BAR;
    PG8_STAGE(PG8_SB(1, 0), cB + kstep, voffB); PG8_STAGE(PG8_SA(1, 0), cA + kstep, voffA); PG8_STAGE(PG8_SB(1, 1), cB + hstep + kstep, voffB);
    PG8_WAIT_V(6); PG8_BAR;
    PG8_STAMP();
    for (;;) {
        const bool has_next = S.next(ui + 1, nxt);
        const char* nA = has_next ? (const char*)g.A + (size_t)nxt.pm * tstep + (size_t)(nxt.pn >> g.a_grp_shift) * g.a_grp_bytes : cA; const char* nB = has_next ? (const char*)g.Bt + (size_t)nxt.pn * tstep : cB;
        for (int t = 0; t < nt; t += 2) {
            const bool last = (t == nt - 2);
            const char* a1 = cA + (size_t)(t + 1) * kstep;
            const char* a2 = last ? nA : cA + (size_t)(t + 2) * kstep; const char* b2 = last ? nB : cB + (size_t)(t + 2) * kstep;
            const char* a3 = a2 + kstep; const char* b3 = b2 + kstep;
            if (last && has_next) S.a_ready(nxt);
            PG8_LDB(B0, 0, 0); PG8_SCHED; PG8_LDA(At, 0, 0); PG8_STAGE(PG8_SA(1, 1), a1 + hstep, voffA);
            PG8_WAIT_L(8); PG8_BAR; PG8_WAIT_L(0); PG8_MMA(0, 0, At, B0); PG8_BAR; PG8_SCHED;
            PG8_LDB(B1, 0, 1); PG8_STAGE(PG8_SB(0, 0), b2, voffB);
            PG8_BAR; PG8_WAIT_L(0); PG8_MMA(0, 1, At, B1); PG8_BAR;
            PG8_LDA(At, 0, 1); PG8_STAGE(PG8_SA(0, 0), a2, voffA);
            PG8_BAR; PG8_WAIT_L(0); PG8_MMA(1, 0, At, B0); PG8_BAR; PG8_SCHED;
            PG8_STAGE(PG8_SB(0, 1), b2 + hstep, voffB);
            PG8_WAIT_V(6); PG8_BAR; PG8_MMA(1, 1, At, B1); PG8_BAR;
            PG8_LDB(B0, 1, 0); PG8_SCHED; PG8_LDA(At, 1, 0); PG8_STAGE(PG8_SA(0, 1), a2 + hstep, voffA);
            PG8_WAIT_L(8); PG8_BAR; PG8_WAIT_L(0); PG8_MMA(0, 0, At, B0); PG8_BAR; PG8_SCHED;
            PG8_LDB(B1, 1, 1); PG8_STAGE(PG8_SB(1, 0), b3, voffB);
            PG8_BAR; PG8_WAIT_L(0); PG8_MMA(0, 1, At, B1); PG8_BAR;
            PG8_LDA(At, 1, 1); PG8_STAGE(PG8_SA(1, 0), a3, voffA);
            PG8_BAR; PG8_WAIT_L(0); PG8_MMA(1, 0, At, B0); PG8_BAR; PG8_SCHED;
            PG8_STAGE(PG8_SB(1, 1), b3 + hstep, voffB);
            PG8_WAIT_V(6); PG8_BAR; PG8_MMA(1, 1, At, B1); PG8_BAR;
        }
        PG8_STAMP();
        if constexpr (!Epi::AFTER_DRAIN) { E(acc, cur, wr, wc, fr, fq); S.done(cur); }
        PG8_STAMP();
        if (!has_next) break;
#pragma unroll
        for (int a = 0; a < 2; ++a)
#pragma unroll
            for (int b = 0; b < 2; ++b)
#pragma unroll
                for (int m = 0; m < 4; ++m)
#pragma unroll
                    for (int n = 0; n < 2; ++n) acc[a][b][m][n] = (f32x4){0.f, 0.f, 0.f, 0.f};
        cur = nxt; cA = nA; cB = nB; ++ui;
    }
    PG8_WAIT_V(0);
    if (wr == 0) PG8_BAR;
    PG8_BAR;
    if constexpr (Epi::AFTER_DRAIN) { E.fused(acc, cur, wr, wc, fr, fq, lds, wid, lane); S.done(cur); }
    PG8_STAMP();
    if (STAMP && wid == 0) { stamps[lane] = lane < nts ? (((unsigned long long)(unsigned)ts_hi << 32) | (unsigned)ts_lo) : 0ull;
        if (lane == 62) stamps[62] = rt_entry; if (lane == 63) stamps[63] = (unsigned long long)wall_clock64(); }
#undef PG8_STAMP
#undef PG8_SA
#undef PG8_SB
#undef PG8_STAGE
#undef PG8_LDA
#undef PG8_LDB
#undef PG8_MMA
#undef PG8_WAIT_V
#undef PG8_WAIT_L
#undef PG8_BAR
#undef PG8_SCHED
}
}
struct Params { const float* in[35]; float* out; unsigned char* ws; int pad0, pad1; };

constexpr size_t MB = 1u << 20;
constexpr size_t WS_WMIX  = 0;
constexpr size_t WMIX_B   = (size_t)3584 * 2048 * 2;
constexpr size_t WMIX_C   = WMIX_B + (size_t)5120 * 512 * 2;
constexpr size_t WS_WQ    = WS_WMIX + WMIX_C + (size_t)1024 * 1024 * 2;
constexpr size_t WS_WKV   = WS_WQ + (size_t)1024 * 1024 * 2;
constexpr size_t WS_WO    = WS_WKV + (size_t)2048 * 1024 * 2;
constexpr size_t WS_WGU   = WS_WO + (size_t)1024 * 1024 * 2;
constexpr size_t WS_WDN   = WS_WGU + (size_t)5632 * 1024 * 2;
constexpr size_t WS_MN    = WS_WDN + (size_t)1024 * 2816 * 2;
constexpr size_t WS_KV    = WS_MN + (size_t)4096 * 1024 * 2;
constexpr size_t WS_ROPE  = WS_KV + (size_t)4096 * 2048 * 2;
constexpr size_t WS_ARENA = WS_ROPE + (size_t)4096 * 16 * 4;
constexpr size_t AR_A = 0, AR_B = (size_t)TC * 8192, AR_C = (size_t)TC * 14336, AR_D = (size_t)TC * 24576, AR_END = (size_t)TC * 26624;
constexpr size_t WS_BAR = WS_ARENA + AR_END;
constexpr size_t WS_SS = WS_BAR + 16384;
constexpr size_t WS_END = WS_SS + (size_t)2 * TC * 8;

__device__ __forceinline__ int map_row(int n, int mode) {
    if (mode == 0) return n;
    const int up = n >= 2816, c = up ? n - 2816 : n;
    return (c >> 4) * 32 + ((c & 15) >> 2) * 8 + up * 4 + (c & 3);
}
__device__ __forceinline__ void tr_job(LAS unsigned char* lds, const float* __restrict__ src, int ld_src, int K, int N, u16* dst, int ld_dst, int col0, const float* __restrict__ s1, int mode, int rot) {
    LAS float* T = (LAS float*)lds;
    const int tid = ltid(), nkt = K >> 6, nnt = N >> 6, ntile = nkt * nnt;
    for (int t = (blockIdx.x + rot) % gridDim.x; t < ntile; t += gridDim.x) {
        const int kt = t / nnt, nt = t % nnt;
#pragma unroll
        for (int it = 0; it < 2; ++it) {
            const int kk = (tid >> 4) + it * 32, n4 = (tid & 15) * 4;
            f32x4 v = *(const f32x4*)(src + (size_t)(kt * 64 + kk) * ld_src + nt * 64 + n4);
            const float s = s1 ? s1[kt * 64 + kk] : 1.0f;
#pragma unroll
            for (int e = 0; e < 4; ++e) T[(n4 + e) * 65 + kk] = v[e] * s;
        }
        __syncthreads();
        {
            const int n = tid >> 3, k8 = (tid & 7) * 8; float f[8];
#pragma unroll
            for (int e = 0; e < 8; ++e) f[e] = T[n * 65 + k8 + e];
            u32x4 w; w.x = cvt_pk_bf16(f[0], f[1]); w.y = cvt_pk_bf16(f[2], f[3]); w.z = cvt_pk_bf16(f[4], f[5]); w.w = cvt_pk_bf16(f[6], f[7]);
            *(u32x4*)(dst + (size_t)map_row(nt * 64 + n, mode) * ld_dst + col0 + kt * 64 + k8) = w;
        }
        __syncthreads();
    }
}

__device__ __forceinline__ void norm_rows(const float* __restrict__ X, const u16* __restrict__ Xh, const float* __restrict__ g, u16* dst, int ld_dst, int nrows) {
    const int lane = ltid() & 63, gw = blockIdx.x * 8 + (ltid() >> 6), nw = gridDim.x * 8;
    f32x4 gv[4];
#pragma unroll
    for (int i = 0; i < 4; ++i) gv[i] = *(const f32x4*)(g + i * 256 + lane * 4);
    for (int r = gw; r < nrows; r += nw) {
        f32x4 v[4]; float ss = 0.f;
#pragma unroll
        for (int i = 0; i < 4; ++i) {
            if (Xh) { const u32x2 h = *(const u32x2*)(Xh + (size_t)r * 1024 + i * 256 + lane * 4); v[i] = (f32x4){bflo(h.x), bfhi(h.x), bflo(h.y), bfhi(h.y)}; }
            else v[i] = *(const f32x4*)(X + (size_t)r * 1024 + i * 256 + lane * 4);
            ss += v[i][0] * v[i][0] + v[i][1] * v[i][1] + v[i][2] * v[i][2] + v[i][3] * v[i][3]; }
        ss = wave_sum(ss); const float rs = rsqrtf(ss * (1.0f / 1024.0f) + 1e-6f);
#pragma unroll
        for (int i = 0; i < 4; ++i) { u32x2 w; w.x = cvt_pk_bf16(v[i][0] * rs * gv[i][0], v[i][1] * rs * gv[i][1]); w.y = cvt_pk_bf16(v[i][2] * rs * gv[i][2], v[i][3] * rs * gv[i][3]);
            *(u32x2*)(dst + (size_t)r * ld_dst + i * 256 + lane * 4) = w; }
    }
}
__device__ __forceinline__ void norm_final(const u16* __restrict__ Xh, float* out, const float* __restrict__ g, int nrows) {
    const int lane = ltid() & 63, gw = blockIdx.x * 8 + (ltid() >> 6), nw = gridDim.x * 8;
    f32x4 gv[4];
#pragma unroll
    for (int i = 0; i < 4; ++i) gv[i] = *(const f32x4*)(g + i * 256 + lane * 4);
    for (int r = gw; r < nrows; r += nw) {
        f32x4 v[4]; float ss = 0.f;
#pragma unroll
        for (int i = 0; i < 4; ++i) { const u32x2 h = *(const u32x2*)(Xh + (size_t)r * 1024 + i * 256 + lane * 4); v[i] = (f32x4){bflo(h.x), bfhi(h.x), bflo(h.y), bfhi(h.y)};
            ss += v[i][0] * v[i][0] + v[i][1] * v[i][1] + v[i][2] * v[i][2] + v[i][3] * v[i][3]; }
        ss = wave_sum(ss); const float rs = rsqrtf(ss * (1.0f / 1024.0f) + 1e-6f);
#pragma unroll
        for (int i = 0; i < 4; ++i) *(f32x4*)(out + (size_t)r * 1024 + i * 256 + lane * 4) = v[i] * rs * gv[i];
    }
}
__device__ __forceinline__ void norm_shift(const float* __restrict__ X, const u16* __restrict__ Xh, const float* __restrict__ g, const float* __restrict__ mu, u16* XNX, u16* XM, int S) {
    const int lane = ltid() & 63, gw = blockIdx.x * 8 + (ltid() >> 6), nw = gridDim.x * 8;
    f32x4 gv[4], m0[4], m2[4], m3[4];
#pragma unroll
    for (int i = 0; i < 4; ++i) { gv[i] = *(const f32x4*)(g + i * 256 + lane * 4); m0[i] = *(const f32x4*)(mu + i * 256 + lane * 4); m2[i] = *(const f32x4*)(mu + 2048 + i * 256 + lane * 4); m3[i] = *(const f32x4*)(mu + 3072 + i * 256 + lane * 4); }
    for (int run = gw; run < TC / 8; run += nw) {
        const int r0 = run * 8;
        f32x4 xp[4], xc[4], xq[4];
#define NS_LOAD(dst, rr) do { const int r_ = (rr); const bool in_ = (r_ >= 0) && (r_ < TC) && ((r_ / S) == (r0 / S)); float ss_ = 0.f; \
            _Pragma("unroll") for (int i = 0; i < 4; ++i) { if (!in_) dst[i] = (f32x4){0.f, 0.f, 0.f, 0.f}; \
                else if (Xh) { const u32x2 h_ = *(const u32x2*)(Xh + (size_t)r_ * 1024 + i * 256 + lane * 4); dst[i] = (f32x4){bflo(h_.x), bfhi(h_.x), bflo(h_.y), bfhi(h_.y)}; } \
                else dst[i] = *(const f32x4*)(X + (size_t)r_ * 1024 + i * 256 + lane * 4); \
                ss_ += dst[i][0] * dst[i][0] + dst[i][1] * dst[i][1] + dst[i][2] * dst[i][2] + dst[i][3] * dst[i][3]; } \
            ss_ = wave_sum(ss_); const float rs_ = in_ ? rsqrtf(ss_ * (1.0f / 1024.0f) + 1e-6f) : 0.f; \
            _Pragma("unroll") for (int i = 0; i < 4; ++i) dst[i] = dst[i] * rs_ * gv[i]; } while (0)
        NS_LOAD(xp, r0 - 1); NS_LOAD(xc, r0);
#pragma unroll 1
        for (int k = 0; k < 8; ++k) {
            const int r = r0 + k;
            NS_LOAD(xq, r + 1);
#pragma unroll
            for (int i = 0; i < 4; ++i) { float xn[4], xx[4];
#pragma unroll
                for (int e = 0; e < 4; ++e) { xn[e] = xc[i][e]; xx[e] = 0.5f * (xp[i][e] + xq[i][e]) - xn[e]; }
                const size_t o = (size_t)r * 2048 + i * 256 + lane * 4, om = (size_t)r * 1024 + i * 256 + lane * 4;
                u32x2 w; w.x = cvt_pk_bf16(xn[0], xn[1]); w.y = cvt_pk_bf16(xn[2], xn[3]); *(u32x2*)(XNX + o) = w;
                u32x2 z; z.x = cvt_pk_bf16(xx[0], xx[1]); z.y = cvt_pk_bf16(xx[2], xx[3]); *(u32x2*)(XNX + o + 1024) = z;
                u32x2 a; a.x = cvt_pk_bf16(xn[0] + xx[0] * m0[i][0], xn[1] + xx[1] * m0[i][1]); a.y = cvt_pk_bf16(xn[2] + xx[2] * m0[i][2], xn[3] + xx[3] * m0[i][3]); *(u32x2*)(XM + om) = a;
                u32x2 b; b.x = cvt_pk_bf16(xn[0] + xx[0] * m2[i][0], xn[1] + xx[1] * m2[i][1]); b.y = cvt_pk_bf16(xn[2] + xx[2] * m2[i][2], xn[3] + xx[3] * m2[i][3]); *(u32x2*)(XM + (size_t)TC * 1024 + om) = b;
                u32x2 c; c.x = cvt_pk_bf16(xn[0] + xx[0] * m3[i][0], xn[1] + xx[1] * m3[i][1]); c.y = cvt_pk_bf16(xn[2] + xx[2] * m3[i][2], xn[3] + xx[3] * m3[i][3]); *(u32x2*)(XM + (size_t)2 * TC * 1024 + om) = c; }
#pragma unroll
            for (int i = 0; i < 4; ++i) { xp[i] = xc[i]; xc[i] = xq[i]; }
        }
#undef NS_LOAD
    }
}

__device__ __forceinline__ bf16x8 as_bf16x8(u32x4 v) { return __builtin_bit_cast(bf16x8, v); }
__device__ __forceinline__ u32x4 rot8(u32x4 mine, u32x4 partner, int c, const float* __restrict__ rope, float scale) {
    float cs[16];
#pragma unroll
    for (int i = 0; i < 4; ++i) { const f32x4 t = *(const f32x4*)(rope + 4 * i); cs[4 * i] = t[0]; cs[4 * i + 1] = t[1]; cs[4 * i + 2] = t[2]; cs[4 * i + 3] = t[3]; }
    float o[8];
#pragma unroll
    for (int i = 0; i < 4; ++i) {
        const unsigned mw = mine[i], pw = partner[i];
        const float m0 = bflo(mw), m1 = bfhi(mw), p0 = bflo(pw), p1 = bfhi(pw);
        const float c0 = cs[4 * i], s0 = cs[4 * i + 1], c1 = cs[4 * i + 2], s1 = cs[4 * i + 3];
        if (c == 0) { o[2 * i] = (m0 * c0 - p0 * s0) * scale; o[2 * i + 1] = (m1 * c1 - p1 * s1) * scale; }
        else        { o[2 * i] = (m0 * c0 + p0 * s0) * scale; o[2 * i + 1] = (m1 * c1 + p1 * s1) * scale; }
    }
    u32x4 r; r.x = cvt_pk_bf16(o[0], o[1]); r.y = cvt_pk_bf16(o[2], o[3]); r.z = cvt_pk_bf16(o[4], o[5]); r.w = cvt_pk_bf16(o[6], o[7]); return r;
}
__device__ __forceinline__ u32x4 scale8(u32x4 v, float scale) {
    u32x4 r;
#pragma unroll
    for (int i = 0; i < 4; ++i) r[i] = cvt_pk_bf16(bflo(v[i]) * scale, bfhi(v[i]) * scale);
    return r;
}

__device__ __forceinline__ void dil_attn_phase(LAS unsigned char* lds, const u16* __restrict__ Z, u16* PART, float* LSE, const float* __restrict__ ROPE, int S) {
    const int tid = ltid(), lane = tid & 63, w = tid >> 6, fr = lane & 15, fq = lane >> 4;
    LAS u16* Ks = (LAS u16*)lds;
    LAS u16* Vt = (LAS u16*)(lds + 272 * 144);
    const int upb = S >> 7, nunits = (TC / S) * 8 * 3 * upb;
    for (int u = blockIdx.x; u < nunits; u += gridDim.x) {
        const int sh = u / (3 * upb), rem = u % (3 * upb), g = rem / upb, idx = rem % upb, seq = sh >> 3, head = sh & 7;
        const int d = 1 << (2 * g), L = S / d, nb2 = upb / d, r = idx / nb2, pair = idx % nb2;
        const int seqbase = seq * S, kl0 = 128 * pair - 64;
        {
            const int c = tid & 7, klb = tid >> 3;
            u32x4 kv[5], pk[5], vv[5]; int sp[5];
#pragma unroll
            for (int i = 0; i < 5; ++i) {
                const int kl = klb + 64 * i, lp = kl0 + kl; const bool ok = (kl < 272) && (lp >= 0) && (lp < L);
                const int s = ok ? lp * d + r : 0; sp[i] = ok ? s : -1;
                const u16* row = Z + (size_t)(seqbase + s) * 3072 + head * 64;
                kv[i] = ok ? *(const u32x4*)(row + 512 + c * 8) : (u32x4){0u, 0u, 0u, 0u};
                pk[i] = (ok && c < 2) ? *(const u32x4*)(row + 512 + (c ^ 1) * 8) : (u32x4){0u, 0u, 0u, 0u};
                const int klv = lane + 64 * i, lpv = kl0 + klv; const bool okv = (klv < 272) && (lpv >= 0) && (lpv < L);
                const int sv = okv ? lpv * d + r : 0;
                vv[i] = okv ? *(const u32x4*)(Z + (size_t)(seqbase + sv) * 3072 + head * 64 + 1024 + w * 8) : (u32x4){0u, 0u, 0u, 0u};
            }
            __builtin_amdgcn_sched_barrier(0);
#pragma unroll
            for (int i = 0; i < 5; ++i) {
                const int kl = klb + 64 * i;
                if (kl < 272) { u32x4 kk = kv[i]; if (c < 2 && sp[i] >= 0) kk = rot8(kk, pk[i], c, ROPE + sp[i] * 16, 1.0f); *(LAS u32x4*)(Ks + kl * 72 + c * 8) = kk; }
                const int klv = lane + 64 * i;
                if (klv < 272) {
#pragma unroll
                    for (int e = 0; e < 4; ++e) { Vt[(w * 8 + 2 * e) * 280 + klv] = (u16)(vv[i][e] & 0xffffu); Vt[(w * 8 + 2 * e + 1) * 280 + klv] = (u16)(vv[i][e] >> 16); } }
            }
        }
        const int lq = 128 * pair + 16 * w + fr, sq = lq * d + r; const int tokq = seqbase + sq;
        bf16x8 qf[2];
        {
            const u16* row = Z + (size_t)tokq * 3072 + head * 64;
            u32x4 q0 = *(const u32x4*)(row + fq * 8), q1 = *(const u32x4*)(row + 32 + fq * 8);
            if (fq < 2) { const u32x4 pk = *(const u32x4*)(row + (fq ^ 1) * 8); q0 = rot8(q0, pk, fq, ROPE + sq * 16, 0.125f); } else q0 = scale8(q0, 0.125f);
            q1 = scale8(q1, 0.125f);
            qf[0] = as_bf16x8(q0); qf[1] = as_bf16x8(q1);
        }
        __syncthreads();
        f32x4 sacc[10];
#pragma unroll
        for (int kt = 0; kt < 10; ++kt) { sacc[kt] = (f32x4){0.f, 0.f, 0.f, 0.f};
#pragma unroll
            for (int sl = 0; sl < 2; ++sl) { const bf16x8 a = *(const LAS bf16x8*)(Ks + (16 * w + 16 * kt + fr) * 72 + sl * 32 + fq * 8); sacc[kt] = __builtin_amdgcn_mfma_f32_16x16x32_bf16(a, qf[sl], sacc[kt], 0, 0, 0); } }
        float mx = -3.0e38f;
#pragma unroll
        for (int kt = 0; kt < 10; ++kt)
#pragma unroll
            for (int j = 0; j < 4; ++j) { const int diff = 16 * kt + fq * 4 + j - 64 - fr, lp = lq + diff; const bool ok = (diff >= -64) && (diff <= 64) && (lp >= 0) && (lp < L);
                const float sv = ok ? sacc[kt][j] : -1.0e30f; sacc[kt][j] = sv; mx = fmaxf(mx, sv); }
        mx = fmaxf(mx, __shfl_xor(mx, 16)); mx = fmaxf(mx, __shfl_xor(mx, 32));
        float den = 0.f;
#pragma unroll
        for (int kt = 0; kt < 10; ++kt)
#pragma unroll
            for (int j = 0; j < 4; ++j) { const float sv = sacc[kt][j]; const float p = (sv > -1.0e29f) ? __expf(sv - mx) : 0.f; sacc[kt][j] = p; den += p; }
        den += __shfl_xor(den, 16); den += __shfl_xor(den, 32);
        bf16x8 pb[5];
#pragma unroll
        for (int uu = 0; uu < 5; ++uu) { u32x4 t; t.x = cvt_pk_bf16(sacc[2 * uu][0], sacc[2 * uu][1]); t.y = cvt_pk_bf16(sacc[2 * uu][2], sacc[2 * uu][3]);
            t.z = cvt_pk_bf16(sacc[2 * uu + 1][0], sacc[2 * uu + 1][1]); t.w = cvt_pk_bf16(sacc[2 * uu + 1][2], sacc[2 * uu + 1][3]); pb[uu] = as_bf16x8(t); }
        const float inv = 1.0f / den;
        u16* po = PART + ((size_t)g * TC + tokq) * 512 + head * 64 + fq * 4;
#pragma unroll
        for (int mt = 0; mt < 4; ++mt) { f32x4 o = (f32x4){0.f, 0.f, 0.f, 0.f};
#pragma unroll
            for (int uu = 0; uu < 5; ++uu) { const LAS u16* vp = Vt + (mt * 16 + fr) * 280 + 16 * w + 32 * uu + fq * 4;
                const u32x2 lo = *(const LAS u32x2*)vp, hi = *(const LAS u32x2*)(vp + 16); u32x4 t; t.x = lo.x; t.y = lo.y; t.z = hi.x; t.w = hi.y;
                o = __builtin_amdgcn_mfma_f32_16x16x32_bf16(as_bf16x8(t), pb[uu], o, 0, 0, 0); }
            u32x2 wv; wv.x = cvt_pk_bf16(o[0] * inv, o[1] * inv); wv.y = cvt_pk_bf16(o[2] * inv, o[3] * inv); *(u32x2*)(po + mt * 16) = wv; }
        if (fq == 0) LSE[((size_t)g * TC + tokq) * 8 + head] = mx + __logf(den);
        __syncthreads();
    }
}

__device__ __forceinline__ void merge_conv_phase(const u16* __restrict__ Z, const u16* __restrict__ PART, const float* __restrict__ LSE, const float* __restrict__ convw, u16* Y, int S) {
    const int lane = ltid() & 63, gw = blockIdx.x * 8 + (ltid() >> 6), nw = gridDim.x * 8;
    float cw[3][8];
#pragma unroll
    for (int j = 0; j < 3; ++j)
#pragma unroll
        for (int e = 0; e < 8; ++e) cw[j][e] = convw[j * 512 + lane * 8 + e];
    for (int t = gw; t < TC; t += nw) {
        const int s = t % S, head = lane >> 3;
        const float l0 = LSE[((size_t)0 * TC + t) * 8 + head], l1 = LSE[((size_t)1 * TC + t) * 8 + head], l2 = LSE[((size_t)2 * TC + t) * 8 + head];
        const float lm = fmaxf(l0, fmaxf(l1, l2)); float w0 = __expf(l0 - lm), w1 = __expf(l1 - lm), w2 = __expf(l2 - lm); const float wi = 1.0f / (w0 + w1 + w2); w0 *= wi; w1 *= wi; w2 *= wi;
        const u32x4 p0 = *(const u32x4*)(PART + ((size_t)0 * TC + t) * 512 + lane * 8), p1 = *(const u32x4*)(PART + ((size_t)1 * TC + t) * 512 + lane * 8), p2 = *(const u32x4*)(PART + ((size_t)2 * TC + t) * 512 + lane * 8);
        u32x4 ya;
#pragma unroll
        for (int i = 0; i < 4; ++i) ya[i] = cvt_pk_bf16(w0 * bflo(p0[i]) + w1 * bflo(p1[i]) + w2 * bflo(p2[i]), w0 * bfhi(p0[i]) + w1 * bfhi(p1[i]) + w2 * bfhi(p2[i]));
        *(u32x4*)(Y + (size_t)t * 1024 + lane * 8) = ya;
        const u16* zr = Z + (size_t)t * 3072;
        const u32x4 bg = *(const u32x4*)(zr + 1536 + lane * 8);
        float acc[8];
#pragma unroll
        for (int e = 0; e < 8; ++e) acc[e] = 0.f;
#pragma unroll
        for (int j = 0; j < 3; ++j) { const int sj = s + j - 1;
            if (sj >= 0 && sj < S) { const u16* zj = zr + (ptrdiff_t)(j - 1) * 3072; const u32x4 cg = *(const u32x4*)(zj + 2048 + lane * 8), hh = *(const u32x4*)(zj + 2560 + lane * 8);
#pragma unroll
                for (int i = 0; i < 4; ++i) { acc[2 * i] += cw[j][2 * i] * (bflo(cg[i]) * bflo(hh[i])); acc[2 * i + 1] += cw[j][2 * i + 1] * (bfhi(cg[i]) * bfhi(hh[i])); } } }
        u32x4 yb;
#pragma unroll
        for (int i = 0; i < 4; ++i) yb[i] = cvt_pk_bf16(bflo(bg[i]) * acc[2 * i], bfhi(bg[i]) * acc[2 * i + 1]);
        *(u32x4*)(Y + (size_t)t * 1024 + 512 + lane * 8) = yb;
    }
}

__device__ __forceinline__ void cross_attn_pair(LAS unsigned char* lds, const u16* __restrict__ Q, const u16* __restrict__ KV, int memrow0, u16* O, int S, int seq, int head, int qt0) {
    const int tid = ltid(), lane = tid & 63, w = tid >> 6, fr = lane & 15, fq = lane >> 4;
    LAS u16* Ks = (LAS u16*)lds;
    const u16* kvb = KV + (size_t)(memrow0 + seq * 256) * 2048 + head * 256;
    { u32x4 tmp[16];
#pragma unroll
      for (int i = 0; i < 16; ++i) { const int task = tid + i * NTHREADS, key = task >> 5, c = task & 31; tmp[i] = *(const u32x4*)(kvb + (size_t)key * 2048 + c * 8); }
#pragma unroll
      for (int i = 0; i < 16; ++i) { const int task = tid + i * NTHREADS, key = task >> 5, c = task & 31; *(LAS u32x4*)(Ks + key * 264 + c * 8) = tmp[i]; } }
    const int tok0 = seq * S + qt0 * 128 + 16 * w + fr;
    bf16x8 pb[2][8]; float inv[2];
    __syncthreads();
#pragma unroll
    for (int h = 0; h < 2; ++h) {
        bf16x8 qf[8];
        { const u16* row = Q + (size_t)(tok0 + 128 * h) * 1024 + head * 256;
#pragma unroll
          for (int sl = 0; sl < 8; ++sl) qf[sl] = as_bf16x8(scale8(*(const u32x4*)(row + sl * 32 + fq * 8), 0.0625f)); }
        f32x4 sacc[16];
#pragma unroll
        for (int kt = 0; kt < 16; ++kt) { sacc[kt] = (f32x4){0.f, 0.f, 0.f, 0.f};
#pragma unroll
            for (int sl = 0; sl < 8; ++sl) { const bf16x8 a = *(const LAS bf16x8*)(Ks + (16 * kt + fr) * 264 + sl * 32 + fq * 8); sacc[kt] = __builtin_amdgcn_mfma_f32_16x16x32_bf16(a, qf[sl], sacc[kt], 0, 0, 0); } }
        float mx = -3.0e38f;
#pragma unroll
        for (int kt = 0; kt < 16; ++kt)
#pragma unroll
            for (int j = 0; j < 4; ++j) mx = fmaxf(mx, sacc[kt][j]);
        mx = fmaxf(mx, __shfl_xor(mx, 16)); mx = fmaxf(mx, __shfl_xor(mx, 32));
        float den = 0.f;
#pragma unroll
        for (int kt = 0; kt < 16; ++kt)
#pragma unroll
            for (int j = 0; j < 4; ++j) { const float pe = __expf(sacc[kt][j] - mx); sacc[kt][j] = pe; den += pe; }
        den += __shfl_xor(den, 16); den += __shfl_xor(den, 32);
        inv[h] = 1.0f / den;
#pragma unroll
        for (int uu = 0; uu < 8; ++uu) { u32x4 t; t.x = cvt_pk_bf16(sacc[2 * uu][0], sacc[2 * uu][1]); t.y = cvt_pk_bf16(sacc[2 * uu][2], sacc[2 * uu][3]);
            t.z = cvt_pk_bf16(sacc[2 * uu + 1][0], sacc[2 * uu + 1][1]); t.w = cvt_pk_bf16(sacc[2 * uu + 1][2], sacc[2 * uu + 1][3]); pb[h][uu] = as_bf16x8(t); }
    }
    __syncthreads();
    { u32x4 tmp[16]; const int key = (w & 3) * 64 + lane, cb = (w >> 2) * 16;
#pragma unroll
      for (int i = 0; i < 16; ++i) tmp[i] = *(const u32x4*)(kvb + 1024 + (size_t)key * 2048 + (cb + i) * 8);
#pragma unroll
      for (int i = 0; i < 16; ++i) {
#pragma unroll
        for (int e = 0; e < 4; ++e) { Ks[((cb + i) * 8 + 2 * e) * 264 + key] = (u16)(tmp[i][e] & 0xffffu); Ks[((cb + i) * 8 + 2 * e + 1) * 264 + key] = (u16)(tmp[i][e] >> 16); } } }
    __syncthreads();
#pragma unroll
    for (int h = 0; h < 2; ++h) {
        u16* po = O + (size_t)(tok0 + 128 * h) * 1024 + head * 256 + fq * 4;
#pragma unroll
        for (int mt = 0; mt < 16; ++mt) { f32x4 o = (f32x4){0.f, 0.f, 0.f, 0.f};
#pragma unroll
            for (int uu = 0; uu < 8; ++uu) { const LAS u16* vp = Ks + (mt * 16 + fr) * 264 + 32 * uu + fq * 4;
                const u32x2 lo = *(const LAS u32x2*)vp, hi = *(const LAS u32x2*)(vp + 16); u32x4 t; t.x = lo.x; t.y = lo.y; t.z = hi.x; t.w = hi.y;
                o = __builtin_amdgcn_mfma_f32_16x16x32_bf16(as_bf16x8(t), pb[h][uu], o, 0, 0, 0); }
            u32x2 wv; wv.x = cvt_pk_bf16(o[0] * inv[h], o[1] * inv[h]); wv.y = cvt_pk_bf16(o[2] * inv[h], o[3] * inv[h]); *(u32x2*)(po + mt * 16) = wv; }
    }
    __syncthreads();
}
template <int CTRL> __device__ __forceinline__ float dpp_add(float v) { const int t = __builtin_amdgcn_update_dpp(__float_as_int(v), __float_as_int(v), CTRL, 0xf, 0xf, true); return v + __int_as_float(t); }
template <int L> __device__ __forceinline__ float row_reduce(float v) {
    v = dpp_add<0xB1>(v); v = dpp_add<0x4E>(v); v = dpp_add<0x141>(v);
    if (L == 16) v = dpp_add<0x140>(v);
    return v;
}
__device__ __forceinline__ void row_reduce2(float& a, float& b) {
    asm volatile("s_nop 1\n\t"
        "v_add_f32_dpp %0, %0, %0 quad_perm:[1,0,3,2] row_mask:0xf bank_mask:0xf bound_ctrl:1\n\t"
        "v_add_f32_dpp %1, %1, %1 quad_perm:[1,0,3,2] row_mask:0xf bank_mask:0xf bound_ctrl:1\n\t"
        "s_nop 0\n\t"
        "v_add_f32_dpp %0, %0, %0 quad_perm:[2,3,0,1] row_mask:0xf bank_mask:0xf bound_ctrl:1\n\t"
        "v_add_f32_dpp %1, %1, %1 quad_perm:[2,3,0,1] row_mask:0xf bank_mask:0xf bound_ctrl:1\n\t"
        "s_nop 0\n\t"
        "v_add_f32_dpp %0, %0, %0 row_half_mirror row_mask:0xf bank_mask:0xf bound_ctrl:1\n\t"
        "v_add_f32_dpp %1, %1, %1 row_half_mirror row_mask:0xf bank_mask:0xf bound_ctrl:1\n\t"
        "s_nop 0\n\t"
        "v_add_f32_dpp %0, %0, %0 row_mirror row_mask:0xf bank_mask:0xf bound_ctrl:1\n\t"
        "v_add_f32_dpp %1, %1, %1 row_mirror row_mask:0xf bank_mask:0xf bound_ctrl:1\n\t"
        "s_nop 1"
        : "+v"(a), "+v"(b));
}
__device__ __forceinline__ void half_reduce2(float& a, float& b) {
    asm volatile("s_nop 1\n\t"
        "v_add_f32_dpp %0, %0, %0 quad_perm:[1,0,3,2] row_mask:0xf bank_mask:0xf bound_ctrl:1\n\t"
        "v_add_f32_dpp %1, %1, %1 quad_perm:[1,0,3,2] row_mask:0xf bank_mask:0xf bound_ctrl:1\n\t"
        "s_nop 0\n\t"
        "v_add_f32_dpp %0, %0, %0 quad_perm:[2,3,0,1] row_mask:0xf bank_mask:0xf bound_ctrl:1\n\t"
        "v_add_f32_dpp %1, %1, %1 quad_perm:[2,3,0,1] row_mask:0xf bank_mask:0xf bound_ctrl:1\n\t"
        "s_nop 0\n\t"
        "v_add_f32_dpp %0, %0, %0 row_half_mirror row_mask:0xf bank_mask:0xf bound_ctrl:1\n\t"
        "v_add_f32_dpp %1, %1, %1 row_half_mirror row_mask:0xf bank_mask:0xf bound_ctrl:1\n\t"
        "s_nop 1"
        : "+v"(a), "+v"(b));
}
__device__ __forceinline__ void half_reduce1(float& a) {
    asm volatile("s_nop 1\n\t"
        "v_add_f32_dpp %0, %0, %0 quad_perm:[1,0,3,2] row_mask:0xf bank_mask:0xf bound_ctrl:1\n\t"
        "s_nop 1\n\t"
        "v_add_f32_dpp %0, %0, %0 quad_perm:[2,3,0,1] row_mask:0xf bank_mask:0xf bound_ctrl:1\n\t"
        "s_nop 1\n\t"
        "v_add_f32_dpp %0, %0, %0 row_half_mirror row_mask:0xf bank_mask:0xf bound_ctrl:1\n\t"
        "s_nop 1"
        : "+v"(a));
}
__device__ __forceinline__ void row_reduce4(float& a, float& b, float& c, float& d) {
#define RR4_STEP(ctl) "v_add_f32_dpp %0, %0, %0 " ctl " row_mask:0xf bank_mask:0xf bound_ctrl:1\n\t" "v_add_f32_dpp %1, %1, %1 " ctl " row_mask:0xf bank_mask:0xf bound_ctrl:1\n\t" \
                      "v_add_f32_dpp %2, %2, %2 " ctl " row_mask:0xf bank_mask:0xf bound_ctrl:1\n\t" "v_add_f32_dpp %3, %3, %3 " ctl " row_mask:0xf bank_mask:0xf bound_ctrl:1\n\t"
    asm volatile("s_nop 1\n\t" RR4_STEP("quad_perm:[1,0,3,2]") RR4_STEP("quad_perm:[2,3,0,1]") RR4_STEP("row_half_mirror") RR4_STEP("row_mirror") "s_nop 1"
        : "+v"(a), "+v"(b), "+v"(c), "+v"(d));
#undef RR4_STEP
}
__device__ __forceinline__ float wave_sum_fast(float v) { v = dpp_add<0xB1>(v); v = dpp_add<0x4E>(v); v = dpp_add<0x141>(v); v = dpp_add<0x140>(v); v += __shfl_xor(v, 16); v += __shfl_xor(v, 32); return v; }
constexpr int TS = 32;
struct ScanRaw { u16 r[8], k[8], v[8], e[8], a[8]; };
template <int RR, int J>
__device__ __forceinline__ void scan_item(LAS unsigned char* lds, const u16* __restrict__ RKV, const u16* __restrict__ Ed, const u16* __restrict__ Ad, const float* __restrict__ kkw, const float* __restrict__ kaw,
                          const float* __restrict__ rkw, u16* OD, float* BON, int S, int seqbase, int head, int dir, int rowbase) {
    constexpr int NACT = 4;
    const int tid = ltid(), lane = tid & 63, w = tid >> 6;
    constexpr int L = 64 / J, NRG = 64 / L;
    const int rg = lane / L, jg = lane % L, j0 = jg * J, row0 = rowbase + w * (NRG * RR) + rg * RR;
    const float kkc = kkw[head * 64 + lane], kac = kaw[head * 64 + lane], rkc = rkw[head * 64 + lane];
    f32x2 st_[RR][J / 2];
#pragma unroll
    for (int r = 0; r < RR; ++r)
#pragma unroll
        for (int q = 0; q < J / 2; ++q) st_[r][q] = (f32x2){0.f, 0.f};
    const int nch = S / TS;
    ScanRaw raw;
    constexpr int NPT = 8;
    const bool prep = (w >= 4); const int pw = w - 4;
#define SCAN_LOAD(ch) do { if (prep) { _Pragma("unroll") for (int q = 0; q < NPT; ++q) { const int i = (ch) * TS + pw * NPT + q; const int t = dir ? (S - 1 - i) : i; const size_t tok = (size_t)(seqbase + t); \
        raw.r[q] = RKV[tok * 3072 + head * 64 + lane]; raw.k[q] = RKV[tok * 3072 + 1024 + head * 64 + lane]; raw.v[q] = RKV[tok * 3072 + 2048 + head * 64 + lane]; \
        raw.e[q] = Ed[tok * 1024 + head * 64 + lane]; raw.a[q] = Ad[tok * 1024 + head * 64 + lane]; } } } while (0)
#define SCAN_PREP(buf, ch) do { if (prep) { LAS float* B_ = (LAS float*)(lds + (buf) * 49152); _Pragma("unroll") for (int q = 0; q < NPT; ++q) { const int ls = pw * NPT + q; \
        const float r_ = bf2f(raw.r[q]), k_ = bf2f(raw.k[q]), v_ = bf2f(raw.v[q]), a_ = bf2f(raw.a[q]); const float e_ = (float)__builtin_bit_cast(_Float16, raw.e[q]); \
        const float kr_ = k_ * kkc; const float ss_ = wave_sum_fast(kr_ * kr_); const float kk_ = kr_ * rsqrtf(fmaxf(ss_, 1e-24f)); \
        B_[(0 * TS + ls) * 64 + lane] = __expf(-e_); B_[(1 * TS + ls) * 64 + lane] = -kk_; B_[(2 * TS + ls) * 64 + lane] = kk_ * a_; \
        const float kd_ = k_ * (1.0f + (a_ - 1.0f) * kac); const float bn_ = wave_sum_fast(r_ * kd_ * rkc); \
        { const int i_ = (ch) * TS + ls; const int t_ = dir ? (S - 1 - i_) : i_; if (lane == 0) BON[((size_t)dir * TC + seqbase + t_) * 16 + head] = bn_; } \
        B_[(3 * TS + ls) * 64 + lane] = kd_; B_[(4 * TS + ls) * 64 + lane] = r_; B_[(5 * TS + ls) * 64 + lane] = v_; } } } while (0)
    SCAN_LOAD(0);
    SCAN_PREP(0, 0);
    __syncthreads();
    for (int ch = 0; ch < nch; ++ch) {
        if (ch + 1 < nch) SCAN_LOAD(ch + 1);
        if (w < NACT) {
            const LAS float* B = (const LAS float*)(lds + (ch & 1) * 49152);
            float os[RR];
#pragma unroll
            for (int r = 0; r < RR; ++r) os[r] = 0.f;
            f32x4 W[J / 4], A[J / 4], Bb[J / 4], K[J / 4], R[J / 4];
#pragma unroll
            for (int q = 0; q < J / 4; ++q) { W[q] = *(const LAS f32x4*)(B + (0 * TS) * 64 + j0 + 4 * q); A[q] = *(const LAS f32x4*)(B + (1 * TS) * 64 + j0 + 4 * q); Bb[q] = *(const LAS f32x4*)(B + (2 * TS) * 64 + j0 + 4 * q);
                K[q] = *(const LAS f32x4*)(B + (3 * TS) * 64 + j0 + 4 * q); R[q] = *(const LAS f32x4*)(B + (4 * TS) * 64 + j0 + 4 * q); }
            float V[RR];
#pragma unroll
            for (int r = 0; r < RR; ++r) V[r] = B[(5 * TS) * 64 + row0 + r];
#pragma unroll
            for (int ls = 0; ls < TS; ++ls) {
                f32x4 nW[J / 4], nA[J / 4], nB[J / 4], nK[J / 4], nR[J / 4]; float nV[RR];
#pragma unroll
                for (int q = 0; q < J / 4; ++q) { nW[q] = W[q]; nA[q] = A[q]; nB[q] = Bb[q]; nK[q] = K[q]; nR[q] = R[q]; }
#pragma unroll
                for (int r = 0; r < RR; ++r) nV[r] = V[r];
                if (ls + 1 < TS) {
#pragma unroll
                    for (int q = 0; q < J / 4; ++q) { nW[q] = *(const LAS f32x4*)(B + (0 * TS + ls + 1) * 64 + j0 + 4 * q); nA[q] = *(const LAS f32x4*)(B + (1 * TS + ls + 1) * 64 + j0 + 4 * q); nB[q] = *(const LAS f32x4*)(B + (2 * TS + ls + 1) * 64 + j0 + 4 * q);
                        nK[q] = *(const LAS f32x4*)(B + (3 * TS + ls + 1) * 64 + j0 + 4 * q); nR[q] = *(const LAS f32x4*)(B + (4 * TS + ls + 1) * 64 + j0 + 4 * q); }
                    if (RR == 1) nV[0] = B[(5 * TS + ls + 1) * 64 + row0];
                    else if (RR == 2) { const f32x2 t = *(const LAS f32x2*)(B + (5 * TS + ls + 1) * 64 + row0); nV[0] = t[0]; nV[RR - 1] = t[1]; }
                    else { const f32x4 t = *(const LAS f32x4*)(B + (5 * TS + ls + 1) * 64 + row0);
#pragma unroll
                        for (int r = 0; r < RR; ++r) nV[r] = t[r]; }
                }
                __builtin_amdgcn_sched_barrier(0);
                float sa[RR];
#pragma unroll
                for (int r = 0; r < RR; ++r) { f32x2 p = st_[r][0] * (f32x2){A[0][0], A[0][1]};
#pragma unroll
                    for (int q = 1; q < J / 2; ++q) p = st_[r][q] * (f32x2){A[q >> 1][(q & 1) * 2], A[q >> 1][(q & 1) * 2 + 1]} + p;
                    sa[r] = p[0] + p[1]; }
                if (J == 4) { if (RR == 2) row_reduce2(sa[0], sa[RR - 1]); else row_reduce4(sa[0], sa[RR > 1 ? 1 : 0], sa[RR > 1 ? RR - 2 : 0], sa[RR - 1]); } else if (RR == 1) half_reduce1(sa[0]); else half_reduce2(sa[0], sa[RR - 1]);
                float o[RR];
#pragma unroll
                for (int r = 0; r < RR; ++r) { const f32x2 sv = {sa[r], sa[r]}, vv = {V[r], V[r]}; f32x2 u = {0.f, 0.f};
#pragma unroll
                    for (int q = 0; q < J / 2; ++q) { const int qq = q >> 1, e = (q & 1) * 2;
                        st_[r][q] = st_[r][q] * (f32x2){W[qq][e], W[qq][e + 1]} + (sv * (f32x2){Bb[qq][e], Bb[qq][e + 1]} + vv * (f32x2){K[qq][e], K[qq][e + 1]});
                        u = st_[r][q] * (f32x2){R[qq][e], R[qq][e + 1]} + u; }
                    o[r] = u[0] + u[1]; }
                if (J == 4) { if (RR == 2) row_reduce2(o[0], o[RR - 1]); else row_reduce4(o[0], o[RR > 1 ? 1 : 0], o[RR > 1 ? RR - 2 : 0], o[RR - 1]); } else if (RR == 1) half_reduce1(o[0]); else half_reduce2(o[0], o[RR - 1]);
                const bool mine = (jg == (ls & (L - 1)));
#pragma unroll
                for (int r = 0; r < RR; ++r) os[r] = mine ? o[r] : os[r];
                if ((ls & (L - 1)) == L - 1) {
                    const int i = ch * TS + (ls - (L - 1)) + jg; const int t = dir ? (S - 1 - i) : i;
                    u16* op = OD + ((size_t)dir * TC + seqbase + t) * 1024 + head * 64 + row0;
                    if (RR == 1) *op = f2bf(os[0]);
                    else if (RR == 2) *(unsigned*)op = cvt_pk_bf16(os[0], os[RR - 1]);
                    else { u32x2 pk; pk.x = cvt_pk_bf16(os[0], os[RR > 1 ? 1 : 0]); pk.y = cvt_pk_bf16(os[RR - 2], os[RR - 1]); *(u32x2*)op = pk; }
                }
                __builtin_amdgcn_sched_barrier(0);
#pragma unroll
                for (int q = 0; q < J / 4; ++q) { W[q] = nW[q]; A[q] = nA[q]; Bb[q] = nB[q]; K[q] = nK[q]; R[q] = nR[q]; }
#pragma unroll
                for (int r = 0; r < RR; ++r) V[r] = nV[r];
            }
        }
        if (ch + 1 < nch) SCAN_PREP((ch + 1) & 1, ch + 1);
        __syncthreads();
    }
#undef SCAN_LOAD
#undef SCAN_PREP
}
__device__ __forceinline__ void scan_phase(LAS unsigned char* lds, const u16* RKV, const u16* EAG, const float* kkw, const float* kaw, const float* rkw, u16* OD, float* BON, int S) {
    for (int item = blockIdx.x; item < 256; item += gridDim.x) {
        if (S == 4096) { const int id = item >> 1, half = item & 1, seq = id >> 5, rem = id & 31, head = rem >> 1, dir = rem & 1;
            scan_item<2, 4>(lds, RKV, EAG + (size_t)dir * TC * 1024, EAG + (size_t)(2 + dir) * TC * 1024, kkw, kaw, rkw, OD, BON, S, seq * S, head, dir, half * 32);
        } else { const int seq = item >> 5, rem = item & 31, head = rem >> 1, dir = rem & 1;
            scan_item<2, 8>(lds, RKV, EAG + (size_t)dir * TC * 1024, EAG + (size_t)(2 + dir) * TC * 1024, kkw, kaw, rkw, OD, BON, S, seq * S, head, dir, 0);
        }
        __syncthreads();
    }
}
__device__ __forceinline__ float quad_sum(float v) { v = dpp_add<0xB1>(v); v = dpp_add<0x4E>(v); return v; }
__device__ __forceinline__ void rwkv_post_phase(const u16* __restrict__ OD, const float* __restrict__ BON, const u16* __restrict__ RKV, const u16* __restrict__ EAG,
                                const float* __restrict__ lnw, const float* __restrict__ lnb, u16* Y) {
    const int lane = ltid() & 63, gw = blockIdx.x * 8 + (ltid() >> 6), nw = gridDim.x * 8, c0 = lane * 16;
    float lw[16], lb[16];
#pragma unroll
    for (int i = 0; i < 4; ++i) { const f32x4 c = *(const f32x4*)(lnw + c0 + 4 * i), d = *(const f32x4*)(lnb + c0 + 4 * i);
#pragma unroll
        for (int e = 0; e < 4; ++e) { lw[4 * i + e] = c[e]; lb[4 * i + e] = d[e]; } }
    for (int t = gw; t < TC; t += nw) {
        u32x4 oa[2], ob[2], vv[2], gg[2];
#pragma unroll
        for (int i = 0; i < 2; ++i) { oa[i] = *(const u32x4*)(OD + (size_t)t * 1024 + c0 + 8 * i); ob[i] = *(const u32x4*)(OD + ((size_t)TC + t) * 1024 + c0 + 8 * i);
            vv[i] = *(const u32x4*)(RKV + (size_t)t * 3072 + 2048 + c0 + 8 * i); gg[i] = *(const u32x4*)(EAG + ((size_t)4 * TC + t) * 1024 + c0 + 8 * i); }
        const float bsum = BON[(size_t)t * 16 + (lane >> 2)] + BON[((size_t)TC + t) * 16 + (lane >> 2)];
        float y[16];
#pragma unroll
        for (int i = 0; i < 16; ++i) { const int w_ = (i & 7) >> 1; const bool hi = i & 1; y[i] = (hi ? bfhi(oa[i >> 3][w_]) : bflo(oa[i >> 3][w_])) + (hi ? bfhi(ob[i >> 3][w_]) : bflo(ob[i >> 3][w_])); }
        float sm = 0.f;
#pragma unroll
        for (int i = 0; i < 16; ++i) sm += y[i];
        const float mean = quad_sum(sm) * (1.0f / 64.0f);
        float sv = 0.f;
#pragma unroll
        for (int i = 0; i < 16; ++i) { y[i] -= mean; sv += y[i] * y[i]; }
        const float rstd = rsqrtf(quad_sum(sv) * (1.0f / 64.0f) + 64e-5f);
        float o[16];
#pragma unroll
        for (int i = 0; i < 16; ++i) { const int w_ = (i & 7) >> 1; const bool hi = i & 1;
            const float v = hi ? bfhi(vv[i >> 3][w_]) : bflo(vv[i >> 3][w_]), g = hi ? bfhi(gg[i >> 3][w_]) : bflo(gg[i >> 3][w_]);
            o[i] = (y[i] * rstd * lw[i] + lb[i] + bsum * v) * g; }
#pragma unroll
        for (int i = 0; i < 2; ++i) { u32x4 w; w.x = cvt_pk_bf16(o[8 * i], o[8 * i + 1]); w.y = cvt_pk_bf16(o[8 * i + 2], o[8 * i + 3]); w.z = cvt_pk_bf16(o[8 * i + 4], o[8 * i + 5]); w.w = cvt_pk_bf16(o[8 * i + 6], o[8 * i + 7]);
            *(u32x4*)(Y + (size_t)t * 1024 + c0 + 8 * i) = w; }
    }
}
__device__ __forceinline__ void build_w2comb(u16* W2, const float* __restrict__ w2, const float* __restrict__ a2, const float* __restrict__ g2) {
    const size_t total = (size_t)384 * 5120, stride = (size_t)gridDim.x * NTHREADS;
    for (size_t idx = (size_t)blockIdx.x * NTHREADS + ltid(); idx < total; idx += stride) {
        const int k = (int)(idx / 5120), n = (int)(idx % 5120), sel = n >> 10, nn = n & 1023; float v = 0.f;
        if (sel == 0 && k < 64) v = w2[(size_t)k * 1024 + nn];
        else if (sel == 1 && k >= 64 && k < 128) v = w2[(size_t)(64 + (k - 64)) * 1024 + nn];
        else if (sel == 2 && k >= 128 && k < 192) v = a2[(size_t)(k - 128) * 1024 + nn];
        else if (sel == 3 && k >= 192 && k < 256) v = a2[(size_t)(64 + (k - 192)) * 1024 + nn];
        else if (sel == 4 && k >= 256 && k < 384) v = g2[(size_t)(k - 256) * 1024 + nn];
        W2[(size_t)n * 384 + k] = f2bf(v);
    }
}

namespace pg8 {
struct EpiAny {
    static constexpr bool PERM = true, AFTER_DRAIN = false;
    int mode; u16* o16; u16* o16b; u16* x; const float* b0; const float* b1; int ldc; int M; unsigned long long* ssw; const unsigned long long* ssr; const float* xin;
    __device__ __forceinline__ void operator()(const f32x4 (&acc)[2][2][4][2], const Unit& u, int wr, int wc, int fr, int fq) const {
        if (mode == 0) EpiStore16{o16, ldc, ssr}(acc, u, wr, wc, fr, fq);
        else if (mode == 1) EpiResid{x, xin, ssw}(acc, u, wr, wc, fr, fq);
        else if (mode == 2) EpiSwiglu{o16, ssr}(acc, u, wr, wc, fr, fq);
        else if (mode == 3) EpiRwkv{o16}(acc, u, wr, wc, fr, fq);
        else EpiLora2{o16, b0, b1, M}(acc, u, wr, wc, fr, fq);
    }
};
}

__global__ void __launch_bounds__(NTHREADS, 2) mega(Params p) {
    extern __shared__ __attribute__((aligned(16))) unsigned char lds_raw[];
    LAS unsigned char* lds = (LAS unsigned char*)lds_raw;
    ltid_setup();
    cg::grid_group grid = cg::this_grid();
    unsigned char* const ws = p.ws;
    u16* const Xb = (u16*)(ws + WS_ARENA + AR_A);
    unsigned char* const RA = (unsigned char*)p.out;
    const size_t gstride = (size_t)gridDim.x * NTHREADS;

    {
        float* const ROPE = (float*)(ws + WS_ROPE);
        for (size_t i = (size_t)blockIdx.x * NTHREADS + ltid(); i < 4096 * 8; i += gstride) { const int pos = (int)(i >> 3), fi = (int)(i & 7);
            const float inv = powf(500000.0f, -2.0f * (float)fi / 16.0f); const float ang = (float)pos * inv;
            ROPE[i * 2] = (float)cos((double)ang); ROPE[i * 2 + 1] = (float)sin((double)ang); }
    }
    if (blockIdx.x == 0) for (int i = ltid(); i < XCD_BAR_WORDS; i += NTHREADS) ((unsigned*)(ws + WS_BAR))[i] = 0u;
    __syncthreads();
    grid.sync();
    volatile LAS unsigned* xst = (volatile LAS unsigned*)(lds + LDS_BYTES - 16);
    if (ltid() == 0) { xst[0] = 0u; xst[1] = 0u; }
    __syncthreads();
    XcdBarrier xbar = xcd_barrier_post((unsigned*)(ws + WS_BAR), xst);
#ifndef DUP_MISC
#define DUP_MISC 1
#endif
#ifndef DUP_SYNC
#define DUP_SYNC 1
#endif
#ifndef DUP_STEP
#define DUP_STEP -1
#define DUP_PAR -1
#endif
#ifndef DUP_SCAN
#define DUP_SCAN 1
#endif
    for (int ph = 0; ph < 4 * NCHUNK * 15; ++ph) {
        const int l = ph / (NCHUNK * 15), c = (ph / 15) % NCHUNK, s = ph % 15;
        const int e = l >> 1; const bool odd = (l & 1) != 0;
        if (s < 3 && c != 0) continue;
        if (s == 6 && !odd) continue;
        if (s == 8 || s == 12 || s == 10) continue;
        const int S = c < 2 ? 4096 : 2048;
        u16* const Xc = Xb + (size_t)c * TC * 1024;
        const float* const Xin0 = c < 2 ? p.in[0] + (size_t)c * TC * 1024 : p.in[1];
        unsigned char* const AR = ws + WS_ARENA;
        u16* const XN = (u16*)RA; u16* const BUFB = (u16*)(AR + AR_B); u16* const BUFC = (u16*)(AR + AR_C); u16* const Y = (u16*)(AR + AR_D);
        bool do_gemm = false; const u16* gA = nullptr; const u16* gB = nullptr; int gM = TC, gN = 1024, gK = 1024; size_t g_grp = 0; int g_shift = 0, ngemm = 1;
        pg8::EpiAny E{0, nullptr, nullptr, nullptr, nullptr, nullptr, 0, TC, nullptr, nullptr, nullptr};
        unsigned long long* const SSC = (unsigned long long*)(ws + WS_SS); unsigned long long* const SSF = SSC + TC;
        for (int dup = 0; dup < ((s == 5 && odd) ? DUP_SCAN : ((s == DUP_STEP && (DUP_PAR < 0 || (int)odd == DUP_PAR)) ? 2 : DUP_MISC)); ++dup) {
        if (s == 0) {
            const float* mu = p.in[12] + (size_t)e * 6 * 1024;
            u16* const WMIX = (u16*)(ws + WS_WMIX);
            for (int j = 0; j < 22; ++j) {
                const float* src = nullptr; int ld_src = 1024, K = 1024, N = 1024, ld_dst = 1024, col0 = 0, mode = 0; u16* dst = nullptr; const float* s1 = nullptr;
                if (j < 17) {
                    if (!odd) {
                        if (j == 0) { src = p.in[9] + (size_t)e * 1024 * 3072; ld_src = 3072; N = 3072; dst = WMIX; }
                        else if (j == 1) { src = p.in[10] + (size_t)e * 1024 * 1024; dst = WMIX + (size_t)3072 * 1024; }
                        else continue;
                    } else {
                        const int half = j & 1, q = j >> 1;
                        u16* const WL1 = WMIX + (size_t)3072 * 1024;
                        if (q < 3) { if (half) continue; src = p.in[13 + q] + (size_t)e * 1024 * 1024; dst = WMIX + (size_t)q * 1024 * 1024; }
                        else if (q < 5) { const int d = q - 3; src = p.in[18] + ((size_t)e * 2 + d) * 1024 * 64; ld_src = 64; N = 64; dst = WL1 + (size_t)(d * 64) * 2048; ld_dst = 2048; col0 = half * 1024; if (half) s1 = mu + 1 * 1024; }
                        else if (q < 7) { const int d = q - 5; src = p.in[21] + ((size_t)e * 2 + d) * 1024 * 64; ld_src = 64; N = 64; dst = WL1 + (size_t)(128 + d * 64) * 2048; ld_dst = 2048; col0 = half * 1024; if (half) s1 = mu + 4 * 1024; }
                        else if (q == 7) { src = p.in[23] + (size_t)e * 1024 * 128; ld_src = 128; N = 128; dst = WL1 + (size_t)256 * 2048; ld_dst = 2048; col0 = half * 1024; if (half) s1 = mu + 5 * 1024; }
                        else { if (half) continue; src = p.in[16] + (size_t)e * 1024 * 1024; dst = (u16*)(ws + WS_WMIX + WMIX_C); }
                    }
                } else if (j == 17) { src = p.in[30] + (size_t)l * 1024 * 1024; dst = (u16*)(ws + WS_WQ); s1 = p.in[5] + l * 1024; }
                else if (j == 18) { src = p.in[31] + (size_t)l * 1024 * 2048; ld_src = 2048; N = 2048; dst = (u16*)(ws + WS_WKV); }
                else if (j == 19) { src = p.in[32] + (size_t)l * 1024 * 1024; dst = (u16*)(ws + WS_WO); }
                else if (j == 20) { src = p.in[33] + (size_t)l * 1024 * 5632; ld_src = 5632; N = 5632; dst = (u16*)(ws + WS_WGU); mode = 1; s1 = p.in[7] + l * 1024; }
                else { src = p.in[34] + (size_t)l * 2816 * 1024; K = 2816; dst = (u16*)(ws + WS_WDN); ld_dst = 2816; }
                tr_job(lds, src, ld_src, K, N, dst, ld_dst, col0, s1, mode, j * 37);
            }
            if (odd) {
                for (size_t i = (size_t)blockIdx.x * NTHREADS + ltid(); i < (size_t)128 * 2048 / 8; i += gstride) ((u32x4*)(WMIX + (size_t)3072 * 1024 + (size_t)384 * 2048))[i] = (u32x4){0u, 0u, 0u, 0u};
                build_w2comb((u16*)(ws + WS_WMIX + WMIX_B), p.in[19] + (size_t)e * 2 * 64 * 1024, p.in[22] + (size_t)e * 2 * 64 * 1024, p.in[24] + (size_t)e * 128 * 1024);
            }
        }
        if (s == 0) {
            for (int rep = 0; rep < 2; ++rep) norm_rows(p.in[2 + rep], nullptr, p.in[6] + l * 1024, (u16*)(ws + WS_MN) + (size_t)rep * 2048 * 1024, 1024, 2048);
        }
        else if (s == 1) { do_gemm = true; gA = (u16*)(ws + WS_MN); gB = (u16*)(ws + WS_WKV); gM = 4096; gN = 2048; E.o16 = (u16*)(ws + WS_KV); E.ldc = 2048; }
        else if (s == 3) { do_gemm = true; gB = (u16*)(ws + WS_WMIX);
            if (!odd) { gA = XN; gN = 3072; E.o16 = BUFB; E.ldc = 3072; }
            else { gA = BUFC; gN = 3072; E.o16 = BUFB; E.ldc = 3072; g_grp = (size_t)TC * 1024 * 2; g_shift = 2; ngemm = 2; } }
        else if (s == 4) {
            if (!odd) dil_attn_phase(lds, BUFB, BUFC, (float*)(AR + AR_C + (size_t)3 * TC * 512 * 2), (const float*)(ws + WS_ROPE), S);
            else { do_gemm = true; gA = (u16*)(RA + (size_t)TC * 4096); gB = (u16*)(ws + WS_WMIX + WMIX_B); gN = 5120; gK = 384; E.mode = 4; E.o16 = BUFC; E.b0 = p.in[17] + (size_t)e * 2048; E.b1 = p.in[20] + (size_t)e * 2048; }
        }
        else if (s == 5) {
            if (!odd) merge_conv_phase(BUFB, BUFC, (const float*)(AR + AR_C + (size_t)3 * TC * 512 * 2), p.in[11] + (size_t)e * 3 * 512, Y, S);
            else scan_phase(lds, BUFB, BUFC, p.in[25] + (size_t)e * 1024, p.in[26] + (size_t)e * 1024, p.in[27] + (size_t)e * 1024, (u16*)RA, (float*)(RA + (size_t)TC * 4096), S);
        }
        else if (s == 6) rwkv_post_phase((const u16*)RA, (const float*)(RA + (size_t)TC * 4096), BUFB, BUFC, p.in[28] + (size_t)e * 1024, p.in[29] + (size_t)e * 1024, Y);
        else if (s == 7) { do_gemm = true; gA = Y; gB = odd ? (u16*)(ws + WS_WMIX + WMIX_C) : (u16*)(ws + WS_WMIX) + (size_t)3072 * 1024; E.mode = 1; E.x = Xc; E.xin = (l == 0) ? Xin0 : nullptr; E.ssw = SSC; }
        else if (s == 9) { do_gemm = true; gA = Xc; gB = (u16*)(ws + WS_WQ); E.o16 = BUFB; E.ldc = 1024; E.ssr = SSC; }
        else if (s == 11) { do_gemm = true; gA = BUFC; gB = (u16*)(ws + WS_WO); E.mode = 1; E.x = Xc; E.xin = nullptr; E.ssw = SSF; }
        else if (s == 13) { do_gemm = true; gA = Xc; gB = (u16*)(ws + WS_WGU); gN = 5632; E.mode = 2; E.o16 = BUFB; E.ssr = SSF; }
        else if (s == 14) { do_gemm = true; gA = BUFB; gB = (u16*)(ws + WS_WDN); gK = 2816; E.mode = 1; E.x = Xc; E.xin = nullptr; }
        }
        if (do_gemm) {
            for (int gi = 0; gi < ngemm; ++gi) {
                if (gi == 1) { gA = XN; gB = (u16*)(ws + WS_WMIX) + (size_t)3072 * 1024; gN = 512; gK = 2048; g_grp = 0; g_shift = 0; E.mode = 3; E.o16 = (u16*)(RA + (size_t)TC * 4096); }
                pg8::Gemm g{gA, gB, gM, gN, gK, g_grp, g_shift}; pg8::StaticOrder SO; SO.init(gM, gN, (int)gridDim.x, (int)blockIdx.x);
                pg8::gemm_phase<pg8::EpiAny, pg8::StaticOrder, false>(lds, g, SO, E, nullptr);
            }
        }
        if (s == 9) {
            pg8::StaticOrder SO2; SO2.init(TC, 1024, (int)gridDim.x, (int)blockIdx.x); pg8::Unit u;
            for (int i = 0; SO2.next(i, u); ++i) { const int t0 = u.pm * 256, seq = t0 / S, qt = (t0 % S) >> 7;
                cross_attn_pair(lds, BUFB, (const u16*)(ws + WS_KV), c < 2 ? c * 1024 : 2048, BUFC, S, seq, u.pn, qt); }
        }
        {
            const int nc = (s == 2 && c == 0) ? 0 : ((s == 14 && c < 2) ? c + 1 : -1);
            if (nc >= 0) {
                const int Sn = nc < 2 ? 4096 : 2048;
                const float* xs = (nc < 2 ? p.in[0] + (size_t)nc * TC * 1024 : p.in[1]);
                const u16* xh = (l == 0) ? nullptr : Xb + (size_t)nc * TC * 1024;
                for (size_t i = (size_t)blockIdx.x * NTHREADS + ltid(); i < (size_t)2 * TC; i += gstride) SSC[i] = 0ull;
                if (odd) norm_shift(xs, xh, p.in[4] + l * 1024, p.in[12] + (size_t)e * 6 * 1024, XN, BUFC, Sn);
                else norm_rows(xs, xh, p.in[4] + l * 1024, XN, 1024, TC);
            }
        }
        if (s == 1) continue;
        for (int dup = 0; dup < DUP_SYNC; ++dup) xcd_barrier(xbar);
    }
    norm_final(Xb, p.out, p.in[8], 49152);
}

extern "C" void kernel_launch(void* const* d_in, const int* in_sizes, int n_in, void* d_out, int out_size, void* d_ws, size_t ws_size, hipStream_t stream) {
    static int grid_blocks = 0;
    if (!grid_blocks) {
        int dev = 0, cus = 0, per_cu = 0;
        if (n_in != 35 || out_size != 49152 * 1024 || ws_size < WS_END) { fprintf(stderr, "kernel_launch: unexpected problem (n_in %d out %d ws %zu need %zu)\n", n_in, out_size, ws_size, (size_t)WS_END); grid_blocks = -1; return; }
        (void)hipGetDevice(&dev);
        (void)hipDeviceGetAttribute(&cus, hipDeviceAttributeMultiprocessorCount, dev);
        (void)hipFuncSetAttribute((const void*)mega, hipFuncAttributeMaxDynamicSharedMemorySize, LDS_BYTES);
        (void)hipOccupancyMaxActiveBlocksPerMultiprocessor(&per_cu, (const void*)mega, NTHREADS, LDS_BYTES);
        if (per_cu < 1) { fprintf(stderr, "kernel_launch: occupancy query says %d blocks per CU\n", per_cu); }
        grid_blocks = cus > 0 ? cus : 256;
    }
    if (grid_blocks < 0) return;
    Params p{};
    for (int i = 0; i < 35; ++i) p.in[i] = (const float*)d_in[i];
    p.out = (float*)d_out; p.ws = (unsigned char*)d_ws;
    void* args[] = {&p};
    hipError_t err = hipLaunchCooperativeKernel((void*)mega, dim3(grid_blocks), dim3(NTHREADS), args, LDS_BYTES, stream);
    if (err != hipSuccess) fprintf(stderr, "cooperative launch failed: %s (grid %d)\n", hipGetErrorString(err), grid_blocks);
}
```

```cpp
#include <hip/hip_runtime.h>
#include <hip/hip_cooperative_groups.h>
#include <cstdio>
namespace cg = cooperative_groups;

#define LAS __attribute__((address_space(3)))
typedef unsigned short u16;
typedef short bf16x8 __attribute__((ext_vector_type(8)));
typedef float f32x4 __attribute__((ext_vector_type(4)));
typedef float f32x2 __attribute__((ext_vector_type(2)));
typedef unsigned u32x4 __attribute__((ext_vector_type(4)));
typedef unsigned u32x2 __attribute__((ext_vector_type(2)));

constexpr int DM = 1024;
constexpr int TC = 16384;
constexpr int NCHUNK = 3;
constexpr int NTHREADS = 512;
constexpr int LDS_BYTES = 139264;

__device__ __forceinline__ unsigned cvt_pk_bf16(float lo, float hi) { unsigned r; asm volatile("v_cvt_pk_bf16_f32 %0, %1, %2" : "=v"(r) : "v"(lo), "v"(hi)); return r; }
__device__ __forceinline__ u16 f2bf(float x) { return (u16)(cvt_pk_bf16(x, 0.f) & 0xffffu); }
__device__ __forceinline__ float bf2f(u16 b) { return __uint_as_float(((unsigned)b) << 16); }
__device__ __forceinline__ float bflo(unsigned w) { return __uint_as_float(w << 16); }
__device__ __forceinline__ float bfhi(unsigned w) { return __uint_as_float(w & 0xffff0000u); }
__device__ __forceinline__ float sigmoidf_(float x) { return 1.0f / (1.0f + __expf(-x)); }
__device__ __forceinline__ float wave_sum(float v) {
#pragma unroll
    for (int o = 32; o >= 1; o >>= 1) v += __shfl_xor(v, o);
    return v;
}
constexpr int WVMAP_OFF = LDS_BYTES - 16 - 256;
__device__ __forceinline__ unsigned hw_slot() { return (unsigned)__builtin_amdgcn_s_getreg((5 << 11) | 4) & 63u; }
__device__ __forceinline__ int ltid() {
    extern __shared__ __attribute__((aligned(16))) unsigned char lds_dyn_[];
    const int wv = __builtin_amdgcn_readfirstlane(*(const volatile LAS int*)((LAS unsigned char*)lds_dyn_ + WVMAP_OFF + hw_slot() * 4));
    int lane; asm volatile("v_mbcnt_lo_u32_b32 %0, -1, 0\n\tv_mbcnt_hi_u32_b32 %0, -1, %0" : "=v"(lane));
    return (wv << 6) | lane;
}
__device__ __forceinline__ void ltid_setup() {
    extern __shared__ __attribute__((aligned(16))) unsigned char lds_dyn_[];
    if ((threadIdx.x & 63) == 0) *(volatile LAS int*)((LAS unsigned char*)lds_dyn_ + WVMAP_OFF + hw_slot() * 4) = (int)(threadIdx.x >> 6);
    __syncthreads();
}
#define XB_TMO      128
#define XB_XCNT(j)  (256  + 64 * (j))
#define XB_XSUB(j)  (1280 + 64 * (j))
#define XB_XGEN(j)  (2304 + 64 * (j))
#define XB_TOP      3328
#define XB_TOPGEN   3392
#define XCD_BAR_WORDS 3456
#define XB_SPIN_CAP (1u << 18)

__device__ __forceinline__ unsigned xb_ld(unsigned* p)              { return __hip_atomic_load(p, __ATOMIC_RELAXED, __HIP_MEMORY_SCOPE_AGENT); }
__device__ __forceinline__ unsigned xb_add(unsigned* p, unsigned v) { return __hip_atomic_fetch_add(p, v, __ATOMIC_RELAXED, __HIP_MEMORY_SCOPE_AGENT); }
__device__ __forceinline__ unsigned xb_xcc_id() { return (unsigned)__builtin_amdgcn_s_getreg((3 << 11) | 20) & 0xFu; }
#define XB_SPIN(cond, bar) do { unsigned _sp = 0; while (cond) { __builtin_amdgcn_s_sleep(1); \
    if ((++_sp & 255u) == 0u) { if (xb_ld(&(bar)[XB_TMO])) break; if (_sp > XB_SPIN_CAP) { atomicAdd(&(bar)[XB_TMO], 1u); break; } } } } while (0)

struct XcdBarrier {
    unsigned* bar; unsigned x;
    volatile LAS unsigned* st;
};

__device__ __forceinline__ XcdBarrier xcd_barrier_post(unsigned* bar, volatile LAS unsigned* st) {
    XcdBarrier b; b.bar = bar; b.x = xb_xcc_id(); b.st = st;
    if (ltid() == 0) (void)xb_add(&bar[XB_XCNT(b.x)], 1u);
    return b;
}
__device__ __forceinline__ void xcd_barrier_complete(unsigned* bar, unsigned x, unsigned& nloc, unsigned& nx) {
    const unsigned G = gridDim.x * gridDim.y * gridDim.z;
    unsigned sum, cnt, mine, sp = 0u;
    for (;;) {
        sum = 0u; cnt = 0u; mine = 0u;
#pragma unroll
        for (unsigned j = 0; j < 16; ++j) { const unsigned c = xb_ld(&bar[XB_XCNT(j)]); sum += c; cnt += (c > 0u) ? 1u : 0u; mine = (j == x) ? c : mine; }
        if (sum == G) break;
        __builtin_amdgcn_s_sleep(1);
        if ((++sp & 255u) == 0u) { if (xb_ld(&bar[XB_TMO])) break; if (sp > XB_SPIN_CAP) { atomicAdd(&bar[XB_TMO], 1u); break; } }
    }
    nloc = mine > 0u ? mine : 1u; nx = cnt > 0u ? cnt : 1u;
}

__device__ __forceinline__ void xcd_barrier(const XcdBarrier& b) {
    asm volatile("s_waitcnt vmcnt(0)" ::: "memory");
    __syncthreads();
    if (ltid() == 0) {
        unsigned* bar = b.bar;
        __builtin_amdgcn_s_waitcnt(0);
        unsigned nloc = b.st[0], nx = b.st[1];
        if (nloc == 0u) { xcd_barrier_complete(bar, b.x, nloc, nx); b.st[0] = nloc; b.st[1] = nx; }
        const unsigned old = xb_add(&bar[XB_XSUB(b.x)], 1u);
        const unsigned gen = old / nloc;
        if (old + 1u == (gen + 1u) * nloc) {
            __builtin_amdgcn_fence(__ATOMIC_RELEASE, "agent");
            asm volatile("s_waitcnt vmcnt(0)" ::: "memory");
            const unsigned og = xb_add(&bar[XB_TOP], 1u);
            const unsigned tg = og / nx;
            if (og + 1u == (tg + 1u) * nx) xb_add(&bar[XB_TOPGEN], 1u);
            else XB_SPIN(xb_ld(&bar[XB_TOPGEN]) == tg, bar);
            __builtin_amdgcn_fence(__ATOMIC_ACQUIRE, "agent");
            xb_add(&bar[XB_XGEN(b.x)], 1u);
            asm volatile("s_waitcnt vmcnt(0)" ::: "memory");
        } else {
            XB_SPIN(xb_ld(&bar[XB_XGEN(b.x)]) == gen, bar);
            __builtin_amdgcn_fence(__ATOMIC_ACQUIRE, "agent");
            asm volatile("s_waitcnt vmcnt(0)" ::: "memory");
        }
    }
    __syncthreads();
}
namespace pg8 {
#define PG8_LAS __attribute__((address_space(3)))
typedef unsigned short bf16_t;
typedef short bf16x8 __attribute__((ext_vector_type(8)));
typedef float f32x4 __attribute__((ext_vector_type(4)));
typedef unsigned u32x4 __attribute__((ext_vector_type(4)));
constexpr int BM = 256, BK = 64, HALF = 128, HTB = HALF * BK * 2  , STAGE_BYTES = 8 * HTB, NXCD = 8, WGM = 8;

__host__ __device__ __forceinline__ int lds_byte(int r, int c) { const int st = (r >> 4) * 2 + (c >> 5), rr = r & 15, cc = c & 31, ob = rr * 64 + cc * 2; return st * 1024 + (ob ^ (((ob >> 9) & 1) << 5)); }
__host__ __device__ __forceinline__ void stage_rc(int b, int& R, int& C) { const int st = b / 1024, sb = b % 1024, swz = sb ^ (((sb >> 9) & 1) << 5); R = (st >> 1) * 16 + swz / 64; C = (st & 1) * 32 + (swz % 64) / 2; }
__host__ __device__ __forceinline__ int perm32(int rho) { const int n = rho >> 4, i = rho & 15; return 8 * (i >> 2) + 4 * n + (i & 3); }

struct Unit { int pm, pn; };
struct Gemm { const bf16_t* A; const bf16_t* Bt; int M, N, K; size_t a_grp_bytes; int a_grp_shift; };

struct StaticOrder {
    int nM, nN, nwg, G, c;
    __host__ __device__ __forceinline__ void init(int M, int N, int G_, int c_) { nM = M / BM; nN = N / BM; nwg = nM * nN; G = G_; c = c_; }
    __host__ __device__ __forceinline__ bool next(int i, Unit& u) const {
        const long L = (long)i * G + c; if (L >= nwg) return false;
        int wgid = (int)L; { const int q = nwg / NXCD, r = nwg % NXCD, xcd = wgid % NXCD, off = wgid / NXCD; wgid = (xcd < r ? xcd * (q + 1) : r * (q + 1) + (xcd - r) * q) + off; }
        const int nig = WGM * nN, gid = wgid / nig, fm = gid * WGM, gsz = (nM - fm) < WGM ? (nM - fm) : WGM;
        u.pm = fm + ((wgid % nig) % gsz); u.pn = (wgid % nig) / gsz; return true;
    }
    __device__ __forceinline__ void a_ready(const Unit&) const {}
    __device__ __forceinline__ void done(const Unit&) const {}
};
struct EpiStore16 {
    static constexpr bool PERM = true, AFTER_DRAIN = false;
    u16* O; int ldc; const unsigned long long* SS;
    __device__ __forceinline__ void operator()(const f32x4 (&acc)[2][2][4][2], const Unit& u, int wr, int wc, int fr, int fq) const {
        const int row0 = u.pm * BM + wr * 64 + fr, col0 = u.pn * BM + wc * 32 + 8 * fq;
#pragma unroll
        for (int ai = 0; ai < 2; ++ai)
#pragma unroll
            for (int m = 0; m < 4; ++m) { const int row = row0 + ai * HALF + m * 16; u16* rowp = O + (size_t)row * ldc + col0;
                const float rs = SS ? rsqrtf((float)SS[row] * (1.0f / (1024.0f * 1048576.0f)) + 1e-6f) : 1.0f;
#pragma unroll
                for (int bj = 0; bj < 2; ++bj) { const f32x4 v0 = acc[ai][bj][m][0] * rs, v1 = acc[ai][bj][m][1] * rs; u32x4 w; w.x = cvt_pk_bf16(v0[0], v0[1]); w.y = cvt_pk_bf16(v0[2], v0[3]); w.z = cvt_pk_bf16(v1[0], v1[1]); w.w = cvt_pk_bf16(v1[2], v1[3]);
                    *(u32x4*)(rowp + bj * HALF) = w; } }
    }
};
struct EpiResid {
    static constexpr bool PERM = true, AFTER_DRAIN = false;
    u16* Xb; const float* Xin32; unsigned long long* SS;
    __device__ __forceinline__ void operator()(const f32x4 (&acc)[2][2][4][2], const Unit& u, int wr, int wc, int fr, int fq) const {
        const int row0 = u.pm * BM + wr * 64 + fr, col0 = u.pn * BM + wc * 32 + 8 * fq;
#pragma unroll
        for (int ai = 0; ai < 2; ++ai)
#pragma unroll
            for (int m = 0; m < 4; ++m) { const int row = row0 + ai * HALF + m * 16; const unsigned off = (unsigned)(row * 1024 + col0); float ss = 0.f;
#pragma unroll
                for (int bj = 0; bj < 2; ++bj) { const unsigned o = off + bj * HALF; f32x4 x0, x1;
                    if (Xin32) { x0 = *(const f32x4*)(Xin32 + o); x1 = *(const f32x4*)(Xin32 + o + 4); }
                    else { const u32x4 h = *(const u32x4*)(Xb + o); x0 = (f32x4){bflo(h.x), bfhi(h.x), bflo(h.y), bfhi(h.y)}; x1 = (f32x4){bflo(h.z), bfhi(h.z), bflo(h.w), bfhi(h.w)}; }
                    const f32x4 v0 = x0 + acc[ai][bj][m][0], v1 = x1 + acc[ai][bj][m][1];
                    u32x4 w; w.x = cvt_pk_bf16(v0[0], v0[1]); w.y = cvt_pk_bf16(v0[2], v0[3]); w.z = cvt_pk_bf16(v1[0], v1[1]); w.w = cvt_pk_bf16(v1[2], v1[3]);
                    *(u32x4*)(Xb + o) = w;
                    if (SS) ss += (v0[0] * v0[0] + v0[1] * v0[1]) + (v0[2] * v0[2] + v0[3] * v0[3]) + (v1[0] * v1[0] + v1[1] * v1[1]) + (v1[2] * v1[2] + v1[3] * v1[3]); }
                if (SS) { ss += __shfl_xor(ss, 16); ss += __shfl_xor(ss, 32); if (fq == 0) atomicAdd(SS + row, (unsigned long long)(ss * 1048576.0f)); } }
    }
};
struct EpiSwiglu {
    static constexpr bool PERM = true, AFTER_DRAIN = false;
    u16* H; const unsigned long long* SS;
    __device__ __forceinline__ void operator()(const f32x4 (&acc)[2][2][4][2], const Unit& u, int wr, int wc, int fr, int fq) const {
        const int row0 = u.pm * BM + wr * 64 + fr, col0 = u.pn * 128 + wc * 16 + 4 * fq;
#pragma unroll
        for (int ai = 0; ai < 2; ++ai)
#pragma unroll
            for (int m = 0; m < 4; ++m) { const int row = row0 + ai * HALF + m * 16; u16* rowp = H + (size_t)row * 2816 + col0;
                const float rs = rsqrtf((float)SS[row] * (1.0f / (1024.0f * 1048576.0f)) + 1e-6f);
#pragma unroll
                for (int bj = 0; bj < 2; ++bj) { const f32x4 g = acc[ai][bj][m][0] * rs, up = acc[ai][bj][m][1] * rs; float h[4];
#pragma unroll
                    for (int j = 0; j < 4; ++j) h[j] = g[j] / (1.0f + __expf(-g[j])) * up[j];
                    u32x2 w; w.x = cvt_pk_bf16(h[0], h[1]); w.y = cvt_pk_bf16(h[2], h[3]); *(u32x2*)(rowp + bj * 64) = w; } }
    }
};
struct EpiRwkv {
    static constexpr bool PERM = true, AFTER_DRAIN = false;
    u16* L1;
    __device__ __forceinline__ void operator()(const f32x4 (&acc)[2][2][4][2], const Unit& u, int wr, int wc, int fr, int fq) const {
        const int row0 = u.pm * BM + wr * 64 + fr;
        const int col0 = u.pn * BM + wc * 32 + 8 * fq; const int t = u.pn;
#pragma unroll
        for (int ai = 0; ai < 2; ++ai)
#pragma unroll
            for (int m = 0; m < 4; ++m) { u16* rowp = L1 + (size_t)(row0 + ai * HALF + m * 16) * 384 + col0;
#pragma unroll
                for (int bj = 0; bj < 2; ++bj) if (!(t == 1 && bj == 1)) {
#pragma unroll
                    for (int n = 0; n < 2; ++n) { f32x4 v = acc[ai][bj][m][n];
#pragma unroll
                        for (int j = 0; j < 4; ++j) { float x = v[j]; if (t == 1) x = sigmoidf_(x); else if (bj == 0) x = tanhf(x); v[j] = x; }
                        u32x2 w; w.x = cvt_pk_bf16(v[0], v[1]); w.y = cvt_pk_bf16(v[2], v[3]); *(u32x2*)(rowp + bj * HALF + n * 4) = w; } } }
    }
};
struct EpiLora2 {
    static constexpr bool PERM = true, AFTER_DRAIN = false;
    u16* EAG; const float* w0; const float* a0; int M;
    __device__ __forceinline__ void operator()(const f32x4 (&acc)[2][2][4][2], const Unit& u, int wr, int wc, int fr, int fq) const {
        const int row0 = u.pm * BM + wr * 64 + fr; const int sel = u.pn >> 2; const int col0 = (u.pn & 3) * BM + wc * 32 + 8 * fq;
        u16* base = EAG + (size_t)sel * M * 1024;
        const float* bias = sel < 2 ? (w0 + sel * 1024) : (a0 + ((sel - 2) & 1) * 1024);
        f32x4 bv[2][2];
#pragma unroll
        for (int bj = 0; bj < 2; ++bj)
#pragma unroll
            for (int n = 0; n < 2; ++n) bv[bj][n] = (sel < 4) ? *(const f32x4*)(bias + col0 + bj * HALF + n * 4) : (f32x4){0.f, 0.f, 0.f, 0.f};
#pragma unroll
        for (int ai = 0; ai < 2; ++ai)
#pragma unroll
            for (int m = 0; m < 4; ++m) { u16* rowp = base + (size_t)(row0 + ai * HALF + m * 16) * 1024 + col0;
#pragma unroll
                for (int bj = 0; bj < 2; ++bj)
#pragma unroll
                    for (int n = 0; n < 2; ++n) { const f32x4 v = acc[ai][bj][m][n] + bv[bj][n]; u32x2 w;
                        if (sel < 2) { _Float16 h[4];
#pragma unroll
                            for (int j = 0; j < 4; ++j) h[j] = (_Float16)(0.60653066f * sigmoidf_(v[j]));
                            w.x = (unsigned)__builtin_bit_cast(u16, h[0]) | ((unsigned)__builtin_bit_cast(u16, h[1]) << 16);
                            w.y = (unsigned)__builtin_bit_cast(u16, h[2]) | ((unsigned)__builtin_bit_cast(u16, h[3]) << 16);
                        } else if (sel < 4) { w.x = cvt_pk_bf16(sigmoidf_(v[0]), sigmoidf_(v[1])); w.y = cvt_pk_bf16(sigmoidf_(v[2]), sigmoidf_(v[3]));
                        } else { w.x = cvt_pk_bf16(v[0], v[1]); w.y = cvt_pk_bf16(v[2], v[3]); }
                        *(u32x2*)(rowp + bj * HALF + n * 4) = w; } }
    }
};
template <class Epi, class Sched, bool STAMP = false>
__device__ __forceinline__ void gemm_phase(PG8_LAS unsigned char* lds, const Gemm g, const Sched& S, const Epi& E, unsigned long long* stamps) {
    const int tid = ltid(), wid = __builtin_amdgcn_readfirstlane(tid >> 6), lane = tid & 63, wr = wid >> 2, wc = wid & 3, fr = lane & 15, fq = lane >> 4;
    const int K = g.K, nt = K / BK;
    int ts_lo = 0, ts_hi = 0, nts = 0; const unsigned long long rt_entry = STAMP ? (unsigned long long)wall_clock64() : 0ull;
#define PG8_STAMP() do { if (STAMP && wid == 0 && nts < 64) { const unsigned long long _c = (unsigned long long)clock64(); \
        ts_lo = (lane == nts) ? (int)(unsigned)_c : ts_lo; ts_hi = (lane == nts) ? (int)(unsigned)(_c >> 32) : ts_hi; ++nts; } } while (0)
    PG8_STAMP();
    unsigned voffA[2], voffB[2];
#pragma unroll
    for (int i = 0; i < 2; ++i) { int R, C; stage_rc(tid * 16 + i * 8192, R, C); const int Rb = Epi::PERM ? ((R & ~31) + perm32(R & 31)) : R;
        voffA[i] = (unsigned)(R * K + C) * 2u; voffB[i] = (unsigned)(Rb * K + C) * 2u; }
    const size_t kstep = (size_t)(BK * 2);
    const size_t hstep = (size_t)HALF * K * 2;
    const size_t tstep = 2 * hstep;
    const unsigned ldsw = (unsigned)wid * 1024u;
    const int aoff = lds_byte(wr * 64 + fr, fq * 8), boff = lds_byte(wc * 32 + fr, fq * 8);
#define PG8_SA(b, h) (((b) * 2 + (h)) * HTB)
#define PG8_SB(b, h) ((4 + (b) * 2 + (h)) * HTB)
#define PG8_STAGE(bufoff, gbase, voff) do { _Pragma("unroll") for (int _i = 0; _i < 2; ++_i) \
        __builtin_amdgcn_global_load_lds((const unsigned*)((const char*)(gbase) + (voff)[_i]), (PG8_LAS unsigned*)(lds + (bufoff) + ldsw + _i * 8192), 16, 0, 0); } while (0)
#define PG8_LDA(dst, b, h) do { _Pragma("unroll") for (int m = 0; m < 4; ++m) _Pragma("unroll") for (int k = 0; k < 2; ++k) dst[m][k] = *(const PG8_LAS bf16x8*)(lds + PG8_SA(b, h) + aoff + m * 2048 + k * 1024); } while (0)
#define PG8_LDB(dst, b, h) do { _Pragma("unroll") for (int n = 0; n < 2; ++n) _Pragma("unroll") for (int k = 0; k < 2; ++k) dst[n][k] = *(const PG8_LAS bf16x8*)(lds + PG8_SB(b, h) + boff + n * 2048 + k * 1024); } while (0)
#define PG8_MMA(ai, bj, At, Bt) do { __builtin_amdgcn_s_setprio(1); _Pragma("unroll") for (int m = 0; m < 4; ++m) _Pragma("unroll") for (int n = 0; n < 2; ++n) _Pragma("unroll") for (int k = 0; k < 2; ++k) \
        acc[ai][bj][m][n] = __builtin_amdgcn_mfma_f32_16x16x32_bf16(Bt[n][k], At[m][k], acc[ai][bj][m][n], 0, 0, 0); __builtin_amdgcn_s_setprio(0); } while (0)
#define PG8_WAIT_V(n) asm volatile("s_waitcnt vmcnt(" #n ")" ::: "memory")
#define PG8_WAIT_L(n) asm volatile("s_waitcnt lgkmcnt(" #n ")" ::: "memory")
#define PG8_BAR __builtin_amdgcn_s_barrier()
#define PG8_SCHED __builtin_amdgcn_sched_barrier(0)
    Unit cur, nxt; int ui = 0;
    if (!S.next(0, cur)) return;
    f32x4 acc[2][2][4][2];
#pragma unroll
    for (int a = 0; a < 2; ++a)
#pragma unroll
        for (int b = 0; b < 2; ++b)
#pragma unroll
            for (int m = 0; m < 4; ++m)
#pragma unroll
                for (int n = 0; n < 2; ++n) acc[a][b][m][n] = (f32x4){0.f, 0.f, 0.f, 0.f};
    bf16x8 At[4][2], B0[2][2], B1[2][2];
    const char* cA = (const char*)g.A + (size_t)cur.pm * tstep + (size_t)(cur.pn >> g.a_grp_shift) * g.a_grp_bytes; const char* cB = (const char*)g.Bt + (size_t)cur.pn * tstep;
    S.a_ready(cur);
    PG8_STAGE(PG8_SB(0, 0), cB, voffB); PG8_STAGE(PG8_SA(0, 0), cA, voffA); PG8_STAGE(PG8_SB(0, 1), cB + hstep, voffB); PG8_STAGE(PG8_SA(0, 1), cA + hstep, voffA);
    if (wr == 1) PG8_BAR;
    PG8_WAIT_V(4); PG8_BAR;
    PG8_STAGE(PG8_SB(1, 0), cB + kstep, voffB); PG8_STAGE(PG8_SA(1, 0), cA + kstep, voffA); PG8_STAGE(PG8_SB(1, 1), cB + hstep + kstep, voffB);
    PG8_WAIT_V(6); PG8_BAR;
    PG8_STAMP();
    for (;;) {
        const bool has_next = S.next(ui + 1, nxt);
        const char* nA = has_next ? (const char*)g.A + (size_t)nxt.pm * tstep + (size_t)(nxt.pn >> g.a_grp_shift) * g.a_grp_bytes : cA; const char* nB = has_next ? (const char*)g.Bt + (size_t)nxt.pn * tstep : cB;
        for (int t = 0; t < nt; t += 2) {
            const bool last = (t == nt - 2);
            const char* a1 = cA + (size_t)(t + 1) * kstep;
            const char* a2 = last ? nA : cA + (size_t)(t + 2) * kstep; const char* b2 = last ? nB : cB + (size_t)(t + 2) * kstep;
            const char* a3 = a2 + kstep; const char* b3 = b2 + kstep;
            if (last && has_next) S.a_ready(nxt);
            PG8_LDB(B0, 0, 0); PG8_SCHED; PG8_LDA(At, 0, 0); PG8_STAGE(PG8_SA(1, 1), a1 + hstep, voffA);
            PG8_WAIT_L(8); PG8_BAR; PG8_WAIT_L(0); PG8_MMA(0, 0, At, B0); PG8_BAR; PG8_SCHED;
            PG8_LDB(B1, 0, 1); PG8_STAGE(PG8_SB(0, 0), b2, voffB);
            PG8_BAR; PG8_WAIT_L(0); PG8_MMA(0, 1, At, B1); PG8_BAR;
            PG8_LDA(At, 0, 1); PG8_STAGE(PG8_SA(0, 0), a2, voffA);
            PG8_BAR; PG8_WAIT_L(0); PG8_MMA(1, 0, At, B0); PG8_BAR; PG8_SCHED;
            PG8_STAGE(PG8_SB(0, 1), b2 + hstep, voffB);
            PG8_WAIT_V(6); PG8_BAR; PG8_MMA(1, 1, At, B1); PG8_BAR;
            PG8_LDB(B0, 1, 0); PG8_SCHED; PG8_LDA(At, 1, 0); PG8_STAGE(PG8_SA(0, 1), a2 + hstep, voffA);
            PG8_WAIT_L(8); PG8_BAR; PG8_WAIT_L(0); PG8_MMA(0, 0, At, B0); PG8_BAR; PG8_SCHED;
            PG8_LDB(B1, 1, 1); PG8_STAGE(PG8_SB(1, 0), b3, voffB);
            PG8_BAR; PG8_WAIT_L(0); PG8_MMA(0, 1, At, B1); PG8_BAR;
            PG8_LDA(At, 1, 1); PG8_STAGE(PG8_SA(1, 0), a3, voffA);
            PG8_BAR; PG8_WAIT_L(0); PG8_MMA(1, 0, At, B0); PG8_BAR; PG8_SCHED;
            PG8_STAGE(PG8_SB(1, 1), b3 + hstep, voffB);
            PG8_WAIT_V(6); PG8_BAR; PG8_MMA(1, 1, At, B1); PG8_BAR;
        }
        PG8_STAMP();
        if constexpr (!Epi::AFTER_DRAIN) { E(acc, cur, wr, wc, fr, fq); S.done(cur); }
        PG8_STAMP();
        if (!has_next) break;
#pragma unroll
        for (int a = 0; a < 2; ++a)
#pragma unroll
            for (int b = 0; b < 2; ++b)
#pragma unroll
                for (int m = 0; m < 4; ++m)
#pragma unroll
                    for (int n = 0; n < 2; ++n) acc[a][b][m][n] = (f32x4){0.f, 0.f, 0.f, 0.f};
        cur = nxt; cA = nA; cB = nB; ++ui;
    }
    PG8_WAIT_V(0);
    if (wr == 0) PG8_BAR;
    PG8_BAR;
    if constexpr (Epi::AFTER_DRAIN) { E.fused(acc, cur, wr, wc, fr, fq, lds, wid, lane); S.done(cur); }
    PG8_STAMP();
    if (STAMP && wid == 0) { stamps[lane] = lane < nts ? (((unsigned long long)(unsigned)ts_hi << 32) | (unsigned)ts_lo) : 0ull;
        if (lane == 62) stamps[62] = rt_entry; if (lane == 63) stamps[63] = (unsigned long long)wall_clock64(); }
#undef PG8_STAMP
#undef PG8_SA
#undef PG8_SB
#undef PG8_STAGE
#undef PG8_LDA
#undef PG8_LDB
#undef PG8_MMA
#undef PG8_WAIT_V
#undef PG8_WAIT_L
#undef PG8_BAR
#undef PG8_SCHED
}
}
struct Params { const float* in[35]; float* out; unsigned char* ws; int pad0, pad1; };

constexpr size_t MB = 1u << 20;
constexpr size_t WS_WMIX  = 0;
constexpr size_t WMIX_B   = (size_t)3584 * 2048 * 2;
constexpr size_t WMIX_C   = WMIX_B + (size_t)5120 * 512 * 2;
constexpr size_t WS_WQ    = WS_WMIX + WMIX_C + (size_t)1024 * 1024 * 2;
constexpr size_t WS_WKV   = WS_WQ + (size_t)1024 * 1024 * 2;
constexpr size_t WS_WO    = WS_WKV + (size_t)2048 * 1024 * 2;
constexpr size_t WS_WGU   = WS_WO + (size_t)1024 * 1024 * 2;
constexpr size_t WS_WDN   = WS_WGU + (size_t)5632 * 1024 * 2;
constexpr size_t WS_MN    = WS_WDN + (size_t)1024 * 2816 * 2;
constexpr size_t WS_KV    = WS_MN + (size_t)4096 * 1024 * 2;
constexpr size_t WS_ROPE  = WS_KV + (size_t)4096 * 2048 * 2;
constexpr size_t WS_ARENA = WS_ROPE + (size_t)4096 * 16 * 4;
constexpr size_t AR_A = 0, AR_B = (size_t)TC * 8192, AR_C = (size_t)TC * 14336, AR_D = (size_t)TC * 24576, AR_END = (size_t)TC * 26624;
constexpr size_t WS_BAR = WS_ARENA + AR_END;
constexpr size_t WS_SS = WS_BAR + 16384;
constexpr size_t WS_END = WS_SS + (size_t)2 * TC * 8;

__device__ __forceinline__ int map_row(int n, int mode) {
    if (mode == 0) return n;
    const int up = n >= 2816, c = up ? n - 2816 : n;
    return (c >> 4) * 32 + ((c & 15) >> 2) * 8 + up * 4 + (c & 3);
}
__device__ __forceinline__ void tr_job(LAS unsigned char* lds, const float* __restrict__ src, int ld_src, int K, int N, u16* dst, int ld_dst, int col0, const float* __restrict__ s1, int mode, int rot) {
    LAS float* T = (LAS float*)lds;
    const int tid = ltid(), nkt = K >> 6, nnt = N >> 6, ntile = nkt * nnt;
    for (int t = (blockIdx.x + rot) % gridDim.x; t < ntile; t += gridDim.x) {
        const int kt = t / nnt, nt = t % nnt;
#pragma unroll
        for (int it = 0; it < 2; ++it) {
            const int kk = (tid >> 4) + it * 32, n4 = (tid & 15) * 4;
            f32x4 v = *(const f32x4*)(src + (size_t)(kt * 64 + kk) * ld_src + nt * 64 + n4);
            const float s = s1 ? s1[kt * 64 + kk] : 1.0f;
#pragma unroll
            for (int e = 0; e < 4; ++e) T[(n4 + e) * 65 + kk] = v[e] * s;
        }
        __syncthreads();
        {
            const int n = tid >> 3, k8 = (tid & 7) * 8; float f[8];
#pragma unroll
            for (int e = 0; e < 8; ++e) f[e] = T[n * 65 + k8 + e];
            u32x4 w; w.x = cvt_pk_bf16(f[0], f[1]); w.y = cvt_pk_bf16(f[2], f[3]); w.z = cvt_pk_bf16(f[4], f[5]); w.w = cvt_pk_bf16(f[6], f[7]);
            *(u32x4*)(dst + (size_t)map_row(nt * 64 + n, mode) * ld_dst + col0 + kt * 64 + k8) = w;
        }
        __syncthreads();
    }
}

__device__ __forceinline__ void norm_rows(const float* __restrict__ X, const u16* __restrict__ Xh, const float* __restrict__ g, u16* dst, int ld_dst, int nrows) {
    const int lane = ltid() & 63, gw = blockIdx.x * 8 + (ltid() >> 6), nw = gridDim.x * 8;
    f32x4 gv[4];
#pragma unroll
    for (int i = 0; i < 4; ++i) gv[i] = *(const f32x4*)(g + i * 256 + lane * 4);
    for (int r = gw; r < nrows; r += nw) {
        f32x4 v[4]; float ss = 0.f;
#pragma unroll
        for (int i = 0; i < 4; ++i) {
            if (Xh) { const u32x2 h = *(const u32x2*)(Xh + (size_t)r * 1024 + i * 256 + lane * 4); v[i] = (f32x4){bflo(h.x), bfhi(h.x), bflo(h.y), bfhi(h.y)}; }
            else v[i] = *(const f32x4*)(X + (size_t)r * 1024 + i * 256 + lane * 4);
            ss += v[i][0] * v[i][0] + v[i][1] * v[i][1] + v[i][2] * v[i][2] + v[i][3] * v[i][3]; }
        ss = wave_sum(ss); const float rs = rsqrtf(ss * (1.0f / 1024.0f) + 1e-6f);
#pragma unroll
        for (int i = 0; i < 4; ++i) { u32x2 w; w.x = cvt_pk_bf16(v[i][0] * rs * gv[i][0], v[i][1] * rs * gv[i][1]); w.y = cvt_pk_bf16(v[i][2] * rs * gv[i][2], v[i][3] * rs * gv[i][3]);
            *(u32x2*)(dst + (size_t)r * ld_dst + i * 256 + lane * 4) = w; }
    }
}
__device__ __forceinline__ void norm_final(const u16* __restrict__ Xh, float* out, const float* __restrict__ g, int nrows) {
    const int lane = ltid() & 63, gw = blockIdx.x * 8 + (ltid() >> 6), nw = gridDim.x * 8;
    f32x4 gv[4];
#pragma unroll
    for (int i = 0; i < 4; ++i) gv[i] = *(const f32x4*)(g + i * 256 + lane * 4);
    for (int r = gw; r < nrows; r += nw) {
        f32x4 v[4]; float ss = 0.f;
#pragma unroll
        for (int i = 0; i < 4; ++i) { const u32x2 h = *(const u32x2*)(Xh + (size_t)r * 1024 + i * 256 + lane * 4); v[i] = (f32x4){bflo(h.x), bfhi(h.x), bflo(h.y), bfhi(h.y)};
            ss += v[i][0] * v[i][0] + v[i][1] * v[i][1] + v[i][2] * v[i][2] + v[i][3] * v[i][3]; }
        ss = wave_sum(ss); const float rs = rsqrtf(ss * (1.0f / 1024.0f) + 1e-6f);
#pragma unroll
        for (int i = 0; i < 4; ++i) *(f32x4*)(out + (size_t)r * 1024 + i * 256 + lane * 4) = v[i] * rs * gv[i];
    }
}
__device__ __forceinline__ void norm_shift(const float* __restrict__ X, const u16* __restrict__ Xh, const float* __restrict__ g, const float* __restrict__ mu, u16* XNX, u16* XM, int S) {
    const int lane = ltid() & 63, gw = blockIdx.x * 8 + (ltid() >> 6), nw = gridDim.x * 8;
    f32x4 gv[4], m0[4], m2[4], m3[4];
#pragma unroll
    for (int i = 0; i < 4; ++i) { gv[i] = *(const f32x4*)(g + i * 256 + lane * 4); m0[i] = *(const f32x4*)(mu + i * 256 + lane * 4); m2[i] = *(const f32x4*)(mu + 2048 + i * 256 + lane * 4); m3[i] = *(const f32x4*)(mu + 3072 + i * 256 + lane * 4); }
    for (int run = gw; run < TC / 8; run += nw) {
        const int r0 = run * 8;
        f32x4 xp[4], xc[4], xq[4];
#define NS_LOAD(dst, rr) do { const int r_ = (rr); const bool in_ = (r_ >= 0) && (r_ < TC) && ((r_ / S) == (r0 / S)); float ss_ = 0.f; \
            _Pragma("unroll") for (int i = 0; i < 4; ++i) { if (!in_) dst[i] = (f32x4){0.f, 0.f, 0.f, 0.f}; \
                else if (Xh) { const u32x2 h_ = *(const u32x2*)(Xh + (size_t)r_ * 1024 + i * 256 + lane * 4); dst[i] = (f32x4){bflo(h_.x), bfhi(h_.x), bflo(h_.y), bfhi(h_.y)}; } \
                else dst[i] = *(const f32x4*)(X + (size_t)r_ * 1024 + i * 256 + lane * 4); \
                ss_ += dst[i][0] * dst[i][0] + dst[i][1] * dst[i][1] + dst[i][2] * dst[i][2] + dst[i][3] * dst[i][3]; } \
            ss_ = wave_sum(ss_); const float rs_ = in_ ? rsqrtf(ss_ * (1.0f / 1024.0f) + 1e-6f) : 0.f; \
            _Pragma("unroll") for (int i = 0; i < 4; ++i) dst[i] = dst[i] * rs_ * gv[i]; } while (0)
        NS_LOAD(xp, r0 - 1); NS_LOAD(xc, r0);
#pragma unroll 1
        for (int k = 0; k < 8; ++k) {
            const int r = r0 + k;
            NS_LOAD(xq, r + 1);
#pragma unroll
            for (int i = 0; i < 4; ++i) { float xn[4], xx[4];
#pragma unroll
                for (int e = 0; e < 4; ++e) { xn[e] = xc[i][e]; xx[e] = 0.5f * (xp[i][e] + xq[i][e]) - xn[e]; }
                const size_t o = (size_t)r * 2048 + i * 256 + lane * 4, om = (size_t)r * 1024 + i * 256 + lane * 4;
                u32x2 w; w.x = cvt_pk_bf16(xn[0], xn[1]); w.y = cvt_pk_bf16(xn[2], xn[3]); *(u32x2*)(XNX + o) = w;
                u32x2 z; z.x = cvt_pk_bf16(xx[0], xx[1]); z.y = cvt_pk_bf16(xx[2], xx[3]); *(u32x2*)(XNX + o + 1024) = z;
                u32x2 a; a.x = cvt_pk_bf16(xn[0] + xx[0] * m0[i][0], xn[1] + xx[1] * m0[i][1]); a.y = cvt_pk_bf16(xn[2] + xx[2] * m0[i][2], xn[3] + xx[3] * m0[i][3]); *(u32x2*)(XM + om) = a;
                u32x2 b; b.x = cvt_pk_bf16(xn[0] + xx[0] * m2[i][0], xn[1] + xx[1] * m2[i][1]); b.y = cvt_pk_bf16(xn[2] + xx[2] * m2[i][2], xn[3] + xx[3] * m2[i][3]); *(u32x2*)(XM + (size_t)TC * 1024 + om) = b;
                u32x2 c; c.x = cvt_pk_bf16(xn[0] + xx[0] * m3[i][0], xn[1] + xx[1] * m3[i][1]); c.y = cvt_pk_bf16(xn[2] + xx[2] * m3[i][2], xn[3] + xx[3] * m3[i][3]); *(u32x2*)(XM + (size_t)2 * TC * 1024 + om) = c; }
#pragma unroll
            for (int i = 0; i < 4; ++i) { xp[i] = xc[i]; xc[i] = xq[i]; }
        }
#undef NS_LOAD
    }
}

__device__ __forceinline__ bf16x8 as_bf16x8(u32x4 v) { return __builtin_bit_cast(bf16x8, v); }
__device__ __forceinline__ u32x4 rot8(u32x4 mine, u32x4 partner, int c, const float* __restrict__ rope, float scale) {
    float cs[16];
#pragma unroll
    for (int i = 0; i < 4; ++i) { const f32x4 t = *(const f32x4*)(rope + 4 * i); cs[4 * i] = t[0]; cs[4 * i + 1] = t[1]; cs[4 * i + 2] = t[2]; cs[4 * i + 3] = t[3]; }
    float o[8];
#pragma unroll
    for (int i = 0; i < 4; ++i) {
        const unsigned mw = mine[i], pw = partner[i];
        const float m0 = bflo(mw), m1 = bfhi(mw), p0 = bflo(pw), p1 = bfhi(pw);
        const float c0 = cs[4 * i], s0 = cs[4 * i + 1], c1 = cs[4 * i + 2], s1 = cs[4 * i + 3];
        if (c == 0) { o[2 * i] = (m0 * c0 - p0 * s0) * scale; o[2 * i + 1] = (m1 * c1 - p1 * s1) * scale; }
        else        { o[2 * i] = (m0 * c0 + p0 * s0) * scale; o[2 * i + 1] = (m1 * c1 + p1 * s1) * scale; }
    }
    u32x4 r; r.x = cvt_pk_bf16(o[0], o[1]); r.y = cvt_pk_bf16(o[2], o[3]); r.z = cvt_pk_bf16(o[4], o[5]); r.w = cvt_pk_bf16(o[6], o[7]); return r;
}
__device__ __forceinline__ u32x4 scale8(u32x4 v, float scale) {
    u32x4 r;
#pragma unroll
    for (int i = 0; i < 4; ++i) r[i] = cvt_pk_bf16(bflo(v[i]) * scale, bfhi(v[i]) * scale);
    return r;
}

__device__ __forceinline__ void dil_attn_phase(LAS unsigned char* lds, const u16* __restrict__ Z, u16* PART, float* LSE, const float* __restrict__ ROPE, int S) {
    const int tid = ltid(), lane = tid & 63, w = tid >> 6, fr = lane & 15, fq = lane >> 4;
    LAS u16* Ks = (LAS u16*)lds;
    LAS u16* Vt = (LAS u16*)(lds + 272 * 144);
    const int upb = S >> 7, nunits = (TC / S) * 8 * 3 * upb;
    for (int u = blockIdx.x; u < nunits; u += gridDim.x) {
        const int sh = u / (3 * upb), rem = u % (3 * upb), g = rem / upb, idx = rem % upb, seq = sh >> 3, head = sh & 7;
        const int d = 1 << (2 * g), L = S / d, nb2 = upb / d, r = idx / nb2, pair = idx % nb2;
        const int seqbase = seq * S, kl0 = 128 * pair - 64;
        {
            const int c = tid & 7, klb = tid >> 3;
            u32x4 kv[5], pk[5], vv[5]; int sp[5];
#pragma unroll
            for (int i = 0; i < 5; ++i) {
                const int kl = klb + 64 * i, lp = kl0 + kl; const bool ok = (kl < 272) && (lp >= 0) && (lp < L);
                const int s = ok ? lp * d + r : 0; sp[i] = ok ? s : -1;
                const u16* row = Z + (size_t)(seqbase + s) * 3072 + head * 64;
                kv[i] = ok ? *(const u32x4*)(row + 512 + c * 8) : (u32x4){0u, 0u, 0u, 0u};
                pk[i] = (ok && c < 2) ? *(const u32x4*)(row + 512 + (c ^ 1) * 8) : (u32x4){0u, 0u, 0u, 0u};
                const int klv = lane + 64 * i, lpv = kl0 + klv; const bool okv = (klv < 272) && (lpv >= 0) && (lpv < L);
                const int sv = okv ? lpv * d + r : 0;
                vv[i] = okv ? *(const u32x4*)(Z + (size_t)(seqbase + sv) * 3072 + head * 64 + 1024 + w * 8) : (u32x4){0u, 0u, 0u, 0u};
            }
            __builtin_amdgcn_sched_barrier(0);
#pragma unroll
            for (int i = 0; i < 5; ++i) {
                const int kl = klb + 64 * i;
                if (kl < 272) { u32x4 kk = kv[i]; if (c < 2 && sp[i] >= 0) kk = rot8(kk, pk[i], c, ROPE + sp[i] * 16, 1.0f); *(LAS u32x4*)(Ks + kl * 72 + c * 8) = kk; }
                const int klv = lane + 64 * i;
                if (klv < 272) {
#pragma unroll
                    for (int e = 0; e < 4; ++e) { Vt[(w * 8 + 2 * e) * 280 + klv] = (u16)(vv[i][e] & 0xffffu); Vt[(w * 8 + 2 * e + 1) * 280 + klv] = (u16)(vv[i][e] >> 16); } }
            }
        }
        const int lq = 128 * pair + 16 * w + fr, sq = lq * d + r; const int tokq = seqbase + sq;
        bf16x8 qf[2];
        {
            const u16* row = Z + (size_t)tokq * 3072 + head * 64;
            u32x4 q0 = *(const u32x4*)(row + fq * 8), q1 = *(const u32x4*)(row + 32 + fq * 8);
            if (fq < 2) { const u32x4 pk = *(const u32x4*)(row + (fq ^ 1) * 8); q0 = rot8(q0, pk, fq, ROPE + sq * 16, 0.125f); } else q0 = scale8(q0, 0.125f);
            q1 = scale8(q1, 0.125f);
            qf[0] = as_bf16x8(q0); qf[1] = as_bf16x8(q1);
        }
        __syncthreads();
        f32x4 sacc[10];
#pragma unroll
        for (int kt = 0; kt < 10; ++kt) { sacc[kt] = (f32x4){0.f, 0.f, 0.f, 0.f};
#pragma unroll
            for (int sl = 0; sl < 2; ++sl) { const bf16x8 a = *(const LAS bf16x8*)(Ks + (16 * w + 16 * kt + fr) * 72 + sl * 32 + fq * 8); sacc[kt] = __builtin_amdgcn_mfma_f32_16x16x32_bf16(a, qf[sl], sacc[kt], 0, 0, 0); } }
        float mx = -3.0e38f;
#pragma unroll
        for (int kt = 0; kt < 10; ++kt)
#pragma unroll
            for (int j = 0; j < 4; ++j) { const int diff = 16 * kt + fq * 4 + j - 64 - fr, lp = lq + diff; const bool ok = (diff >= -64) && (diff <= 64) && (lp >= 0) && (lp < L);
                const float sv = ok ? sacc[kt][j] : -1.0e30f; sacc[kt][j] = sv; mx = fmaxf(mx, sv); }
        mx = fmaxf(mx, __shfl_xor(mx, 16)); mx = fmaxf(mx, __shfl_xor(mx, 32));
        float den = 0.f;
#pragma unroll
        for (int kt = 0; kt < 10; ++kt)
#pragma unroll
            for (int j = 0; j < 4; ++j) { const float sv = sacc[kt][j]; const float p = (sv > -1.0e29f) ? __expf(sv - mx) : 0.f; sacc[kt][j] = p; den += p; }
        den += __shfl_xor(den, 16); den += __shfl_xor(den, 32);
        bf16x8 pb[5];
#pragma unroll
        for (int uu = 0; uu < 5; ++uu) { u32x4 t; t.x = cvt_pk_bf16(sacc[2 * uu][0], sacc[2 * uu][1]); t.y = cvt_pk_bf16(sacc[2 * uu][2], sacc[2 * uu][3]);
            t.z = cvt_pk_bf16(sacc[2 * uu + 1][0], sacc[2 * uu + 1][1]); t.w = cvt_pk_bf16(sacc[2 * uu + 1][2], sacc[2 * uu + 1][3]); pb[uu] = as_bf16x8(t); }
        const float inv = 1.0f / den;
        u16* po = PART + ((size_t)g * TC + tokq) * 512 + head * 64 + fq * 4;
#pragma unroll
        for (int mt = 0; mt < 4; ++mt) { f32x4 o = (f32x4){0.f, 0.f, 0.f, 0.f};
#pragma unroll
            for (int uu = 0; uu < 5; ++uu) { const LAS u16* vp = Vt + (mt * 16 + fr) * 280 + 16 * w + 32 * uu + fq * 4;
                const u32x2 lo = *(const LAS u32x2*)vp, hi = *(const LAS u32x2*)(vp + 16); u32x4 t; t.x = lo.x; t.y = lo.y; t.z = hi.x; t.w = hi.y;
                o = __builtin_amdgcn_mfma_f32_16x16x32_bf16(as_bf16x8(t), pb[uu], o, 0, 0, 0); }
            u32x2 wv; wv.x = cvt_pk_bf16(o[0] * inv, o[1] * inv); wv.y = cvt_pk_bf16(o[2] * inv, o[3] * inv); *(u32x2*)(po + mt * 16) = wv; }
        if (fq == 0) LSE[((size_t)g * TC + tokq) * 8 + head] = mx + __logf(den);
        __syncthreads();
    }
}

__device__ __forceinline__ void merge_conv_phase(const u16* __restrict__ Z, const u16* __restrict__ PART, const float* __restrict__ LSE, const float* __restrict__ convw, u16* Y, int S) {
    const int lane = ltid() & 63, gw = blockIdx.x * 8 + (ltid() >> 6), nw = gridDim.x * 8;
    float cw[3][8];
#pragma unroll
    for (int j = 0; j < 3; ++j)
#pragma unroll
        for (int e = 0; e < 8; ++e) cw[j][e] = convw[j * 512 + lane * 8 + e];
    for (int t = gw; t < TC; t += nw) {
        const int s = t % S, head = lane >> 3;
        const float l0 = LSE[((size_t)0 * TC + t) * 8 + head], l1 = LSE[((size_t)1 * TC + t) * 8 + head], l2 = LSE[((size_t)2 * TC + t) * 8 + head];
        const float lm = fmaxf(l0, fmaxf(l1, l2)); float w0 = __expf(l0 - lm), w1 = __expf(l1 - lm), w2 = __expf(l2 - lm); const float wi = 1.0f / (w0 + w1 + w2); w0 *= wi; w1 *= wi; w2 *= wi;
        const u32x4 p0 = *(const u32x4*)(PART + ((size_t)0 * TC + t) * 512 + lane * 8), p1 = *(const u32x4*)(PART + ((size_t)1 * TC + t) * 512 + lane * 8), p2 = *(const u32x4*)(PART + ((size_t)2 * TC + t) * 512 + lane * 8);
        u32x4 ya;
#pragma unroll
        for (int i = 0; i < 4; ++i) ya[i] = cvt_pk_bf16(w0 * bflo(p0[i]) + w1 * bflo(p1[i]) + w2 * bflo(p2[i]), w0 * bfhi(p0[i]) + w1 * bfhi(p1[i]) + w2 * bfhi(p2[i]));
        *(u32x4*)(Y + (size_t)t * 1024 + lane * 8) = ya;
        const u16* zr = Z + (size_t)t * 3072;
        const u32x4 bg = *(const u32x4*)(zr + 1536 + lane * 8);
        float acc[8];
#pragma unroll
        for (int e = 0; e < 8; ++e) acc[e] = 0.f;
#pragma unroll
        for (int j = 0; j < 3; ++j) { const int sj = s + j - 1;
            if (sj >= 0 && sj < S) { const u16* zj = zr + (ptrdiff_t)(j - 1) * 3072; const u32x4 cg = *(const u32x4*)(zj + 2048 + lane * 8), hh = *(const u32x4*)(zj + 2560 + lane * 8);
#pragma unroll
                for (int i = 0; i < 4; ++i) { acc[2 * i] += cw[j][2 * i] * (bflo(cg[i]) * bflo(hh[i])); acc[2 * i + 1] += cw[j][2 * i + 1] * (bfhi(cg[i]) * bfhi(hh[i])); } } }
        u32x4 yb;
#pragma unroll
        for (int i = 0; i < 4; ++i) yb[i] = cvt_pk_bf16(bflo(bg[i]) * acc[2 * i], bfhi(bg[i]) * acc[2 * i + 1]);
        *(u32x4*)(Y + (size_t)t * 1024 + 512 + lane * 8) = yb;
    }
}

__device__ __forceinline__ void cross_attn_pair(LAS unsigned char* lds, const u16* __restrict__ Q, const u16* __restrict__ KV, int memrow0, u16* O, int S, int seq, int head, int qt0) {
    const int tid = ltid(), lane = tid & 63, w = tid >> 6, fr = lane & 15, fq = lane >> 4;
    LAS u16* Ks = (LAS u16*)lds;
    const u16* kvb = KV + (size_t)(memrow0 + seq * 256) * 2048 + head * 256;
    { u32x4 tmp[16];
#pragma unroll
      for (int i = 0; i < 16; ++i) { const int task = tid + i * NTHREADS, key = task >> 5, c = task & 31; tmp[i] = *(const u32x4*)(kvb + (size_t)key * 2048 + c * 8); }
#pragma unroll
      for (int i = 0; i < 16; ++i) { const int task = tid + i * NTHREADS, key = task >> 5, c = task & 31; *(LAS u32x4*)(Ks + key * 264 + c * 8) = tmp[i]; } }
    const int tok0 = seq * S + qt0 * 128 + 16 * w + fr;
    bf16x8 pb[2][8]; float inv[2];
    __syncthreads();
#pragma unroll
    for (int h = 0; h < 2; ++h) {
        bf16x8 qf[8];
        { const u16* row = Q + (size_t)(tok0 + 128 * h) * 1024 + head * 256;
#pragma unroll
          for (int sl = 0; sl < 8; ++sl) qf[sl] = as_bf16x8(scale8(*(const u32x4*)(row + sl * 32 + fq * 8), 0.0625f)); }
        f32x4 sacc[16];
#pragma unroll
        for (int kt = 0; kt < 16; ++kt) { sacc[kt] = (f32x4){0.f, 0.f, 0.f, 0.f};
#pragma unroll
            for (int sl = 0; sl < 8; ++sl) { const bf16x8 a = *(const LAS bf16x8*)(Ks + (16 * kt + fr) * 264 + sl * 32 + fq * 8); sacc[kt] = __builtin_amdgcn_mfma_f32_16x16x32_bf16(a, qf[sl], sacc[kt], 0, 0, 0); } }
        float mx = -3.0e38f;
#pragma unroll
        for (int kt = 0; kt < 16; ++kt)
#pragma unroll
            for (int j = 0; j < 4; ++j) mx = fmaxf(mx, sacc[kt][j]);
        mx = fmaxf(mx, __shfl_xor(mx, 16)); mx = fmaxf(mx, __shfl_xor(mx, 32));
        float den = 0.f;
#pragma unroll
        for (int kt = 0; kt < 16; ++kt)
#pragma unroll
            for (int j = 0; j < 4; ++j) { const float pe = __expf(sacc[kt][j] - mx); sacc[kt][j] = pe; den += pe; }
        den += __shfl_xor(den, 16); den += __shfl_xor(den, 32);
        inv[h] = 1.0f / den;
#pragma unroll
        for (int uu = 0; uu < 8; ++uu) { u32x4 t; t.x = cvt_pk_bf16(sacc[2 * uu][0], sacc[2 * uu][1]); t.y = cvt_pk_bf16(sacc[2 * uu][2], sacc[2 * uu][3]);
            t.z = cvt_pk_bf16(sacc[2 * uu + 1][0], sacc[2 * uu + 1][1]); t.w = cvt_pk_bf16(sacc[2 * uu + 1][2], sacc[2 * uu + 1][3]); pb[h][uu] = as_bf16x8(t); }
    }
    __syncthreads();
    { u32x4 tmp[16]; const int key = (w & 3) * 64 + lane, cb = (w >> 2) * 16;
#pragma unroll
      for (int i = 0; i < 16; ++i) tmp[i] = *(const u32x4*)(kvb + 1024 + (size_t)key * 2048 + (cb + i) * 8);
#pragma unroll
      for (int i = 0; i < 16; ++i) {
#pragma unroll
        for (int e = 0; e < 4; ++e) { Ks[((cb + i) * 8 + 2 * e) * 264 + key] = (u16)(tmp[i][e] & 0xffffu); Ks[((cb + i) * 8 + 2 * e + 1) * 264 + key] = (u16)(tmp[i][e] >> 16); } } }
    __syncthreads();
#pragma unroll
    for (int h = 0; h < 2; ++h) {
        u16* po = O + (size_t)(tok0 + 128 * h) * 1024 + head * 256 + fq * 4;
#pragma unroll
        for (int mt = 0; mt < 16; ++mt) { f32x4 o = (f32x4){0.f, 0.f, 0.f, 0.f};
#pragma unroll
            for (int uu = 0; uu < 8; ++uu) { const LAS u16* vp = Ks + (mt * 16 + fr) * 264 + 32 * uu + fq * 4;
                const u32x2 lo = *(const LAS u32x2*)vp, hi = *(const LAS u32x2*)(vp + 16); u32x4 t; t.x = lo.x; t.y = lo.y; t.z = hi.x; t.w = hi.y;
                o = __builtin_amdgcn_mfma_f32_16x16x32_bf16(as_bf16x8(t), pb[h][uu], o, 0, 0, 0); }
            u32x2 wv; wv.x = cvt_pk_bf16(o[0] * inv[h], o[1] * inv[h]); wv.y = cvt_pk_bf16(o[2] * inv[h], o[3] * inv[h]); *(u32x2*)(po + mt * 16) = wv; }
    }
    __syncthreads();
}
template <int CTRL> __device__ __forceinline__ float dpp_add(float v) { const int t = __builtin_amdgcn_update_dpp(__float_as_int(v), __float_as_int(v), CTRL, 0xf, 0xf, true); return v + __int_as_float(t); }
template <int L> __device__ __forceinline__ float row_reduce(float v) {
    v = dpp_add<0xB1>(v); v = dpp_add<0x4E>(v); v = dpp_add<0x141>(v);
    if (L == 16) v = dpp_add<0x140>(v);
    return v;
}
__device__ __forceinline__ void row_reduce2(float& a, float& b) {
    asm volatile("s_nop 1\n\t"
        "v_add_f32_dpp %0, %0, %0 quad_perm:[1,0,3,2] row_mask:0xf bank_mask:0xf bound_ctrl:1\n\t"
        "v_add_f32_dpp %1, %1, %1 quad_perm:[1,0,3,2] row_mask:0xf bank_mask:0xf bound_ctrl:1\n\t"
        "s_nop 0\n\t"
        "v_add_f32_dpp %0, %0, %0 quad_perm:[2,3,0,1] row_mask:0xf bank_mask:0xf bound_ctrl:1\n\t"
        "v_add_f32_dpp %1, %1, %1 quad_perm:[2,3,0,1] row_mask:0xf bank_mask:0xf bound_ctrl:1\n\t"
        "s_nop 0\n\t"
        "v_add_f32_dpp %0, %0, %0 row_half_mirror row_mask:0xf bank_mask:0xf bound_ctrl:1\n\t"
        "v_add_f32_dpp %1, %1, %1 row_half_mirror row_mask:0xf bank_mask:0xf bound_ctrl:1\n\t"
        "s_nop 0\n\t"
        "v_add_f32_dpp %0, %0, %0 row_mirror row_mask:0xf bank_mask:0xf bound_ctrl:1\n\t"
        "v_add_f32_dpp %1, %1, %1 row_mirror row_mask:0xf bank_mask:0xf bound_ctrl:1"
        : "+v"(a), "+v"(b));
}
__device__ __forceinline__ void half_reduce2(float& a, float& b) {
    asm volatile("s_nop 1\n\t"
        "v_add_f32_dpp %0, %0, %0 quad_perm:[1,0,3,2] row_mask:0xf bank_mask:0xf bound_ctrl:1\n\t"
        "v_add_f32_dpp %1, %1, %1 quad_perm:[1,0,3,2] row_mask:0xf bank_mask:0xf bound_ctrl:1\n\t"
        "s_nop 0\n\t"
        "v_add_f32_dpp %0, %0, %0 quad_perm:[2,3,0,1] row_mask:0xf bank_mask:0xf bound_ctrl:1\n\t"
        "v_add_f32_dpp %1, %1, %1 quad_perm:[2,3,0,1] row_mask:0xf bank_mask:0xf bound_ctrl:1\n\t"
        "s_nop 0\n\t"
        "v_add_f32_dpp %0, %0, %0 row_half_mirror row_mask:0xf bank_mask:0xf bound_ctrl:1\n\t"
        "v_add_f32_dpp %1, %1, %1 row_half_mirror row_mask:0xf bank_mask:0xf bound_ctrl:1"
        : "+v"(a), "+v"(b));
}
__device__ __forceinline__ void half_reduce1(float& a) {
    asm volatile("s_nop 1\n\t"
        "v_add_f32_dpp %0, %0, %0 quad_perm:[1,0,3,2] row_mask:0xf bank_mask:0xf bound_ctrl:1\n\t"
        "s_nop 1\n\t"
        "v_add_f32_dpp %0, %0, %0 quad_perm:[2,3,0,1] row_mask:0xf bank_mask:0xf bound_ctrl:1\n\t"
        "s_nop 1\n\t"
        "v_add_f32_dpp %0, %0, %0 row_half_mirror row_mask:0xf bank_mask:0xf bound_ctrl:1\n\t"
        "s_nop 1"
        : "+v"(a));
}
__device__ __forceinline__ void row_reduce4(float& a, float& b, float& c, float& d) {
#define RR4_STEP(ctl) "v_add_f32_dpp %0, %0, %0 " ctl " row_mask:0xf bank_mask:0xf bound_ctrl:1\n\t" "v_add_f32_dpp %1, %1, %1 " ctl " row_mask:0xf bank_mask:0xf bound_ctrl:1\n\t" \
                      "v_add_f32_dpp %2, %2, %2 " ctl " row_mask:0xf bank_mask:0xf bound_ctrl:1\n\t" "v_add_f32_dpp %3, %3, %3 " ctl " row_mask:0xf bank_mask:0xf bound_ctrl:1\n\t"
    asm volatile("s_nop 1\n\t" RR4_STEP("quad_perm:[1,0,3,2]") RR4_STEP("quad_perm:[2,3,0,1]") RR4_STEP("row_half_mirror") RR4_STEP("row_mirror") "s_nop 1"
        : "+v"(a), "+v"(b), "+v"(c), "+v"(d));
#undef RR4_STEP
}
__device__ __forceinline__ void half_reduce4(float& a, float& b, float& c, float& d) {
#define HR4_STEP(ctl) "v_add_f32_dpp %0, %0, %0 " ctl " row_mask:0xf bank_mask:0xf bound_ctrl:1\n\t" "v_add_f32_dpp %1, %1, %1 " ctl " row_mask:0xf bank_mask:0xf bound_ctrl:1\n\t" \
                      "v_add_f32_dpp %2, %2, %2 " ctl " row_mask:0xf bank_mask:0xf bound_ctrl:1\n\t" "v_add_f32_dpp %3, %3, %3 " ctl " row_mask:0xf bank_mask:0xf bound_ctrl:1\n\t"
    asm volatile("s_nop 1\n\t" HR4_STEP("quad_perm:[1,0,3,2]") HR4_STEP("quad_perm:[2,3,0,1]") HR4_STEP("row_half_mirror") "s_nop 0"
        : "+v"(a), "+v"(b), "+v"(c), "+v"(d));
#undef HR4_STEP
}
__device__ __forceinline__ float wave_sum_fast(float v) { v = dpp_add<0xB1>(v); v = dpp_add<0x4E>(v); v = dpp_add<0x141>(v); v = dpp_add<0x140>(v); v += __shfl_xor(v, 16); v += __shfl_xor(v, 32); return v; }
constexpr int TS = 32;
struct ScanRaw { u16 r[8], k[8], v[8], e[8], a[8]; };
template <int RR, int J>
__device__ __forceinline__ void scan_item(LAS unsigned char* lds, const u16* __restrict__ RKV, const u16* __restrict__ Ed, const u16* __restrict__ Ad, const float* __restrict__ kkw, const float* __restrict__ kaw,
                          const float* __restrict__ rkw, u16* OD, float* BON, int S, int seqbase, int head, int dir, int rowbase) {
    constexpr int NACT = 4;
    const int tid = ltid(), lane = tid & 63, w = tid >> 6;
    constexpr int L = 64 / J, NRG = 64 / L;
    const int rg = lane / L, jg = lane % L, j0 = jg * J, row0 = rowbase + w * (NRG * RR) + rg * RR;
    const float kkc = kkw[head * 64 + lane], kac = kaw[head * 64 + lane], rkc = rkw[head * 64 + lane];
    f32x2 st_[RR][J / 2];
#pragma unroll
    for (int r = 0; r < RR; ++r)
#pragma unroll
        for (int q = 0; q < J / 2; ++q) st_[r][q] = (f32x2){0.f, 0.f};
    const int nch = S / TS;
    ScanRaw raw;
    constexpr int NPT = 8;
    const bool prep = (w >= 4); const int pw = w - 4;
#define SCAN_LOAD(ch) do { if (prep) { _Pragma("unroll") for (int q = 0; q < NPT; ++q) { const int i = (ch) * TS + pw * NPT + q; const int t = dir ? (S - 1 - i) : i; const size_t tok = (size_t)(seqbase + t); \
        raw.r[q] = RKV[tok * 3072 + head * 64 + lane]; raw.k[q] = RKV[tok * 3072 + 1024 + head * 64 + lane]; raw.v[q] = RKV[tok * 3072 + 2048 + head * 64 + lane]; \
        raw.e[q] = Ed[tok * 1024 + head * 64 + lane]; raw.a[q] = Ad[tok * 1024 + head * 64 + lane]; } } } while (0)
#define SCAN_PREP(buf, ch) do { if (prep) { LAS float* B_ = (LAS float*)(lds + (buf) * 49152); _Pragma("unroll") for (int q = 0; q < NPT; ++q) { const int ls = pw * NPT + q; \
        const float r_ = bf2f(raw.r[q]), k_ = bf2f(raw.k[q]), v_ = bf2f(raw.v[q]), a_ = bf2f(raw.a[q]); const float e_ = (float)__builtin_bit_cast(_Float16, raw.e[q]); \
        const float kr_ = k_ * kkc; const float ss_ = wave_sum_fast(kr_ * kr_); const float kk_ = kr_ * rsqrtf(fmaxf(ss_, 1e-24f)); \
        B_[(0 * TS + ls) * 64 + lane] = __expf(-e_); B_[(1 * TS + ls) * 64 + lane] = -kk_; B_[(2 * TS + ls) * 64 + lane] = kk_ * a_; \
        const float kd_ = k_ * (1.0f + (a_ - 1.0f) * kac); const float bn_ = wave_sum_fast(r_ * kd_ * rkc); \
        { const int i_ = (ch) * TS + ls; const int t_ = dir ? (S - 1 - i_) : i_; if (lane == 0) BON[((size_t)dir * TC + seqbase + t_) * 16 + head] = bn_; } \
        B_[(3 * TS + ls) * 64 + lane] = kd_; B_[(4 * TS + ls) * 64 + lane] = r_; B_[(5 * TS + ls) * 64 + lane] = v_; } } } while (0)
    float os[RR], po[RR];
#pragma unroll
    for (int r = 0; r < RR; ++r) { os[r] = 0.f; po[r] = 0.f; }
    SCAN_LOAD(0);
    SCAN_PREP(0, 0);
    __syncthreads();
    for (int ch = 0; ch < nch; ++ch) {
        if (ch + 1 < nch) SCAN_LOAD(ch + 1);
        if (w < NACT) {
            const LAS float* B = (const LAS float*)(lds + (ch & 1) * 49152);
            f32x4 W[J / 4], A[J / 4], Bb[J / 4], K[J / 4], R[J / 4];
#pragma unroll
            for (int q = 0; q < J / 4; ++q) { W[q] = *(const LAS f32x4*)(B + (0 * TS) * 64 + j0 + 4 * q); A[q] = *(const LAS f32x4*)(B + (1 * TS) * 64 + j0 + 4 * q); Bb[q] = *(const LAS f32x4*)(B + (2 * TS) * 64 + j0 + 4 * q);
                K[q] = *(const LAS f32x4*)(B + (3 * TS) * 64 + j0 + 4 * q); R[q] = *(const LAS f32x4*)(B + (4 * TS) * 64 + j0 + 4 * q); }
            float V[RR];
#pragma unroll
            for (int r = 0; r < RR; ++r) V[r] = B[(5 * TS) * 64 + row0 + r];
#pragma unroll
            for (int ls = 0; ls < TS; ++ls) {
                f32x4 nW[J / 4], nA[J / 4], nB[J / 4], nK[J / 4], nR[J / 4]; float nV[RR];
#pragma unroll
                for (int q = 0; q < J / 4; ++q) { nW[q] = W[q]; nA[q] = A[q]; nB[q] = Bb[q]; nK[q] = K[q]; nR[q] = R[q]; }
#pragma unroll
                for (int r = 0; r < RR; ++r) nV[r] = V[r];
                if (ls + 1 < TS) {
#pragma unroll
                    for (int q = 0; q < J / 4; ++q) { nW[q] = *(const LAS f32x4*)(B + (0 * TS + ls + 1) * 64 + j0 + 4 * q); nA[q] = *(const LAS f32x4*)(B + (1 * TS + ls + 1) * 64 + j0 + 4 * q); nB[q] = *(const LAS f32x4*)(B + (2 * TS + ls + 1) * 64 + j0 + 4 * q);
                        nK[q] = *(const LAS f32x4*)(B + (3 * TS + ls + 1) * 64 + j0 + 4 * q); nR[q] = *(const LAS f32x4*)(B + (4 * TS + ls + 1) * 64 + j0 + 4 * q); }
                    if (RR == 1) nV[0] = B[(5 * TS + ls + 1) * 64 + row0];
                    else if (RR == 2) { const f32x2 t = *(const LAS f32x2*)(B + (5 * TS + ls + 1) * 64 + row0); nV[0] = t[0]; nV[RR - 1] = t[1]; }
                    else { const f32x4 t = *(const LAS f32x4*)(B + (5 * TS + ls + 1) * 64 + row0);
#pragma unroll
                        for (int r = 0; r < RR; ++r) nV[r] = t[r]; }
                }
                __builtin_amdgcn_sched_barrier(0);
                float sa[RR];
#pragma unroll
                for (int r = 0; r < RR; ++r) { f32x2 p = st_[r][0] * (f32x2){A[0][0], A[0][1]};
#pragma unroll
                    for (int q = 1; q < J / 2; ++q) p = st_[r][q] * (f32x2){A[q >> 1][(q & 1) * 2], A[q >> 1][(q & 1) * 2 + 1]} + p;
                    sa[r] = p[0] + p[1]; }
                static_assert(RR == 2, "merged reduction written for two rows per lane");
                if (J == 4) row_reduce4(sa[0], sa[1], po[0], po[1]); else half_reduce4(sa[0], sa[1], po[0], po[1]);
                {
                    const int pl = (ls + TS - 1) & (TS - 1);
                    const bool mine = (jg == (pl & (L - 1)));
                    os[0] = mine ? po[0] : os[0]; os[1] = mine ? po[1] : os[1];
                    if ((pl & (L - 1)) == L - 1 && (ls > 0 || ch > 0)) {
                        const int i = (ls > 0 ? ch : ch - 1) * TS + (pl - (L - 1)) + jg; const int t = dir ? (S - 1 - i) : i;
                        *(unsigned*)(OD + ((size_t)dir * TC + seqbase + t) * 1024 + head * 64 + row0) = cvt_pk_bf16(os[0], os[1]);
                    }
                }
#pragma unroll
                for (int r = 0; r < RR; ++r) { const f32x2 sv = {sa[r], sa[r]}, vv = {V[r], V[r]}; f32x2 u = {0.f, 0.f};
#pragma unroll
                    for (int q = 0; q < J / 2; ++q) { const int qq = q >> 1, e = (q & 1) * 2;
                        st_[r][q] = st_[r][q] * (f32x2){W[qq][e], W[qq][e + 1]} + (sv * (f32x2){Bb[qq][e], Bb[qq][e + 1]} + vv * (f32x2){K[qq][e], K[qq][e + 1]});
                        u = st_[r][q] * (f32x2){R[qq][e], R[qq][e + 1]} + u; }
                    po[r] = u[0] + u[1]; }
                __builtin_amdgcn_sched_barrier(0);
#pragma unroll
                for (int q = 0; q < J / 4; ++q) { W[q] = nW[q]; A[q] = nA[q]; Bb[q] = nB[q]; K[q] = nK[q]; R[q] = nR[q]; }
#pragma unroll
                for (int r = 0; r < RR; ++r) V[r] = nV[r];
            }
        }
        if (ch + 1 < nch) SCAN_PREP((ch + 1) & 1, ch + 1);
        __syncthreads();
    }
    if (w < NACT) {
        if (J == 4) row_reduce2(po[0], po[1]); else half_reduce2(po[0], po[1]);
        const bool mine = (jg == L - 1);
        os[0] = mine ? po[0] : os[0]; os[1] = mine ? po[1] : os[1];
        const int i = (nch - 1) * TS + (TS - L) + jg; const int t = dir ? (S - 1 - i) : i;
        *(unsigned*)(OD + ((size_t)dir * TC + seqbase + t) * 1024 + head * 64 + row0) = cvt_pk_bf16(os[0], os[1]);
    }
#undef SCAN_LOAD
#undef SCAN_PREP
}
__device__ __forceinline__ void scan_phase(LAS unsigned char* lds, const u16* RKV, const u16* EAG, const float* kkw, const float* kaw, const float* rkw, u16* OD, float* BON, int S) {
    for (int item = blockIdx.x; item < 256; item += gridDim.x) {
        if (S == 4096) { const int id = item >> 1, half = item & 1, seq = id >> 5, rem = id & 31, head = rem >> 1, dir = rem & 1;
            scan_item<2, 4>(lds, RKV, EAG + (size_t)dir * TC * 1024, EAG + (size_t)(2 + dir) * TC * 1024, kkw, kaw, rkw, OD, BON, S, seq * S, head, dir, half * 32);
        } else { const int seq = item >> 5, rem = item & 31, head = rem >> 1, dir = rem & 1;
            scan_item<2, 8>(lds, RKV, EAG + (size_t)dir * TC * 1024, EAG + (size_t)(2 + dir) * TC * 1024, kkw, kaw, rkw, OD, BON, S, seq * S, head, dir, 0);
        }
        __syncthreads();
    }
}
__device__ __forceinline__ float quad_sum(float v) { v = dpp_add<0xB1>(v); v = dpp_add<0x4E>(v); return v; }
__device__ __forceinline__ void rwkv_post_phase(const u16* __restrict__ OD, const float* __restrict__ BON, const u16* __restrict__ RKV, const u16* __restrict__ EAG,
                                const float* __restrict__ lnw, const float* __restrict__ lnb, u16* Y) {
    const int lane = ltid() & 63, gw = blockIdx.x * 8 + (ltid() >> 6), nw = gridDim.x * 8, c0 = lane * 16;
    float lw[16], lb[16];
#pragma unroll
    for (int i = 0; i < 4; ++i) { const f32x4 c = *(const f32x4*)(lnw + c0 + 4 * i), d = *(const f32x4*)(lnb + c0 + 4 * i);
#pragma unroll
        for (int e = 0; e < 4; ++e) { lw[4 * i + e] = c[e]; lb[4 * i + e] = d[e]; } }
    for (int t = gw; t < TC; t += nw) {
        u32x4 oa[2], ob[2], vv[2], gg[2];
#pragma unroll
        for (int i = 0; i < 2; ++i) { oa[i] = *(const u32x4*)(OD + (size_t)t * 1024 + c0 + 8 * i); ob[i] = *(const u32x4*)(OD + ((size_t)TC + t) * 1024 + c0 + 8 * i);
            vv[i] = *(const u32x4*)(RKV + (size_t)t * 3072 + 2048 + c0 + 8 * i); gg[i] = *(const u32x4*)(EAG + ((size_t)4 * TC + t) * 1024 + c0 + 8 * i); }
        const float bsum = BON[(size_t)t * 16 + (lane >> 2)] + BON[((size_t)TC + t) * 16 + (lane >> 2)];
        float y[16];
#pragma unroll
        for (int i = 0; i < 16; ++i) { const int w_ = (i & 7) >> 1; const bool hi = i & 1; y[i] = (hi ? bfhi(oa[i >> 3][w_]) : bflo(oa[i >> 3][w_])) + (hi ? bfhi(ob[i >> 3][w_]) : bflo(ob[i >> 3][w_])); }
        float sm = 0.f;
#pragma unroll
        for (int i = 0; i < 16; ++i) sm += y[i];
        const float mean = quad_sum(sm) * (1.0f / 64.0f);
        float sv = 0.f;
#pragma unroll
        for (int i = 0; i < 16; ++i) { y[i] -= mean; sv += y[i] * y[i]; }
        const float rstd = rsqrtf(quad_sum(sv) * (1.0f / 64.0f) + 64e-5f);
        float o[16];
#pragma unroll
        for (int i = 0; i < 16; ++i) { const int w_ = (i & 7) >> 1; const bool hi = i & 1;
            const float v = hi ? bfhi(vv[i >> 3][w_]) : bflo(vv[i >> 3][w_]), g = hi ? bfhi(gg[i >> 3][w_]) : bflo(gg[i >> 3][w_]);
            o[i] = (y[i] * rstd * lw[i] + lb[i] + bsum * v) * g; }
#pragma unroll
        for (int i = 0; i < 2; ++i) { u32x4 w; w.x = cvt_pk_bf16(o[8 * i], o[8 * i + 1]); w.y = cvt_pk_bf16(o[8 * i + 2], o[8 * i + 3]); w.z = cvt_pk_bf16(o[8 * i + 4], o[8 * i + 5]); w.w = cvt_pk_bf16(o[8 * i + 6], o[8 * i + 7]);
            *(u32x4*)(Y + (size_t)t * 1024 + c0 + 8 * i) = w; }
    }
}
__device__ __forceinline__ void build_w2comb(u16* W2, const float* __restrict__ w2, const float* __restrict__ a2, const float* __restrict__ g2) {
    const size_t total = (size_t)384 * 5120, stride = (size_t)gridDim.x * NTHREADS;
    for (size_t idx = (size_t)blockIdx.x * NTHREADS + ltid(); idx < total; idx += stride) {
        const int k = (int)(idx / 5120), n = (int)(idx % 5120), sel = n >> 10, nn = n & 1023; float v = 0.f;
        if (sel == 0 && k < 64) v = w2[(size_t)k * 1024 + nn];
        else if (sel == 1 && k >= 64 && k < 128) v = w2[(size_t)(64 + (k - 64)) * 1024 + nn];
        else if (sel == 2 && k >= 128 && k < 192) v = a2[(size_t)(k - 128) * 1024 + nn];
        else if (sel == 3 && k >= 192 && k < 256) v = a2[(size_t)(64 + (k - 192)) * 1024 + nn];
        else if (sel == 4 && k >= 256 && k < 384) v = g2[(size_t)(k - 256) * 1024 + nn];
        W2[(size_t)n * 384 + k] = f2bf(v);
    }
}

namespace pg8 {
struct EpiAny {
    static constexpr bool PERM = true, AFTER_DRAIN = false;
    int mode; u16* o16; u16* o16b; u16* x; const float* b0; const float* b1; int ldc; int M; unsigned long long* ssw; const unsigned long long* ssr; const float* xin;
    __device__ __forceinline__ void operator()(const f32x4 (&acc)[2][2][4][2], const Unit& u, int wr, int wc, int fr, int fq) const {
        if (mode == 0) EpiStore16{o16, ldc, ssr}(acc, u, wr, wc, fr, fq);
        else if (mode == 1) EpiResid{x, xin, ssw}(acc, u, wr, wc, fr, fq);
        else if (mode == 2) EpiSwiglu{o16, ssr}(acc, u, wr, wc, fr, fq);
        else if (mode == 3) EpiRwkv{o16}(acc, u, wr, wc, fr, fq);
        else EpiLora2{o16, b0, b1, M}(acc, u, wr, wc, fr, fq);
    }
};
}

__global__ void __launch_bounds__(NTHREADS, 2) mega(Params p) {
    extern __shared__ __attribute__((aligned(16))) unsigned char lds_raw[];
    LAS unsigned char* lds = (LAS unsigned char*)lds_raw;
    ltid_setup();
    cg::grid_group grid = cg::this_grid();
    unsigned char* const ws = p.ws;
    u16* const Xb = (u16*)(ws + WS_ARENA + AR_A);
    unsigned char* const RA = (unsigned char*)p.out;
    const size_t gstride = (size_t)gridDim.x * NTHREADS;

    {
        float* const ROPE = (float*)(ws + WS_ROPE);
        for (size_t i = (size_t)blockIdx.x * NTHREADS + ltid(); i < 4096 * 8; i += gstride) { const int pos = (int)(i >> 3), fi = (int)(i & 7);
            const float inv = powf(500000.0f, -2.0f * (float)fi / 16.0f); const float ang = (float)pos * inv;
            ROPE[i * 2] = (float)cos((double)ang); ROPE[i * 2 + 1] = (float)sin((double)ang); }
    }
    if (blockIdx.x == 0) for (int i = ltid(); i < XCD_BAR_WORDS; i += NTHREADS) ((unsigned*)(ws + WS_BAR))[i] = 0u;
    __syncthreads();
    grid.sync();
    volatile LAS unsigned* xst = (volatile LAS unsigned*)(lds + LDS_BYTES - 16);
    if (ltid() == 0) { xst[0] = 0u; xst[1] = 0u; }
    __syncthreads();
    XcdBarrier xbar = xcd_barrier_post((unsigned*)(ws + WS_BAR), xst);
#ifndef DUP_MISC
#define DUP_MISC 1
#endif
#ifndef DUP_SYNC
#define DUP_SYNC 1
#endif
#ifndef DUP_STEP
#define DUP_STEP -1
#define DUP_PAR -1
#endif
#ifndef DUP_SCAN
#define DUP_SCAN 1
#endif
    for (int ph = 0; ph < 4 * NCHUNK * 15; ++ph) {
        const int l = ph / (NCHUNK * 15), c = (ph / 15) % NCHUNK, s = ph % 15;
        const int e = l >> 1; const bool odd = (l & 1) != 0;
        if (s < 3 && c != 0) continue;
        if (s == 6 && !odd) continue;
        if (s == 8 || s == 12 || s == 10) continue;
        const int S = c < 2 ? 4096 : 2048;
        u16* const Xc = Xb + (size_t)c * TC * 1024;
        const float* const Xin0 = c < 2 ? p.in[0] + (size_t)c * TC * 1024 : p.in[1];
        unsigned char* const AR = ws + WS_ARENA;
        u16* const XN = (u16*)RA; u16* const BUFB = (u16*)(AR + AR_B); u16* const BUFC = (u16*)(AR + AR_C); u16* const Y = (u16*)(AR + AR_D);
        bool do_gemm = false; const u16* gA = nullptr; const u16* gB = nullptr; int gM = TC, gN = 1024, gK = 1024; size_t g_grp = 0; int g_shift = 0, ngemm = 1;
        pg8::EpiAny E{0, nullptr, nullptr, nullptr, nullptr, nullptr, 0, TC, nullptr, nullptr, nullptr};
        unsigned long long* const SSC = (unsigned long long*)(ws + WS_SS); unsigned long long* const SSF = SSC + TC;
        for (int dup = 0; dup < ((s == 5 && odd) ? DUP_SCAN : ((s == DUP_STEP && (DUP_PAR < 0 || (int)odd == DUP_PAR)) ? 2 : DUP_MISC)); ++dup) {
        if (s == 0) {
            const float* mu = p.in[12] + (size_t)e * 6 * 1024;
            u16* const WMIX = (u16*)(ws + WS_WMIX);
            for (int j = 0; j < 22; ++j) {
                const float* src = nullptr; int ld_src = 1024, K = 1024, N = 1024, ld_dst = 1024, col0 = 0, mode = 0; u16* dst = nullptr; const float* s1 = nullptr;
                if (j < 17) {
                    if (!odd) {
                        if (j == 0) { src = p.in[9] + (size_t)e * 1024 * 3072; ld_src = 3072; N = 3072; dst = WMIX; }
                        else if (j == 1) { src = p.in[10] + (size_t)e * 1024 * 1024; dst = WMIX + (size_t)3072 * 1024; }
                        else continue;
                    } else {
                        const int half = j & 1, q = j >> 1;
                        u16* const WL1 = WMIX + (size_t)3072 * 1024;
                        if (q < 3) { if (half) continue; src = p.in[13 + q] + (size_t)e * 1024 * 1024; dst = WMIX + (size_t)q * 1024 * 1024; }
                        else if (q < 5) { const int d = q - 3; src = p.in[18] + ((size_t)e * 2 + d) * 1024 * 64; ld_src = 64; N = 64; dst = WL1 + (size_t)(d * 64) * 2048; ld_dst = 2048; col0 = half * 1024; if (half) s1 = mu + 1 * 1024; }
                        else if (q < 7) { const int d = q - 5; src = p.in[21] + ((size_t)e * 2 + d) * 1024 * 64; ld_src = 64; N = 64; dst = WL1 + (size_t)(128 + d * 64) * 2048; ld_dst = 2048; col0 = half * 1024; if (half) s1 = mu + 4 * 1024; }
                        else if (q == 7) { src = p.in[23] + (size_t)e * 1024 * 128; ld_src = 128; N = 128; dst = WL1 + (size_t)256 * 2048; ld_dst = 2048; col0 = half * 1024; if (half) s1 = mu + 5 * 1024; }
                        else { if (half) continue; src = p.in[16] + (size_t)e * 1024 * 1024; dst = (u16*)(ws + WS_WMIX + WMIX_C); }
                    }
                } else if (j == 17) { src = p.in[30] + (size_t)l * 1024 * 1024; dst = (u16*)(ws + WS_WQ); s1 = p.in[5] + l * 1024; }
                else if (j == 18) { src = p.in[31] + (size_t)l * 1024 * 2048; ld_src = 2048; N = 2048; dst = (u16*)(ws + WS_WKV); }
                else if (j == 19) { src = p.in[32] + (size_t)l * 1024 * 1024; dst = (u16*)(ws + WS_WO); }
                else if (j == 20) { src = p.in[33] + (size_t)l * 1024 * 5632; ld_src = 5632; N = 5632; dst = (u16*)(ws + WS_WGU); mode = 1; s1 = p.in[7] + l * 1024; }
                else { src = p.in[34] + (size_t)l * 2816 * 1024; K = 2816; dst = (u16*)(ws + WS_WDN); ld_dst = 2816; }
                tr_job(lds, src, ld_src, K, N, dst, ld_dst, col0, s1, mode, j * 37);
            }
            if (odd) {
                for (size_t i = (size_t)blockIdx.x * NTHREADS + ltid(); i < (size_t)128 * 2048 / 8; i += gstride) ((u32x4*)(WMIX + (size_t)3072 * 1024 + (size_t)384 * 2048))[i] = (u32x4){0u, 0u, 0u, 0u};
                build_w2comb((u16*)(ws + WS_WMIX + WMIX_B), p.in[19] + (size_t)e * 2 * 64 * 1024, p.in[22] + (size_t)e * 2 * 64 * 1024, p.in[24] + (size_t)e * 128 * 1024);
            }
        }
        if (s == 0) {
            for (int rep = 0; rep < 2; ++rep) norm_rows(p.in[2 + rep], nullptr, p.in[6] + l * 1024, (u16*)(ws + WS_MN) + (size_t)rep * 2048 * 1024, 1024, 2048);
        }
        else if (s == 1) { do_gemm = true; gA = (u16*)(ws + WS_MN); gB = (u16*)(ws + WS_WKV); gM = 4096; gN = 2048; E.o16 = (u16*)(ws + WS_KV); E.ldc = 2048; }
        else if (s == 3) { do_gemm = true; gB = (u16*)(ws + WS_WMIX);
            if (!odd) { gA = XN; gN = 3072; E.o16 = BUFB; E.ldc = 3072; }
            else { gA = BUFC; gN = 3072; E.o16 = BUFB; E.ldc = 3072; g_grp = (size_t)TC * 1024 * 2; g_shift = 2; ngemm = 2; } }
        else if (s == 4) {
            if (!odd) dil_attn_phase(lds, BUFB, BUFC, (float*)(AR + AR_C + (size_t)3 * TC * 512 * 2), (const float*)(ws + WS_ROPE), S);
            else { do_gemm = true; gA = (u16*)(RA + (size_t)TC * 4096); gB = (u16*)(ws + WS_WMIX + WMIX_B); gN = 5120; gK = 384; E.mode = 4; E.o16 = BUFC; E.b0 = p.in[17] + (size_t)e * 2048; E.b1 = p.in[20] + (size_t)e * 2048; }
        }
        else if (s == 5) {
            if (!odd) merge_conv_phase(BUFB, BUFC, (const float*)(AR + AR_C + (size_t)3 * TC * 512 * 2), p.in[11] + (size_t)e * 3 * 512, Y, S);
            else scan_phase(lds, BUFB, BUFC, p.in[25] + (size_t)e * 1024, p.in[26] + (size_t)e * 1024, p.in[27] + (size_t)e * 1024, (u16*)RA, (float*)(RA + (size_t)TC * 4096), S);
        }
        else if (s == 6) rwkv_post_phase((const u16*)RA, (const float*)(RA + (size_t)TC * 4096), BUFB, BUFC, p.in[28] + (size_t)e * 1024, p.in[29] + (size_t)e * 1024, Y);
        else if (s == 7) { do_gemm = true; gA = Y; gB = odd ? (u16*)(ws + WS_WMIX + WMIX_C) : (u16*)(ws + WS_WMIX) + (size_t)3072 * 1024; E.mode = 1; E.x = Xc; E.xin = (l == 0) ? Xin0 : nullptr; E.ssw = SSC; }
        else if (s == 9) { do_gemm = true; gA = Xc; gB = (u16*)(ws + WS_WQ); E.o16 = BUFB; E.ldc = 1024; E.ssr = SSC; }
        else if (s == 11) { do_gemm = true; gA = BUFC; gB = (u16*)(ws + WS_WO); E.mode = 1; E.x = Xc; E.xin = nullptr; E.ssw = SSF; }
        else if (s == 13) { do_gemm = true; gA = Xc; gB = (u16*)(ws + WS_WGU); gN = 5632; E.mode = 2; E.o16 = BUFB; E.ssr = SSF; }
        else if (s == 14) { do_gemm = true; gA = BUFB; gB = (u16*)(ws + WS_WDN); gK = 2816; E.mode = 1; E.x = Xc; E.xin = nullptr; }
        }
        if (do_gemm) {
            for (int gi = 0; gi < ngemm; ++gi) {
                if (gi == 1) { gA = XN; gB = (u16*)(ws + WS_WMIX) + (size_t)3072 * 1024; gN = 512; gK = 2048; g_grp = 0; g_shift = 0; E.mode = 3; E.o16 = (u16*)(RA + (size_t)TC * 4096); }
                pg8::Gemm g{gA, gB, gM, gN, gK, g_grp, g_shift}; pg8::StaticOrder SO; SO.init(gM, gN, (int)gridDim.x, (int)blockIdx.x);
                pg8::gemm_phase<pg8::EpiAny, pg8::StaticOrder, false>(lds, g, SO, E, nullptr);
            }
        }
        if (s == 9) {
            pg8::StaticOrder SO2; SO2.init(TC, 1024, (int)gridDim.x, (int)blockIdx.x); pg8::Unit u;
            for (int i = 0; SO2.next(i, u); ++i) { const int t0 = u.pm * 256, seq = t0 / S, qt = (t0 % S) >> 7;
                cross_attn_pair(lds, BUFB, (const u16*)(ws + WS_KV), c < 2 ? c * 1024 : 2048, BUFC, S, seq, u.pn, qt); }
        }
        {
            const int nc = (s == 2 && c == 0) ? 0 : ((s == 14 && c < 2) ? c + 1 : -1);
            if (nc >= 0) {
                const int Sn = nc < 2 ? 4096 : 2048;
                const float* xs = (nc < 2 ? p.in[0] + (size_t)nc * TC * 1024 : p.in[1]);
                const u16* xh = (l == 0) ? nullptr : Xb + (size_t)nc * TC * 1024;
                for (size_t i = (size_t)blockIdx.x * NTHREADS + ltid(); i < (size_t)2 * TC; i += gstride) SSC[i] = 0ull;
                if (odd) norm_shift(xs, xh, p.in[4] + l * 1024, p.in[12] + (size_t)e * 6 * 1024, XN, BUFC, Sn);
                else norm_rows(xs, xh, p.in[4] + l * 1024, XN, 1024, TC);
            }
        }
        if (s == 1) continue;
        for (int dup = 0; dup < DUP_SYNC; ++dup) xcd_barrier(xbar);
    }
    norm_final(Xb, p.out, p.in[8], 49152);
}

extern "C" void kernel_launch(void* const* d_in, const int* in_sizes, int n_in, void* d_out, int out_size, void* d_ws, size_t ws_size, hipStream_t stream) {
    static int grid_blocks = 0;
    if (!grid_blocks) {
        int dev = 0, cus = 0, per_cu = 0;
        if (n_in != 35 || out_size != 49152 * 1024 || ws_size < WS_END) { fprintf(stderr, "kernel_launch: unexpected problem (n_in %d out %d ws %zu need %zu)\n", n_in, out_size, ws_size, (size_t)WS_END); grid_blocks = -1; return; }
        (void)hipGetDevice(&dev);
        (void)hipDeviceGetAttribute(&cus, hipDeviceAttributeMultiprocessorCount, dev);
        (void)hipFuncSetAttribute((const void*)mega, hipFuncAttributeMaxDynamicSharedMemorySize, LDS_BYTES);
        (void)hipOccupancyMaxActiveBlocksPerMultiprocessor(&per_cu, (const void*)mega, NTHREADS, LDS_BYTES);
        if (per_cu < 1) { fprintf(stderr, "kernel_launch: occupancy query says %d blocks per CU\n", per_cu); }
        grid_blocks = cus > 0 ? cus : 256;
    }
    if (grid_blocks < 0) return;
    Params p{};
    for (int i = 0; i < 35; ++i) p.in[i] = (const float*)d_in[i];
    p.out = (float*)d_out; p.ws = (unsigned char*)d_ws;
    void* args[] = {&p};
    hipError_t err = hipLaunchCooperativeKernel((void*)mega, dim3(grid_blocks), dim3(NTHREADS), args, LDS_BYTES, stream);
    if (err != hipSuccess) fprintf(stderr, "cooperative launch failed: %s (grid %d)\n", hipGetErrorString(err), grid_blocks);
}
```

```cpp
#include <hip/hip_runtime.h>
#include <hip/hip_cooperative_groups.h>
#include <cstdio>
namespace cg = cooperative_groups;

#define LAS __attribute__((address_space(3)))
typedef unsigned short u16;
typedef short bf16x8 __attribute__((ext_vector_type(8)));
typedef float f32x4 __attribute__((ext_vector_type(4)));
typedef float f32x2 __attribute__((ext_vector_type(2)));
typedef unsigned u32x4 __attribute__((ext_vector_type(4)));
typedef unsigned u32x2 __attribute__((ext_vector_type(2)));

constexpr int DM = 1024;
constexpr int TC = 16384;
constexpr int NCHUNK = 3;
constexpr int NTHREADS = 512;
constexpr int LDS_BYTES = 139264;

__device__ __forceinline__ unsigned cvt_pk_bf16(float lo, float hi) { unsigned r; asm volatile("v_cvt_pk_bf16_f32 %0, %1, %2" : "=v"(r) : "v"(lo), "v"(hi)); return r; }
__device__ __forceinline__ u16 f2bf(float x) { return (u16)(cvt_pk_bf16(x, 0.f) & 0xffffu); }
__device__ __forceinline__ float bf2f(u16 b) { return __uint_as_float(((unsigned)b) << 16); }
__device__ __forceinline__ float bflo(unsigned w) { return __uint_as_float(w << 16); }
__device__ __forceinline__ float bfhi(unsigned w) { return __uint_as_float(w & 0xffff0000u); }
__device__ __forceinline__ float sigmoidf_(float x) { return 1.0f / (1.0f + __expf(-x)); }
__device__ __forceinline__ float wave_sum(float v) {
#pragma unroll
    for (int o = 32; o >= 1; o >>= 1) v += __shfl_xor(v, o);
    return v;
}
constexpr int WVMAP_OFF = LDS_BYTES - 16 - 256;
__device__ __forceinline__ unsigned hw_slot() { return (unsigned)__builtin_amdgcn_s_getreg((5 << 11) | 4) & 63u; }
__device__ __forceinline__ int ltid() {
    extern __shared__ __attribute__((aligned(16))) unsigned char lds_dyn_[];
    const int wv = __builtin_amdgcn_readfirstlane(*(const volatile LAS int*)((LAS unsigned char*)lds_dyn_ + WVMAP_OFF + hw_slot() * 4));
    int lane; asm volatile("v_mbcnt_lo_u32_b32 %0, -1, 0\n\tv_mbcnt_hi_u32_b32 %0, -1, %0" : "=v"(lane));
    return (wv << 6) | lane;
}
__device__ __forceinline__ void ltid_setup() {
    extern __shared__ __attribute__((aligned(16))) unsigned char lds_dyn_[];
    if ((threadIdx.x & 63) == 0) *(volatile LAS int*)((LAS unsigned char*)lds_dyn_ + WVMAP_OFF + hw_slot() * 4) = (int)(threadIdx.x >> 6);
    __syncthreads();
}
#define XB_TMO      128
#define XB_XCNT(j)  (256  + 64 * (j))
#define XB_XSUB(j)  (1280 + 64 * (j))
#define XB_XGEN(j)  (2304 + 64 * (j))
#define XB_TOP      3328
#define XB_TOPGEN   3392
#define XCD_BAR_WORDS 3456
#define XB_SPIN_CAP (1u << 18)

__device__ __forceinline__ unsigned xb_ld(unsigned* p)              { return __hip_atomic_load(p, __ATOMIC_RELAXED, __HIP_MEMORY_SCOPE_AGENT); }
__device__ __forceinline__ unsigned xb_add(unsigned* p, unsigned v) { return __hip_atomic_fetch_add(p, v, __ATOMIC_RELAXED, __HIP_MEMORY_SCOPE_AGENT); }
__device__ __forceinline__ unsigned xb_xcc_id() { return (unsigned)__builtin_amdgcn_s_getreg((3 << 11) | 20) & 0xFu; }
#define XB_SPIN(cond, bar) do { unsigned _sp = 0; while (cond) { __builtin_amdgcn_s_sleep(1); \
    if ((++_sp & 255u) == 0u) { if (xb_ld(&(bar)[XB_TMO])) break; if (_sp > XB_SPIN_CAP) { atomicAdd(&(bar)[XB_TMO], 1u); break; } } } } while (0)

struct XcdBarrier {
    unsigned* bar; unsigned x;
    volatile LAS unsigned* st;
};

__device__ __forceinline__ XcdBarrier xcd_barrier_post(unsigned* bar, volatile LAS unsigned* st) {
    XcdBarrier b; b.bar = bar; b.x = xb_xcc_id(); b.st = st;
    if (ltid() == 0) (void)xb_add(&bar[XB_XCNT(b.x)], 1u);
    return b;
}
__device__ __forceinline__ void xcd_barrier_complete(unsigned* bar, unsigned x, unsigned& nloc, unsigned& nx) {
    const unsigned G = gridDim.x * gridDim.y * gridDim.z;
    unsigned sum, cnt, mine, sp = 0u;
    for (;;) {
        sum = 0u; cnt = 0u; mine = 0u;
#pragma unroll
        for (unsigned j = 0; j < 16; ++j) { const unsigned c = xb_ld(&bar[XB_XCNT(j)]); sum += c; cnt += (c > 0u) ? 1u : 0u; mine = (j == x) ? c : mine; }
        if (sum == G) break;
        __builtin_amdgcn_s_sleep(1);
        if ((++sp & 255u) == 0u) { if (xb_ld(&bar[XB_TMO])) break; if (sp > XB_SPIN_CAP) { atomicAdd(&bar[XB_TMO], 1u); break; } }
    }
    nloc = mine > 0u ? mine : 1u; nx = cnt > 0u ? cnt : 1u;
}

__device__ __forceinline__ void xcd_barrier(const XcdBarrier& b) {
    asm volatile("s_waitcnt vmcnt(0)" ::: "memory");
    __syncthreads();
    if (ltid() == 0) {
        unsigned* bar = b.bar;
        __builtin_amdgcn_s_waitcnt(0);
        unsigned nloc = b.st[0], nx = b.st[1];
        if (nloc == 0u) { xcd_barrier_complete(bar, b.x, nloc, nx); b.st[0] = nloc; b.st[1] = nx; }
        const unsigned old = xb_add(&bar[XB_XSUB(b.x)], 1u);
        const unsigned gen = old / nloc;
        if (old + 1u == (gen + 1u) * nloc) {
            __builtin_amdgcn_fence(__ATOMIC_RELEASE, "agent");
            asm volatile("s_waitcnt vmcnt(0)" ::: "memory");
            const unsigned og = xb_add(&bar[XB_TOP], 1u);
            const unsigned tg = og / nx;
            if (og + 1u == (tg + 1u) * nx) xb_add(&bar[XB_TOPGEN], 1u);
            else XB_SPIN(xb_ld(&bar[XB_TOPGEN]) == tg, bar);
            __builtin_amdgcn_fence(__ATOMIC_ACQUIRE, "agent");
            xb_add(&bar[XB_XGEN(b.x)], 1u);
            asm volatile("s_waitcnt vmcnt(0)" ::: "memory");
        } else {
            XB_SPIN(xb_ld(&bar[XB_XGEN(b.x)]) == gen, bar);
            __builtin_amdgcn_fence(__ATOMIC_ACQUIRE, "agent");
            asm volatile("s_waitcnt vmcnt(0)" ::: "memory");
        }
    }
    __syncthreads();
}
namespace pg8 {
#define PG8_LAS __attribute__((address_space(3)))
typedef unsigned short bf16_t;
typedef short bf16x8 __attribute__((ext_vector_type(8)));
typedef float f32x4 __attribute__((ext_vector_type(4)));
typedef unsigned u32x4 __attribute__((ext_vector_type(4)));
constexpr int BM = 256, BK = 64, HALF = 128, HTB = HALF * BK * 2  , STAGE_BYTES = 8 * HTB, NXCD = 8, WGM = 8;

__host__ __device__ __forceinline__ int lds_byte(int r, int c) { const int st = (r >> 4) * 2 + (c >> 5), rr = r & 15, cc = c & 31, ob = rr * 64 + cc * 2; return st * 1024 + (ob ^ (((ob >> 9) & 1) << 5)); }
__host__ __device__ __forceinline__ void stage_rc(int b, int& R, int& C) { const int st = b / 1024, sb = b % 1024, swz = sb ^ (((sb >> 9) & 1) << 5); R = (st >> 1) * 16 + swz / 64; C = (st & 1) * 32 + (swz % 64) / 2; }
__host__ __device__ __forceinline__ int perm32(int rho) { const int n = rho >> 4, i = rho & 15; return 8 * (i >> 2) + 4 * n + (i & 3); }

struct Unit { int pm, pn; };
struct Gemm { const bf16_t* A; const bf16_t* Bt; int M, N, K; size_t a_grp_bytes; int a_grp_shift; };

struct StaticOrder {
    int nM, nN, nwg, G, c;
    __host__ __device__ __forceinline__ void init(int M, int N, int G_, int c_) { nM = M / BM; nN = N / BM; nwg = nM * nN; G = G_; c = c_; }
    __host__ __device__ __forceinline__ bool next(int i, Unit& u) const {
        const long L = (long)i * G + c; if (L >= nwg) return false;
        int wgid = (int)L; { const int q = nwg / NXCD, r = nwg % NXCD, xcd = wgid % NXCD, off = wgid / NXCD; wgid = (xcd < r ? xcd * (q + 1) : r * (q + 1) + (xcd - r) * q) + off; }
        const int nig = WGM * nN, gid = wgid / nig, fm = gid * WGM, gsz = (nM - fm) < WGM ? (nM - fm) : WGM;
        u.pm = fm + ((wgid % nig) % gsz); u.pn = (wgid % nig) / gsz; return true;
    }
    __device__ __forceinline__ void a_ready(const Unit&) const {}
    __device__ __forceinline__ void done(const Unit&) const {}
};
struct EpiStore16 {
    static constexpr bool PERM = true, AFTER_DRAIN = false;
    u16* O; int ldc; const unsigned long long* SS;
    __device__ __forceinline__ void operator()(const f32x4 (&acc)[2][2][4][2], const Unit& u, int wr, int wc, int fr, int fq) const {
        const int row0 = u.pm * BM + wr * 64 + fr, col0 = u.pn * BM + wc * 32 + 8 * fq;
#pragma unroll
        for (int ai = 0; ai < 2; ++ai)
#pragma unroll
            for (int m = 0; m < 4; ++m) { const int row = row0 + ai * HALF + m * 16; u16* rowp = O + (size_t)row * ldc + col0;
                const float rs = SS ? rsqrtf((float)SS[row] * (1.0f / (1024.0f * 1048576.0f)) + 1e-6f) : 1.0f;
#pragma unroll
                for (int bj = 0; bj < 2; ++bj) { const f32x4 v0 = acc[ai][bj][m][0] * rs, v1 = acc[ai][bj][m][1] * rs; u32x4 w; w.x = cvt_pk_bf16(v0[0], v0[1]); w.y = cvt_pk_bf16(v0[2], v0[3]); w.z = cvt_pk_bf16(v1[0], v1[1]); w.w = cvt_pk_bf16(v1[2], v1[3]);
                    *(u32x4*)(rowp + bj * HALF) = w; } }
    }
};
struct EpiResid {
    static constexpr bool PERM = true, AFTER_DRAIN = false;
    u16* Xb; const float* Xin32; unsigned long long* SS;
    __device__ __forceinline__ void operator()(const f32x4 (&acc)[2][2][4][2], const Unit& u, int wr, int wc, int fr, int fq) const {
        const int row0 = u.pm * BM + wr * 64 + fr, col0 = u.pn * BM + wc * 32 + 8 * fq;
#pragma unroll
        for (int ai = 0; ai < 2; ++ai)
#pragma unroll
            for (int m = 0; m < 4; ++m) { const int row = row0 + ai * HALF + m * 16; const unsigned off = (unsigned)(row * 1024 + col0); float ss = 0.f;
#pragma unroll
                for (int bj = 0; bj < 2; ++bj) { const unsigned o = off + bj * HALF; f32x4 x0, x1;
                    if (Xin32) { x0 = *(const f32x4*)(Xin32 + o); x1 = *(const f32x4*)(Xin32 + o + 4); }
                    else { const u32x4 h = *(const u32x4*)(Xb + o); x0 = (f32x4){bflo(h.x), bfhi(h.x), bflo(h.y), bfhi(h.y)}; x1 = (f32x4){bflo(h.z), bfhi(h.z), bflo(h.w), bfhi(h.w)}; }
                    const f32x4 v0 = x0 + acc[ai][bj][m][0], v1 = x1 + acc[ai][bj][m][1];
                    u32x4 w; w.x = cvt_pk_bf16(v0[0], v0[1]); w.y = cvt_pk_bf16(v0[2], v0[3]); w.z = cvt_pk_bf16(v1[0], v1[1]); w.w = cvt_pk_bf16(v1[2], v1[3]);
                    *(u32x4*)(Xb + o) = w;
                    if (SS) ss += (v0[0] * v0[0] + v0[1] * v0[1]) + (v0[2] * v0[2] + v0[3] * v0[3]) + (v1[0] * v1[0] + v1[1] * v1[1]) + (v1[2] * v1[2] + v1[3] * v1[3]); }
                if (SS) { ss += __shfl_xor(ss, 16); ss += __shfl_xor(ss, 32); if (fq == 0) atomicAdd(SS + row, (unsigned long long)(ss * 1048576.0f)); } }
    }
};
struct EpiSwiglu {
    static constexpr bool PERM = true, AFTER_DRAIN = false;
    u16* H; const unsigned long long* SS;
    __device__ __forceinline__ void operator()(const f32x4 (&acc)[2][2][4][2], const Unit& u, int wr, int wc, int fr, int fq) const {
        const int row0 = u.pm * BM + wr * 64 + fr, col0 = u.pn * 128 + wc * 16 + 4 * fq;
#pragma unroll
        for (int ai = 0; ai < 2; ++ai)
#pragma unroll
            for (int m = 0; m < 4; ++m) { const int row = row0 + ai * HALF + m * 16; u16* rowp = H + (size_t)row * 2816 + col0;
                const float rs = rsqrtf((float)SS[row] * (1.0f / (1024.0f * 1048576.0f)) + 1e-6f);
#pragma unroll
                for (int bj = 0; bj < 2; ++bj) { const f32x4 g = acc[ai][bj][m][0] * rs, up = acc[ai][bj][m][1] * rs; float h[4];
#pragma unroll
                    for (int j = 0; j < 4; ++j) h[j] = g[j] / (1.0f + __expf(-g[j])) * up[j];
                    u32x2 w; w.x = cvt_pk_bf16(h[0], h[1]); w.y = cvt_pk_bf16(h[2], h[3]); *(u32x2*)(rowp + bj * 64) = w; } }
    }
};
struct EpiRwkv {
    static constexpr bool PERM = true, AFTER_DRAIN = false;
    u16* L1;
    __device__ __forceinline__ void operator()(const f32x4 (&acc)[2][2][4][2], const Unit& u, int wr, int wc, int fr, int fq) const {
        const int row0 = u.pm * BM + wr * 64 + fr;
        const int col0 = u.pn * BM + wc * 32 + 8 * fq; const int t = u.pn;
#pragma unroll
        for (int ai = 0; ai < 2; ++ai)
#pragma unroll
            for (int m = 0; m < 4; ++m) { u16* rowp = L1 + (size_t)(row0 + ai * HALF + m * 16) * 384 + col0;
#pragma unroll
                for (int bj = 0; bj < 2; ++bj) if (!(t == 1 && bj == 1)) {
#pragma unroll
                    for (int n = 0; n < 2; ++n) { f32x4 v = acc[ai][bj][m][n];
#pragma unroll
                        for (int j = 0; j < 4; ++j) { float x = v[j]; if (t == 1) x = sigmoidf_(x); else if (bj == 0) x = tanhf(x); v[j] = x; }
                        u32x2 w; w.x = cvt_pk_bf16(v[0], v[1]); w.y = cvt_pk_bf16(v[2], v[3]); *(u32x2*)(rowp + bj * HALF + n * 4) = w; } } }
    }
};
struct EpiLora2 {
    static constexpr bool PERM = true, AFTER_DRAIN = false;
    u16* EAG; const float* w0; const float* a0; int M;
    __device__ __forceinline__ void operator()(const f32x4 (&acc)[2][2][4][2], const Unit& u, int wr, int wc, int fr, int fq) const {
        const int row0 = u.pm * BM + wr * 64 + fr; const int sel = u.pn >> 2; const int col0 = (u.pn & 3) * BM + wc * 32 + 8 * fq;
        u16* base = EAG + (size_t)sel * M * 1024;
        const float* bias = sel < 2 ? (w0 + sel * 1024) : (a0 + ((sel - 2) & 1) * 1024);
        f32x4 bv[2][2];
#pragma unroll
        for (int bj = 0; bj < 2; ++bj)
#pragma unroll
            for (int n = 0; n < 2; ++n) bv[bj][n] = (sel < 4) ? *(const f32x4*)(bias + col0 + bj * HALF + n * 4) : (f32x4){0.f, 0.f, 0.f, 0.f};
#pragma unroll
        for (int ai = 0; ai < 2; ++ai)
#pragma unroll
            for (int m = 0; m < 4; ++m) { u16* rowp = base + (size_t)(row0 + ai * HALF + m * 16) * 1024 + col0;
#pragma unroll
                for (int bj = 0; bj < 2; ++bj)
#pragma unroll
                    for (int n = 0; n < 2; ++n) { const f32x4 v = acc[ai][bj][m][n] + bv[bj][n]; u32x2 w;
                        if (sel < 2) { _Float16 h[4];
#pragma unroll
                            for (int j = 0; j < 4; ++j) h[j] = (_Float16)(0.60653066f * sigmoidf_(v[j]));
                            w.x = (unsigned)__builtin_bit_cast(u16, h[0]) | ((unsigned)__builtin_bit_cast(u16, h[1]) << 16);
                            w.y = (unsigned)__builtin_bit_cast(u16, h[2]) | ((unsigned)__builtin_bit_cast(u16, h[3]) << 16);
                        } else if (sel < 4) { w.x = cvt_pk_bf16(sigmoidf_(v[0]), sigmoidf_(v[1])); w.y = cvt_pk_bf16(sigmoidf_(v[2]), sigmoidf_(v[3]));
                        } else { w.x = cvt_pk_bf16(v[0], v[1]); w.y = cvt_pk_bf16(v[2], v[3]); }
                        *(u32x2*)(rowp + bj * HALF + n * 4) = w; } }
    }
};
template <class Epi, class Sched, bool STAMP = false>
__device__ __forceinline__ void gemm_phase(PG8_LAS unsigned char* lds, const Gemm g, const Sched& S, const Epi& E, unsigned long long* stamps) {
    const int tid = ltid(), wid = __builtin_amdgcn_readfirstlane(tid >> 6), lane = tid & 63, wr = wid >> 2, wc = wid & 3, fr = lane & 15, fq = lane >> 4;
    const int K = g.K, nt = K / BK;
    int ts_lo = 0, ts_hi = 0, nts = 0; const unsigned long long rt_entry = STAMP ? (unsigned long long)wall_clock64() : 0ull;
#define PG8_STAMP() do { if (STAMP && wid == 0 && nts < 64) { const unsigned long long _c = (unsigned long long)clock64(); \
        ts_lo = (lane == nts) ? (int)(unsigned)_c : ts_lo; ts_hi = (lane == nts) ? (int)(unsigned)(_c >> 32) : ts_hi; ++nts; } } while (0)
    PG8_STAMP();
    unsigned voffA[2], voffB[2];
#pragma unroll
    for (int i = 0; i < 2; ++i) { int R, C; stage_rc(tid * 16 + i * 8192, R, C); const int Rb = Epi::PERM ? ((R & ~31) + perm32(R & 31)) : R;
        voffA[i] = (unsigned)(R * K + C) * 2u; voffB[i] = (unsigned)(Rb * K + C) * 2u; }
    const size_t kstep = (size_t)(BK * 2);
    const size_t hstep = (size_t)HALF * K * 2;
    const size_t tstep = 2 * hstep;
    const unsigned ldsw = (unsigned)wid * 1024u;
    const int aoff = lds_byte(wr * 64 + fr, fq * 8), boff = lds_byte(wc * 32 + fr, fq * 8);
#define PG8_SA(b, h) (((b) * 2 + (h)) * HTB)
#define PG8_SB(b, h) ((4 + (b) * 2 + (h)) * HTB)
#define PG8_STAGE(bufoff, gbase, voff) do { _Pragma("unroll") for (int _i = 0; _i < 2; ++_i) \
        __builtin_amdgcn_global_load_lds((const unsigned*)((const char*)(gbase) + (voff)[_i]), (PG8_LAS unsigned*)(lds + (bufoff) + ldsw + _i * 8192), 16, 0, 0); } while (0)
#define PG8_LDA(dst, b, h) do { _Pragma("unroll") for (int m = 0; m < 4; ++m) _Pragma("unroll") for (int k = 0; k < 2; ++k) dst[m][k] = *(const PG8_LAS bf16x8*)(lds + PG8_SA(b, h) + aoff + m * 2048 + k * 1024); } while (0)
#define PG8_LDB(dst, b, h) do { _Pragma("unroll") for (int n = 0; n < 2; ++n) _Pragma("unroll") for (int k = 0; k < 2; ++k) dst[n][k] = *(const PG8_LAS bf16x8*)(lds + PG8_SB(b, h) + boff + n * 2048 + k * 1024); } while (0)
#define PG8_MMA(ai, bj, At, Bt) do { __builtin_amdgcn_s_setprio(1); _Pragma("unroll") for (int m = 0; m < 4; ++m) _Pragma("unroll") for (int n = 0; n < 2; ++n) _Pragma("unroll") for (int k = 0; k < 2; ++k) \
        acc[ai][bj][m][n] = __builtin_amdgcn_mfma_f32_16x16x32_bf16(Bt[n][k], At[m][k], acc[ai][bj][m][n], 0, 0, 0); __builtin_amdgcn_s_setprio(0); } while (0)
#define PG8_WAIT_V(n) asm volatile("s_waitcnt vmcnt(" #n ")" ::: "memory")
#define PG8_WAIT_L(n) asm volatile("s_waitcnt lgkmcnt(" #n ")" ::: "memory")
#define PG8_BAR __builtin_amdgcn_s_barrier()
#define PG8_SCHED __builtin_amdgcn_sched_barrier(0)
    Unit cur, nxt; int ui = 0;
    if (!S.next(0, cur)) return;
    f32x4 acc[2][2][4][2];
#pragma unroll
    for (int a = 0; a < 2; ++a)
#pragma unroll
        for (int b = 0; b < 2; ++b)
#pragma unroll
            for (int m = 0; m < 4; ++m)
#pragma unroll
                for (int n = 0; n < 2; ++n) acc[a][b][m][n] = (f32x4){0.f, 0.f, 0.f, 0.f};
    bf16x8 At[4][2], B0[2][2], B1[2][2];
    const char* cA = (const char*)g.A + (size_t)cur.pm * tstep + (size_t)(cur.pn >> g.a_grp_shift) * g.a_grp_bytes; const char* cB = (const char*)g.Bt + (size_t)cur.pn * tstep;
    S.a_ready(cur);
    PG8_STAGE(PG8_SB(0, 0), cB, voffB); PG8_STAGE(PG8_SA(0, 0), cA, voffA); PG8_STAGE(PG8_SB(0, 1), cB + hstep, voffB); PG8_STAGE(PG8_SA(0, 1), cA + hstep, voffA);
    if (wr == 1) PG8_BAR;
    PG8_WAIT_V(4); PG8_BAR;
    PG8_STAGE(PG8_SB(1, 0), cB + kstep, voffB); PG8_STAGE(PG8_SA(1, 0), cA + kstep, voffA); PG8_STAGE(PG8_SB(1, 1), cB + hstep + kstep, voffB);
    PG8_WAIT_V(6); PG8_BAR;
    PG8_STAMP();
    for (;;) {
        const bool has_next = S.next(ui + 1, nxt);
        const char* nA = has_next ? (const char*)g.A + (size_t)nxt.pm * tstep + (size_t)(nxt.pn >> g.a_grp_shift) * g.a_grp_bytes : cA; const char* nB = has_next ? (const char*)g.Bt + (size_t)nxt.pn * tstep : cB;
        for (int t = 0; t < nt; t += 2) {
            const bool last = (t == nt - 2);
            const char* a1 = cA + (size_t)(t + 1) * kstep;
            const char* a2 = last ? nA : cA + (size_t)(t + 2) * kstep; const char* b2 = last ? nB : cB + (size_t)(t + 2) * kstep;
            const char* a3 = a2 + kstep; const char* b3 = b2 + kstep;
            if (last && has_next) S.a_ready(nxt);
            PG8_LDB(B0, 0, 0); PG8_SCHED; PG8_LDA(At, 0, 0); PG8_STAGE(PG8_SA(1, 1), a1 + hstep, voffA);
            PG8_WAIT_L(8); PG8_BAR; PG8_WAIT_L(0); PG8_MMA(0, 0, At, B0); PG8_BAR; PG8_SCHED;
            PG8_LDB(B1, 0, 1); PG8_STAGE(PG8_SB(0, 0), b2, voffB);
            PG8_BAR; PG8_WAIT_L(0); PG8_MMA(0, 1, At, B1); PG8_BAR;
            PG8_LDA(At, 0, 1); PG8_STAGE(PG8_SA(0, 0), a2, voffA);
            PG8_BAR; PG8_WAIT_L(0); PG8_MMA(1, 0, At, B0); PG8_BAR; PG8_SCHED;
            PG8_STAGE(PG8_SB(0, 1), b2 + hstep, voffB);
            PG8_WAIT_V(6); PG8_BAR; PG8_MMA(1, 1, At, B1); PG8_BAR;
            PG8_LDB(B0, 1, 0); PG8_SCHED; PG8_LDA(At, 1, 0); PG8_STAGE(PG8_SA(0, 1), a2 + hstep, voffA);
            PG8_WAIT_L(8); PG8_BAR; PG8_WAIT_L(0); PG8_MMA(0, 0, At, B0); PG8_BAR; PG8_SCHED;
            PG8_LDB(B1, 1, 1); PG8_STAGE(PG8_SB(1, 0), b3, voffB);
            PG8_BAR; PG8_WAIT_L(0); PG8_MMA(0, 1, At, B1); PG8_BAR;
            PG8_LDA(At, 1, 1); PG8_STAGE(PG8_SA(1, 0), a3, voffA);
            PG8_BAR; PG8_WAIT_L(0); PG8_MMA(1, 0, At, B0); PG8_BAR; PG8_SCHED;
            PG8_STAGE(PG8_SB(1, 1), b3 + hstep, voffB);
            PG8_WAIT_V(6); PG8_BAR; PG8_MMA(1, 1, At, B1); PG8_BAR;
        }
        PG8_STAMP();
        if constexpr (!Epi::AFTER_DRAIN) { E(acc, cur, wr, wc, fr, fq); S.done(cur); }
        PG8_STAMP();
        if (!has_next) break;
#pragma unroll
        for (int a = 0; a < 2; ++a)
#pragma unroll
            for (int b = 0; b < 2; ++b)
#pragma unroll
                for (int m = 0; m < 4; ++m)
#pragma unroll
                    for (int n = 0; n < 2; ++n) acc[a][b][m][n] = (f32x4){0.f, 0.f, 0.f, 0.f};
        cur = nxt; cA = nA; cB = nB; ++ui;
    }
    PG8_WAIT_V(0);
    if (wr == 0) PG8_BAR;
    PG8_BAR;
    if constexpr (Epi::AFTER_DRAIN) { E.fused(acc, cur, wr, wc, fr, fq, lds, wid, lane); S.done(cur); }
    PG8_STAMP();
    if (STAMP && wid == 0) { stamps[lane] = lane < nts ? (((unsigned long long)(unsigned)ts_hi << 32) | (unsigned)ts_lo) : 0ull;
        if (lane == 62) stamps[62] = rt_entry; if (lane == 63) stamps[63] = (unsigned long long)wall_clock64(); }
#undef PG8_STAMP
#undef PG8_SA
#undef PG8_SB
#undef PG8_STAGE
#undef PG8_LDA
#undef PG8_LDB
#undef PG8_MMA
#undef PG8_WAIT_V
#undef PG8_WAIT_L
#undef PG8_BAR
#undef PG8_SCHED
}
}
struct Params { const float* in[35]; float* out; unsigned char* ws; int pad0, pad1; };

constexpr size_t MB = 1u << 20;
constexpr size_t WS_WMIX  = 0;
constexpr size_t WMIX_B   = (size_t)3584 * 2048 * 2;
constexpr size_t WMIX_C   = WMIX_B + (size_t)5120 * 512 * 2;
constexpr size_t WS_WQ    = WS_WMIX + WMIX_C + (size_t)1024 * 1024 * 2;
constexpr size_t WS_WKV   = WS_WQ + (size_t)1024 * 1024 * 2;
constexpr size_t WS_WO    = WS_WKV + (size_t)2048 * 1024 * 2;
constexpr size_t WS_WGU   = WS_WO + (size_t)1024 * 1024 * 2;
constexpr size_t WS_WDN   = WS_WGU + (size_t)5632 * 1024 * 2;
constexpr size_t WS_MN    = WS_WDN + (size_t)1024 * 2816 * 2;
constexpr size_t WS_KV    = WS_MN + (size_t)4096 * 1024 * 2;
constexpr size_t WS_ROPE  = WS_KV + (size_t)4096 * 2048 * 2;
constexpr size_t WS_ARENA = WS_ROPE + (size_t)4096 * 16 * 4;
constexpr size_t AR_A = 0, AR_B = (size_t)TC * 8192, AR_C = (size_t)TC * 14336, AR_D = (size_t)TC * 24576, AR_END = (size_t)TC * 26624;
constexpr size_t WS_BAR = WS_ARENA + AR_END;
constexpr size_t WS_SS = WS_BAR + 16384;
constexpr size_t WS_END = WS_SS + (size_t)2 * TC * 8;

__device__ __forceinline__ int map_row(int n, int mode) {
    if (mode == 0) return n;
    const int up = n >= 2816, c = up ? n - 2816 : n;
    return (c >> 4) * 32 + ((c & 15) >> 2) * 8 + up * 4 + (c & 3);
}
__device__ __forceinline__ void tr_job(LAS unsigned char* lds, const float* __restrict__ src, int ld_src, int K, int N, u16* dst, int ld_dst, int col0, const float* __restrict__ s1, int mode, int rot) {
    LAS float* T = (LAS float*)lds;
    const int tid = ltid(), nkt = K >> 6, nnt = N >> 6, ntile = nkt * nnt;
    for (int t = (blockIdx.x + rot) % gridDim.x; t < ntile; t += gridDim.x) {
        const int kt = t / nnt, nt = t % nnt;
#pragma unroll
        for (int it = 0; it < 2; ++it) {
            const int kk = (tid >> 4) + it * 32, n4 = (tid & 15) * 4;
            f32x4 v = *(const f32x4*)(src + (size_t)(kt * 64 + kk) * ld_src + nt * 64 + n4);
            const float s = s1 ? s1[kt * 64 + kk] : 1.0f;
#pragma unroll
            for (int e = 0; e < 4; ++e) T[(n4 + e) * 65 + kk] = v[e] * s;
        }
        __syncthreads();
        {
            const int n = tid >> 3, k8 = (tid & 7) * 8; float f[8];
#pragma unroll
            for (int e = 0; e < 8; ++e) f[e] = T[n * 65 + k8 + e];
            u32x4 w; w.x = cvt_pk_bf16(f[0], f[1]); w.y = cvt_pk_bf16(f[2], f[3]); w.z = cvt_pk_bf16(f[4], f[5]); w.w = cvt_pk_bf16(f[6], f[7]);
            *(u32x4*)(dst + (size_t)map_row(nt * 64 + n, mode) * ld_dst + col0 + kt * 64 + k8) = w;
        }
        __syncthreads();
    }
}

__device__ __forceinline__ void norm_rows(const float* __restrict__ X, const u16* __restrict__ Xh, const float* __restrict__ g, u16* dst, int ld_dst, int nrows) {
    const int lane = ltid() & 63, gw = blockIdx.x * 8 + (ltid() >> 6), nw = gridDim.x * 8;
    f32x4 gv[4];
#pragma unroll
    for (int i = 0; i < 4; ++i) gv[i] = *(const f32x4*)(g + i * 256 + lane * 4);
    for (int r = gw; r < nrows; r += nw) {
        f32x4 v[4]; float ss = 0.f;
#pragma unroll
        for (int i = 0; i < 4; ++i) {
            if (Xh) { const u32x2 h = *(const u32x2*)(Xh + (size_t)r * 1024 + i * 256 + lane * 4); v[i] = (f32x4){bflo(h.x), bfhi(h.x), bflo(h.y), bfhi(h.y)}; }
            else v[i] = *(const f32x4*)(X + (size_t)r * 1024 + i * 256 + lane * 4);
            ss += v[i][0] * v[i][0] + v[i][1] * v[i][1] + v[i][2] * v[i][2] + v[i][3] * v[i][3]; }
        ss = wave_sum(ss); const float rs = rsqrtf(ss * (1.0f / 1024.0f) + 1e-6f);
#pragma unroll
        for (int i = 0; i < 4; ++i) { u32x2 w; w.x = cvt_pk_bf16(v[i][0] * rs * gv[i][0], v[i][1] * rs * gv[i][1]); w.y = cvt_pk_bf16(v[i][2] * rs * gv[i][2], v[i][3] * rs * gv[i][3]);
            *(u32x2*)(dst + (size_t)r * ld_dst + i * 256 + lane * 4) = w; }
    }
}
__device__ __forceinline__ void norm_final(const u16* __restrict__ Xh, float* out, const float* __restrict__ g, int nrows) {
    const int lane = ltid() & 63, gw = blockIdx.x * 8 + (ltid() >> 6), nw = gridDim.x * 8;
    f32x4 gv[4];
#pragma unroll
    for (int i = 0; i < 4; ++i) gv[i] = *(const f32x4*)(g + i * 256 + lane * 4);
    for (int r = gw; r < nrows; r += nw) {
        f32x4 v[4]; float ss = 0.f;
#pragma unroll
        for (int i = 0; i < 4; ++i) { const u32x2 h = *(const u32x2*)(Xh + (size_t)r * 1024 + i * 256 + lane * 4); v[i] = (f32x4){bflo(h.x), bfhi(h.x), bflo(h.y), bfhi(h.y)};
            ss += v[i][0] * v[i][0] + v[i][1] * v[i][1] + v[i][2] * v[i][2] + v[i][3] * v[i][3]; }
        ss = wave_sum(ss); const float rs = rsqrtf(ss * (1.0f / 1024.0f) + 1e-6f);
#pragma unroll
        for (int i = 0; i < 4; ++i) *(f32x4*)(out + (size_t)r * 1024 + i * 256 + lane * 4) = v[i] * rs * gv[i];
    }
}
__device__ __forceinline__ void norm_shift(const float* __restrict__ X, const u16* __restrict__ Xh, const float* __restrict__ g, const float* __restrict__ mu, u16* XNX, u16* XM, int S) {
    const int lane = ltid() & 63, gw = blockIdx.x * 8 + (ltid() >> 6), nw = gridDim.x * 8;
    f32x4 gv[4], m0[4], m2[4], m3[4];
#pragma unroll
    for (int i = 0; i < 4; ++i) { gv[i] = *(const f32x4*)(g + i * 256 + lane * 4); m0[i] = *(const f32x4*)(mu + i * 256 + lane * 4); m2[i] = *(const f32x4*)(mu + 2048 + i * 256 + lane * 4); m3[i] = *(const f32x4*)(mu + 3072 + i * 256 + lane * 4); }
    for (int run = gw; run < TC / 8; run += nw) {
        const int r0 = run * 8;
        f32x4 xp[4], xc[4], xq[4];
#define NS_LOAD(dst, rr) do { const int r_ = (rr); const bool in_ = (r_ >= 0) && (r_ < TC) && ((r_ / S) == (r0 / S)); float ss_ = 0.f; \
            _Pragma("unroll") for (int i = 0; i < 4; ++i) { if (!in_) dst[i] = (f32x4){0.f, 0.f, 0.f, 0.f}; \
                else if (Xh) { const u32x2 h_ = *(const u32x2*)(Xh + (size_t)r_ * 1024 + i * 256 + lane * 4); dst[i] = (f32x4){bflo(h_.x), bfhi(h_.x), bflo(h_.y), bfhi(h_.y)}; } \
                else dst[i] = *(const f32x4*)(X + (size_t)r_ * 1024 + i * 256 + lane * 4); \
                ss_ += dst[i][0] * dst[i][0] + dst[i][1] * dst[i][1] + dst[i][2] * dst[i][2] + dst[i][3] * dst[i][3]; } \
            ss_ = wave_sum(ss_); const float rs_ = in_ ? rsqrtf(ss_ * (1.0f / 1024.0f) + 1e-6f) : 0.f; \
            _Pragma("unroll") for (int i = 0; i < 4; ++i) dst[i] = dst[i] * rs_ * gv[i]; } while (0)
        NS_LOAD(xp, r0 - 1); NS_LOAD(xc, r0);
#pragma unroll 1
        for (int k = 0; k < 8; ++k) {
            const int r = r0 + k;
            NS_LOAD(xq, r + 1);
#pragma unroll
            for (int i = 0; i < 4; ++i) { float xn[4], xx[4];
#pragma unroll
                for (int e = 0; e < 4; ++e) { xn[e] = xc[i][e]; xx[e] = 0.5f * (xp[i][e] + xq[i][e]) - xn[e]; }
                const size_t o = (size_t)r * 2048 + i * 256 + lane * 4, om = (size_t)r * 1024 + i * 256 + lane * 4;
                u32x2 w; w.x = cvt_pk_bf16(xn[0], xn[1]); w.y = cvt_pk_bf16(xn[2], xn[3]); *(u32x2*)(XNX + o) = w;
                u32x2 z; z.x = cvt_pk_bf16(xx[0], xx[1]); z.y = cvt_pk_bf16(xx[2], xx[3]); *(u32x2*)(XNX + o + 1024) = z;
                u32x2 a; a.x = cvt_pk_bf16(xn[0] + xx[0] * m0[i][0], xn[1] + xx[1] * m0[i][1]); a.y = cvt_pk_bf16(xn[2] + xx[2] * m0[i][2], xn[3] + xx[3] * m0[i][3]); *(u32x2*)(XM + om) = a;
                u32x2 b; b.x = cvt_pk_bf16(xn[0] + xx[0] * m2[i][0], xn[1] + xx[1] * m2[i][1]); b.y = cvt_pk_bf16(xn[2] + xx[2] * m2[i][2], xn[3] + xx[3] * m2[i][3]); *(u32x2*)(XM + (size_t)TC * 1024 + om) = b;
                u32x2 c; c.x = cvt_pk_bf16(xn[0] + xx[0] * m3[i][0], xn[1] + xx[1] * m3[i][1]); c.y = cvt_pk_bf16(xn[2] + xx[2] * m3[i][2], xn[3] + xx[3] * m3[i][3]); *(u32x2*)(XM + (size_t)2 * TC * 1024 + om) = c; }
#pragma unroll
            for (int i = 0; i < 4; ++i) { xp[i] = xc[i]; xc[i] = xq[i]; }
        }
#undef NS_LOAD
    }
}

__device__ __forceinline__ bf16x8 as_bf16x8(u32x4 v) { return __builtin_bit_cast(bf16x8, v); }
__device__ __forceinline__ u32x4 rot8(u32x4 mine, u32x4 partner, int c, const float* __restrict__ rope, float scale) {
    float cs[16];
#pragma unroll
    for (int i = 0; i < 4; ++i) { const f32x4 t = *(const f32x4*)(rope + 4 * i); cs[4 * i] = t[0]; cs[4 * i + 1] = t[1]; cs[4 * i + 2] = t[2]; cs[4 * i + 3] = t[3]; }
    float o[8];
#pragma unroll
    for (int i = 0; i < 4; ++i) {
        const unsigned mw = mine[i], pw = partner[i];
        const float m0 = bflo(mw), m1 = bfhi(mw), p0 = bflo(pw), p1 = bfhi(pw);
        const float c0 = cs[4 * i], s0 = cs[4 * i + 1], c1 = cs[4 * i + 2], s1 = cs[4 * i + 3];
        if (c == 0) { o[2 * i] = (m0 * c0 - p0 * s0) * scale; o[2 * i + 1] = (m1 * c1 - p1 * s1) * scale; }
        else        { o[2 * i] = (m0 * c0 + p0 * s0) * scale; o[2 * i + 1] = (m1 * c1 + p1 * s1) * scale; }
    }
    u32x4 r; r.x = cvt_pk_bf16(o[0], o[1]); r.y = cvt_pk_bf16(o[2], o[3]); r.z = cvt_pk_bf16(o[4], o[5]); r.w = cvt_pk_bf16(o[6], o[7]); return r;
}
__device__ __forceinline__ u32x4 scale8(u32x4 v, float scale) {
    u32x4 r;
#pragma unroll
    for (int i = 0; i < 4; ++i) r[i] = cvt_pk_bf16(bflo(v[i]) * scale, bfhi(v[i]) * scale);
    return r;
}

__device__ __forceinline__ void dil_attn_phase(LAS unsigned char* lds, const u16* __restrict__ Z, u16* PART, float* LSE, const float* __restrict__ ROPE, int S) {
    const int tid = ltid(), lane = tid & 63, w = tid >> 6, fr = lane & 15, fq = lane >> 4;
    LAS u16* Ks = (LAS u16*)lds;
    LAS u16* Vt = (LAS u16*)(lds + 272 * 144);
    const int upb = S >> 7, nunits = (TC / S) * 8 * 3 * upb;
    for (int u = blockIdx.x; u < nunits; u += gridDim.x) {
        const int sh = u / (3 * upb), rem = u % (3 * upb), g = rem / upb, idx = rem % upb, seq = sh >> 3, head = sh & 7;
        const int d = 1 << (2 * g), L = S / d, nb2 = upb / d, r = idx / nb2, pair = idx % nb2;
        const int seqbase = seq * S, kl0 = 128 * pair - 64;
        {
            const int c = tid & 7, klb = tid >> 3;
            u32x4 kv[5], pk[5], vv[5]; int sp[5];
#pragma unroll
            for (int i = 0; i < 5; ++i) {
                const int kl = klb + 64 * i, lp = kl0 + kl; const bool ok = (kl < 272) && (lp >= 0) && (lp < L);
                const int s = ok ? lp * d + r : 0; sp[i] = ok ? s : -1;
                const u16* row = Z + (size_t)(seqbase + s) * 3072 + head * 64;
                kv[i] = ok ? *(const u32x4*)(row + 512 + c * 8) : (u32x4){0u, 0u, 0u, 0u};
                pk[i] = (ok && c < 2) ? *(const u32x4*)(row + 512 + (c ^ 1) * 8) : (u32x4){0u, 0u, 0u, 0u};
                const int klv = lane + 64 * i, lpv = kl0 + klv; const bool okv = (klv < 272) && (lpv >= 0) && (lpv < L);
                const int sv = okv ? lpv * d + r : 0;
                vv[i] = okv ? *(const u32x4*)(Z + (size_t)(seqbase + sv) * 3072 + head * 64 + 1024 + w * 8) : (u32x4){0u, 0u, 0u, 0u};
            }
            __builtin_amdgcn_sched_barrier(0);
#pragma unroll
            for (int i = 0; i < 5; ++i) {
                const int kl = klb + 64 * i;
                if (kl < 272) { u32x4 kk = kv[i]; if (c < 2 && sp[i] >= 0) kk = rot8(kk, pk[i], c, ROPE + sp[i] * 16, 1.0f); *(LAS u32x4*)(Ks + kl * 72 + c * 8) = kk; }
                const int klv = lane + 64 * i;
                if (klv < 272) {
#pragma unroll
                    for (int e = 0; e < 4; ++e) { Vt[(w * 8 + 2 * e) * 280 + klv] = (u16)(vv[i][e] & 0xffffu); Vt[(w * 8 + 2 * e + 1) * 280 + klv] = (u16)(vv[i][e] >> 16); } }
            }
        }
        const int lq = 128 * pair + 16 * w + fr, sq = lq * d + r; const int tokq = seqbase + sq;
        bf16x8 qf[2];
        {
            const u16* row = Z + (size_t)tokq * 3072 + head * 64;
            u32x4 q0 = *(const u32x4*)(row + fq * 8), q1 = *(const u32x4*)(row + 32 + fq * 8);
            if (fq < 2) { const u32x4 pk = *(const u32x4*)(row + (fq ^ 1) * 8); q0 = rot8(q0, pk, fq, ROPE + sq * 16, 0.125f); } else q0 = scale8(q0, 0.125f);
            q1 = scale8(q1, 0.125f);
            qf[0] = as_bf16x8(q0); qf[1] = as_bf16x8(q1);
        }
        __syncthreads();
        f32x4 sacc[10];
#pragma unroll
        for (int kt = 0; kt < 10; ++kt) { sacc[kt] = (f32x4){0.f, 0.f, 0.f, 0.f};
#pragma unroll
            for (int sl = 0; sl < 2; ++sl) { const bf16x8 a = *(const LAS bf16x8*)(Ks + (16 * w + 16 * kt + fr) * 72 + sl * 32 + fq * 8); sacc[kt] = __builtin_amdgcn_mfma_f32_16x16x32_bf16(a, qf[sl], sacc[kt], 0, 0, 0); } }
        float mx = -3.0e38f;
#pragma unroll
        for (int kt = 0; kt < 10; ++kt)
#pragma unroll
            for (int j = 0; j < 4; ++j) { const int diff = 16 * kt + fq * 4 + j - 64 - fr, lp = lq + diff; const bool ok = (diff >= -64) && (diff <= 64) && (lp >= 0) && (lp < L);
                const float sv = ok ? sacc[kt][j] : -1.0e30f; sacc[kt][j] = sv; mx = fmaxf(mx, sv); }
        mx = fmaxf(mx, __shfl_xor(mx, 16)); mx = fmaxf(mx, __shfl_xor(mx, 32));
        float den = 0.f;
#pragma unroll
        for (int kt = 0; kt < 10; ++kt)
#pragma unroll
            for (int j = 0; j < 4; ++j) { const float sv = sacc[kt][j]; const float p = (sv > -1.0e29f) ? __expf(sv - mx) : 0.f; sacc[kt][j] = p; den += p; }
        den += __shfl_xor(den, 16); den += __shfl_xor(den, 32);
        bf16x8 pb[5];
#pragma unroll
        for (int uu = 0; uu < 5; ++uu) { u32x4 t; t.x = cvt_pk_bf16(sacc[2 * uu][0], sacc[2 * uu][1]); t.y = cvt_pk_bf16(sacc[2 * uu][2], sacc[2 * uu][3]);
            t.z = cvt_pk_bf16(sacc[2 * uu + 1][0], sacc[2 * uu + 1][1]); t.w = cvt_pk_bf16(sacc[2 * uu + 1][2], sacc[2 * uu + 1][3]); pb[uu] = as_bf16x8(t); }
        const float inv = 1.0f / den;
        u16* po = PART + ((size_t)g * TC + tokq) * 512 + head * 64 + fq * 4;
#pragma unroll
        for (int mt = 0; mt < 4; ++mt) { f32x4 o = (f32x4){0.f, 0.f, 0.f, 0.f};
#pragma unroll
            for (int uu = 0; uu < 5; ++uu) { const LAS u16* vp = Vt + (mt * 16 + fr) * 280 + 16 * w + 32 * uu + fq * 4;
                const u32x2 lo = *(const LAS u32x2*)vp, hi = *(const LAS u32x2*)(vp + 16); u32x4 t; t.x = lo.x; t.y = lo.y; t.z = hi.x; t.w = hi.y;
                o = __builtin_amdgcn_mfma_f32_16x16x32_bf16(as_bf16x8(t), pb[uu], o, 0, 0, 0); }
            u32x2 wv; wv.x = cvt_pk_bf16(o[0] * inv, o[1] * inv); wv.y = cvt_pk_bf16(o[2] * inv, o[3] * inv); *(u32x2*)(po + mt * 16) = wv; }
        if (fq == 0) LSE[((size_t)g * TC + tokq) * 8 + head] = mx + __logf(den);
        __syncthreads();
    }
}

__device__ __forceinline__ void merge_conv_phase(const u16* __restrict__ Z, const u16* __restrict__ PART, const float* __restrict__ LSE, const float* __restrict__ convw, u16* Y, int S) {
    const int lane = ltid() & 63, gw = blockIdx.x * 8 + (ltid() >> 6), nw = gridDim.x * 8;
    float cw[3][8];
#pragma unroll
    for (int j = 0; j < 3; ++j)
#pragma unroll
        for (int e = 0; e < 8; ++e) cw[j][e] = convw[j * 512 + lane * 8 + e];
    for (int t = gw; t < TC; t += nw) {
        const int s = t % S, head = lane >> 3;
        const float l0 = LSE[((size_t)0 * TC + t) * 8 + head], l1 = LSE[((size_t)1 * TC + t) * 8 + head], l2 = LSE[((size_t)2 * TC + t) * 8 + head];
        const float lm = fmaxf(l0, fmaxf(l1, l2)); float w0 = __expf(l0 - lm), w1 = __expf(l1 - lm), w2 = __expf(l2 - lm); const float wi = 1.0f / (w0 + w1 + w2); w0 *= wi; w1 *= wi; w2 *= wi;
        const u32x4 p0 = *(const u32x4*)(PART + ((size_t)0 * TC + t) * 512 + lane * 8), p1 = *(const u32x4*)(PART + ((size_t)1 * TC + t) * 512 + lane * 8), p2 = *(const u32x4*)(PART + ((size_t)2 * TC + t) * 512 + lane * 8);
        u32x4 ya;
#pragma unroll
        for (int i = 0; i < 4; ++i) ya[i] = cvt_pk_bf16(w0 * bflo(p0[i]) + w1 * bflo(p1[i]) + w2 * bflo(p2[i]), w0 * bfhi(p0[i]) + w1 * bfhi(p1[i]) + w2 * bfhi(p2[i]));
        *(u32x4*)(Y + (size_t)t * 1024 + lane * 8) = ya;
        const u16* zr = Z + (size_t)t * 3072;
        const u32x4 bg = *(const u32x4*)(zr + 1536 + lane * 8);
        float acc[8];
#pragma unroll
        for (int e = 0; e < 8; ++e) acc[e] = 0.f;
#pragma unroll
        for (int j = 0; j < 3; ++j) { const int sj = s + j - 1;
            if (sj >= 0 && sj < S) { const u16* zj = zr + (ptrdiff_t)(j - 1) * 3072; const u32x4 cg = *(const u32x4*)(zj + 2048 + lane * 8), hh = *(const u32x4*)(zj + 2560 + lane * 8);
#pragma unroll
                for (int i = 0; i < 4; ++i) { acc[2 * i] += cw[j][2 * i] * (bflo(cg[i]) * bflo(hh[i])); acc[2 * i + 1] += cw[j][2 * i + 1] * (bfhi(cg[i]) * bfhi(hh[i])); } } }
        u32x4 yb;
#pragma unroll
        for (int i = 0; i < 4; ++i) yb[i] = cvt_pk_bf16(bflo(bg[i]) * acc[2 * i], bfhi(bg[i]) * acc[2 * i + 1]);
        *(u32x4*)(Y + (size_t)t * 1024 + 512 + lane * 8) = yb;
    }
}

__device__ __forceinline__ void cross_attn_pair(LAS unsigned char* lds, const u16* __restrict__ Q, const u16* __restrict__ KV, int memrow0, u16* O, int S, int seq, int head, int qt0) {
    const int tid = ltid(), lane = tid & 63, w = tid >> 6, fr = lane & 15, fq = lane >> 4;
    LAS u16* Ks = (LAS u16*)lds;
    const u16* kvb = KV + (size_t)(memrow0 + seq * 256) * 2048 + head * 256;
    { u32x4 tmp[16];
#pragma unroll
      for (int i = 0; i < 16; ++i) { const int task = tid + i * NTHREADS, key = task >> 5, c = task & 31; tmp[i] = *(const u32x4*)(kvb + (size_t)key * 2048 + c * 8); }
#pragma unroll
      for (int i = 0; i < 16; ++i) { const int task = tid + i * NTHREADS, key = task >> 5, c = task & 31; *(LAS u32x4*)(Ks + key * 264 + c * 8) = tmp[i]; } }
    const int tok0 = seq * S + qt0 * 128 + 16 * w + fr;
    bf16x8 pb[2][8]; float inv[2];
    __syncthreads();
#pragma unroll
    for (int h = 0; h < 2; ++h) {
        bf16x8 qf[8];
        { const u16* row = Q + (size_t)(tok0 + 128 * h) * 1024 + head * 256;
#pragma unroll
          for (int sl = 0; sl < 8; ++sl) qf[sl] = as_bf16x8(scale8(*(const u32x4*)(row + sl * 32 + fq * 8), 0.0625f)); }
        f32x4 sacc[16];
#pragma unroll
        for (int kt = 0; kt < 16; ++kt) { sacc[kt] = (f32x4){0.f, 0.f, 0.f, 0.f};
#pragma unroll
            for (int sl = 0; sl < 8; ++sl) { const bf16x8 a = *(const LAS bf16x8*)(Ks + (16 * kt + fr) * 264 + sl * 32 + fq * 8); sacc[kt] = __builtin_amdgcn_mfma_f32_16x16x32_bf16(a, qf[sl], sacc[kt], 0, 0, 0); } }
        float mx = -3.0e38f;
#pragma unroll
        for (int kt = 0; kt < 16; ++kt)
#pragma unroll
            for (int j = 0; j < 4; ++j) mx = fmaxf(mx, sacc[kt][j]);
        mx = fmaxf(mx, __shfl_xor(mx, 16)); mx = fmaxf(mx, __shfl_xor(mx, 32));
        float den = 0.f;
#pragma unroll
        for (int kt = 0; kt < 16; ++kt)
#pragma unroll
            for (int j = 0; j < 4; ++j) { const float pe = __expf(sacc[kt][j] - mx); sacc[kt][j] = pe; den += pe; }
        den += __shfl_xor(den, 16); den += __shfl_xor(den, 32);
        inv[h] = 1.0f / den;
#pragma unroll
        for (int uu = 0; uu < 8; ++uu) { u32x4 t; t.x = cvt_pk_bf16(sacc[2 * uu][0], sacc[2 * uu][1]); t.y = cvt_pk_bf16(sacc[2 * uu][2], sacc[2 * uu][3]);
            t.z = cvt_pk_bf16(sacc[2 * uu + 1][0], sacc[2 * uu + 1][1]); t.w = cvt_pk_bf16(sacc[2 * uu + 1][2], sacc[2 * uu + 1][3]); pb[h][uu] = as_bf16x8(t); }
    }
    __syncthreads();
    { u32x4 tmp[16]; const int key = (w & 3) * 64 + lane, cb = (w >> 2) * 16;
#pragma unroll
      for (int i = 0; i < 16; ++i) tmp[i] = *(const u32x4*)(kvb + 1024 + (size_t)key * 2048 + (cb + i) * 8);
#pragma unroll
      for (int i = 0; i < 16; ++i) {
#pragma unroll
        for (int e = 0; e < 4; ++e) { Ks[((cb + i) * 8 + 2 * e) * 264 + key] = (u16)(tmp[i][e] & 0xffffu); Ks[((cb + i) * 8 + 2 * e + 1) * 264 + key] = (u16)(tmp[i][e] >> 16); } } }
    __syncthreads();
#pragma unroll
    for (int h = 0; h < 2; ++h) {
        u16* po = O + (size_t)(tok0 + 128 * h) * 1024 + head * 256 + fq * 4;
#pragma unroll
        for (int mt = 0; mt < 16; ++mt) { f32x4 o = (f32x4){0.f, 0.f, 0.f, 0.f};
#pragma unroll
            for (int uu = 0; uu < 8; ++uu) { const LAS u16* vp = Ks + (mt * 16 + fr) * 264 + 32 * uu + fq * 4;
                const u32x2 lo = *(const LAS u32x2*)vp, hi = *(const LAS u32x2*)(vp + 16); u32x4 t; t.x = lo.x; t.y = lo.y; t.z = hi.x; t.w = hi.y;
                o = __builtin_amdgcn_mfma_f32_16x16x32_bf16(as_bf16x8(t), pb[h][uu], o, 0, 0, 0); }
            u32x2 wv; wv.x = cvt_pk_bf16(o[0] * inv[h], o[1] * inv[h]); wv.y = cvt_pk_bf16(o[2] * inv[h], o[3] * inv[h]); *(u32x2*)(po + mt * 16) = wv; }
    }
    __syncthreads();
}
template <int CTRL> __device__ __forceinline__ float dpp_add(float v) { const int t = __builtin_amdgcn_update_dpp(__float_as_int(v), __float_as_int(v), CTRL, 0xf, 0xf, true); return v + __int_as_float(t); }
template <int L> __device__ __forceinline__ float row_reduce(float v) {
    v = dpp_add<0xB1>(v); v = dpp_add<0x4E>(v); v = dpp_add<0x141>(v);
    if (L == 16) v = dpp_add<0x140>(v);
    return v;
}
__device__ __forceinline__ void row_reduce2(float& a, float& b) {
    asm volatile("s_nop 1\n\t"
        "v_add_f32_dpp %0, %0, %0 quad_perm:[1,0,3,2] row_mask:0xf bank_mask:0xf bound_ctrl:1\n\t"
        "v_add_f32_dpp %1, %1, %1 quad_perm:[1,0,3,2] row_mask:0xf bank_mask:0xf bound_ctrl:1\n\t"
        "s_nop 0\n\t"
        "v_add_f32_dpp %0, %0, %0 quad_perm:[2,3,0,1] row_mask:0xf bank_mask:0xf bound_ctrl:1\n\t"
        "v_add_f32_dpp %1, %1, %1 quad_perm:[2,3,0,1] row_mask:0xf bank_mask:0xf bound_ctrl:1\n\t"
        "s_nop 0\n\t"
        "v_add_f32_dpp %0, %0, %0 row_half_mirror row_mask:0xf bank_mask:0xf bound_ctrl:1\n\t"
        "v_add_f32_dpp %1, %1, %1 row_half_mirror row_mask:0xf bank_mask:0xf bound_ctrl:1\n\t"
        "s_nop 0\n\t"
        "v_add_f32_dpp %0, %0, %0 row_mirror row_mask:0xf bank_mask:0xf bound_ctrl:1\n\t"
        "v_add_f32_dpp %1, %1, %1 row_mirror row_mask:0xf bank_mask:0xf bound_ctrl:1"
        : "+v"(a), "+v"(b));
}
__device__ __forceinline__ void half_reduce2(float& a, float& b) {
    asm volatile("s_nop 1\n\t"
        "v_add_f32_dpp %0, %0, %0 quad_perm:[1,0,3,2] row_mask:0xf bank_mask:0xf bound_ctrl:1\n\t"
        "v_add_f32_dpp %1, %1, %1 quad_perm:[1,0,3,2] row_mask:0xf bank_mask:0xf bound_ctrl:1\n\t"
        "s_nop 0\n\t"
        "v_add_f32_dpp %0, %0, %0 quad_perm:[2,3,0,1] row_mask:0xf bank_mask:0xf bound_ctrl:1\n\t"
        "v_add_f32_dpp %1, %1, %1 quad_perm:[2,3,0,1] row_mask:0xf bank_mask:0xf bound_ctrl:1\n\t"
        "s_nop 0\n\t"
        "v_add_f32_dpp %0, %0, %0 row_half_mirror row_mask:0xf bank_mask:0xf bound_ctrl:1\n\t"
        "v_add_f32_dpp %1, %1, %1 row_half_mirror row_mask:0xf bank_mask:0xf bound_ctrl:1"
        : "+v"(a), "+v"(b));
}
__device__ __forceinline__ void half_reduce1(float& a) {
    asm volatile("s_nop 1\n\t"
        "v_add_f32_dpp %0, %0, %0 quad_perm:[1,0,3,2] row_mask:0xf bank_mask:0xf bound_ctrl:1\n\t"
        "s_nop 1\n\t"
        "v_add_f32_dpp %0, %0, %0 quad_perm:[2,3,0,1] row_mask:0xf bank_mask:0xf bound_ctrl:1\n\t"
        "s_nop 1\n\t"
        "v_add_f32_dpp %0, %0, %0 row_half_mirror row_mask:0xf bank_mask:0xf bound_ctrl:1\n\t"
        "s_nop 1"
        : "+v"(a));
}
__device__ __forceinline__ void row_reduce4(float& a, float& b, float& c, float& d) {
#define RR4_STEP(ctl) "v_add_f32_dpp %0, %0, %0 " ctl " row_mask:0xf bank_mask:0xf bound_ctrl:1\n\t" "v_add_f32_dpp %1, %1, %1 " ctl " row_mask:0xf bank_mask:0xf bound_ctrl:1\n\t" \
                      "v_add_f32_dpp %2, %2, %2 " ctl " row_mask:0xf bank_mask:0xf bound_ctrl:1\n\t" "v_add_f32_dpp %3, %3, %3 " ctl " row_mask:0xf bank_mask:0xf bound_ctrl:1\n\t"
    asm volatile("s_nop 1\n\t" RR4_STEP("quad_perm:[1,0,3,2]") RR4_STEP("quad_perm:[2,3,0,1]") RR4_STEP("row_half_mirror") RR4_STEP("row_mirror") "s_nop 1"
        : "+v"(a), "+v"(b), "+v"(c), "+v"(d));
#undef RR4_STEP
}
__device__ __forceinline__ void half_reduce4(float& a, float& b, float& c, float& d) {
#define HR4_STEP(ctl) "v_add_f32_dpp %0, %0, %0 " ctl " row_mask:0xf bank_mask:0xf bound_ctrl:1\n\t" "v_add_f32_dpp %1, %1, %1 " ctl " row_mask:0xf bank_mask:0xf bound_ctrl:1\n\t" \
                      "v_add_f32_dpp %2, %2, %2 " ctl " row_mask:0xf bank_mask:0xf bound_ctrl:1\n\t" "v_add_f32_dpp %3, %3, %3 " ctl " row_mask:0xf bank_mask:0xf bound_ctrl:1\n\t"
    asm volatile("s_nop 1\n\t" HR4_STEP("quad_perm:[1,0,3,2]") HR4_STEP("quad_perm:[2,3,0,1]") HR4_STEP("row_half_mirror") "s_nop 0"
        : "+v"(a), "+v"(b), "+v"(c), "+v"(d));
#undef HR4_STEP
}
#define MR_STEP(ctl) "v_add_f32_dpp %2, %2, %2 " ctl " row_mask:0xf bank_mask:0xf bound_ctrl:1\n\t" "v_add_f32_dpp %3, %3, %3 " ctl " row_mask:0xf bank_mask:0xf bound_ctrl:1\n\t" \
                     "v_add_f32_dpp %0, %0, %0 " ctl " row_mask:0xf bank_mask:0xf bound_ctrl:1\n\t" "v_add_f32_dpp %1, %1, %1 " ctl " row_mask:0xf bank_mask:0xf bound_ctrl:1\n\t"
__device__ __forceinline__ void merged_reduce16(float& a, float& b, float& c, float& d) {
    asm volatile(MR_STEP("quad_perm:[1,0,3,2]") MR_STEP("quad_perm:[2,3,0,1]") MR_STEP("row_half_mirror") MR_STEP("row_mirror") "" : "+v"(a), "+v"(b), "+v"(c), "+v"(d)); }
__device__ __forceinline__ void merged_reduce8(float& a, float& b, float& c, float& d) {
    asm volatile(MR_STEP("quad_perm:[1,0,3,2]") MR_STEP("quad_perm:[2,3,0,1]") MR_STEP("row_half_mirror") "" : "+v"(a), "+v"(b), "+v"(c), "+v"(d)); }
#undef MR_STEP
__device__ __forceinline__ float wave_sum_fast(float v) { v = dpp_add<0xB1>(v); v = dpp_add<0x4E>(v); v = dpp_add<0x141>(v); v = dpp_add<0x140>(v); v += __shfl_xor(v, 16); v += __shfl_xor(v, 32); return v; }
constexpr int TS = 32;
struct ScanRaw { u16 r[8], k[8], v[8], e[8], a[8]; };
template <int RR, int J>
__device__ __forceinline__ void scan_item(LAS unsigned char* lds, const u16* __restrict__ RKV, const u16* __restrict__ Ed, const u16* __restrict__ Ad, const float* __restrict__ kkw, const float* __restrict__ kaw,
                          const float* __restrict__ rkw, u16* OD, float* BON, int S, int seqbase, int head, int dir, int rowbase) {
    constexpr int NACT = 4;
    const int tid = ltid(), lane = tid & 63, w = tid >> 6;
    constexpr int L = 64 / J, NRG = 64 / L;
    const int rg = lane / L, jg = lane % L, j0 = jg * J, row0 = rowbase + w * (NRG * RR) + rg * RR;
    const float kkc = kkw[head * 64 + lane], kac = kaw[head * 64 + lane], rkc = rkw[head * 64 + lane];
    f32x2 st_[RR][J / 2];
#pragma unroll
    for (int r = 0; r < RR; ++r)
#pragma unroll
        for (int q = 0; q < J / 2; ++q) st_[r][q] = (f32x2){0.f, 0.f};
    const int nch = S / TS;
    ScanRaw raw;
    constexpr int NPT = 8;
    const bool prep = (w >= 4); const int pw = w - 4;
#define SCAN_LOAD(ch) do { if (prep) { _Pragma("unroll") for (int q = 0; q < NPT; ++q) { const int i = (ch) * TS + pw * NPT + q; const int t = dir ? (S - 1 - i) : i; const size_t tok = (size_t)(seqbase + t); \
        raw.r[q] = RKV[tok * 3072 + head * 64 + lane]; raw.k[q] = RKV[tok * 3072 + 1024 + head * 64 + lane]; raw.v[q] = RKV[tok * 3072 + 2048 + head * 64 + lane]; \
        raw.e[q] = Ed[tok * 1024 + head * 64 + lane]; raw.a[q] = Ad[tok * 1024 + head * 64 + lane]; } } } while (0)
#define SCAN_PREP(buf, ch) do { if (prep) { LAS float* B_ = (LAS float*)(lds + (buf) * 49152); _Pragma("unroll") for (int q = 0; q < NPT; ++q) { const int ls = pw * NPT + q; \
        const float r_ = bf2f(raw.r[q]), k_ = bf2f(raw.k[q]), v_ = bf2f(raw.v[q]), a_ = bf2f(raw.a[q]); const float e_ = (float)__builtin_bit_cast(_Float16, raw.e[q]); \
        const float kr_ = k_ * kkc; const float ss_ = wave_sum_fast(kr_ * kr_); const float kk_ = kr_ * rsqrtf(fmaxf(ss_, 1e-24f)); \
        B_[(0 * TS + ls) * 64 + lane] = __expf(-e_); B_[(1 * TS + ls) * 64 + lane] = -kk_; B_[(2 * TS + ls) * 64 + lane] = kk_ * a_; \
        const float kd_ = k_ * (1.0f + (a_ - 1.0f) * kac); const float bn_ = wave_sum_fast(r_ * kd_ * rkc); \
        { const int i_ = (ch) * TS + ls; const int t_ = dir ? (S - 1 - i_) : i_; if (lane == 0) BON[((size_t)dir * TC + seqbase + t_) * 16 + head] = bn_; } \
        B_[(3 * TS + ls) * 64 + lane] = kd_; B_[(4 * TS + ls) * 64 + lane] = r_; B_[(5 * TS + ls) * 64 + lane] = v_; } } } while (0)
    float os[RR], po[RR];
#pragma unroll
    for (int r = 0; r < RR; ++r) { os[r] = 0.f; po[r] = 0.f; }
    SCAN_LOAD(0);
    SCAN_PREP(0, 0);
    __syncthreads();
    for (int ch = 0; ch < nch; ++ch) {
        if (ch + 1 < nch) SCAN_LOAD(ch + 1);
        if (w < NACT) {
            const LAS float* B = (const LAS float*)(lds + (ch & 1) * 49152);
            f32x4 W[J / 4], A[J / 4], Bb[J / 4], K[J / 4], R[J / 4];
#pragma unroll
            for (int q = 0; q < J / 4; ++q) { W[q] = *(const LAS f32x4*)(B + (0 * TS) * 64 + j0 + 4 * q); A[q] = *(const LAS f32x4*)(B + (1 * TS) * 64 + j0 + 4 * q); Bb[q] = *(const LAS f32x4*)(B + (2 * TS) * 64 + j0 + 4 * q);
                K[q] = *(const LAS f32x4*)(B + (3 * TS) * 64 + j0 + 4 * q); R[q] = *(const LAS f32x4*)(B + (4 * TS) * 64 + j0 + 4 * q); }
            float V[RR];
#pragma unroll
            for (int r = 0; r < RR; ++r) V[r] = B[(5 * TS) * 64 + row0 + r];
#pragma unroll
            for (int ls = 0; ls < TS; ++ls) {
                f32x4 nW[J / 4], nA[J / 4], nB[J / 4], nK[J / 4], nR[J / 4]; float nV[RR];
#pragma unroll
                for (int q = 0; q < J / 4; ++q) { nW[q] = W[q]; nA[q] = A[q]; nB[q] = Bb[q]; nK[q] = K[q]; nR[q] = R[q]; }
#pragma unroll
                for (int r = 0; r < RR; ++r) nV[r] = V[r];
                if (ls + 1 < TS) {
#pragma unroll
                    for (int q = 0; q < J / 4; ++q) { nW[q] = *(const LAS f32x4*)(B + (0 * TS + ls + 1) * 64 + j0 + 4 * q); nA[q] = *(const LAS f32x4*)(B + (1 * TS + ls + 1) * 64 + j0 + 4 * q); nB[q] = *(const LAS f32x4*)(B + (2 * TS + ls + 1) * 64 + j0 + 4 * q);
                        nK[q] = *(const LAS f32x4*)(B + (3 * TS + ls + 1) * 64 + j0 + 4 * q); nR[q] = *(const LAS f32x4*)(B + (4 * TS + ls + 1) * 64 + j0 + 4 * q); }
                    if (RR == 1) nV[0] = B[(5 * TS + ls + 1) * 64 + row0];
                    else if (RR == 2) { const f32x2 t = *(const LAS f32x2*)(B + (5 * TS + ls + 1) * 64 + row0); nV[0] = t[0]; nV[RR - 1] = t[1]; }
                    else { const f32x4 t = *(const LAS f32x4*)(B + (5 * TS + ls + 1) * 64 + row0);
#pragma unroll
                        for (int r = 0; r < RR; ++r) nV[r] = t[r]; }
                }
                __builtin_amdgcn_sched_barrier(0);
                float sa[RR];
#pragma unroll
                for (int r = 0; r < RR; ++r) { f32x2 p = st_[r][0] * (f32x2){A[0][0], A[0][1]};
#pragma unroll
                    for (int q = 1; q < J / 2; ++q) p = st_[r][q] * (f32x2){A[q >> 1][(q & 1) * 2], A[q >> 1][(q & 1) * 2 + 1]} + p;
                    sa[r] = p[0] + p[1]; }
                static_assert(RR == 2, "merged reduction written for two rows per lane");
                if (J == 4) merged_reduce16(sa[0], sa[1], po[0], po[1]); else merged_reduce8(sa[0], sa[1], po[0], po[1]);
                {
                    const int pl = (ls + TS - 1) & (TS - 1);
                    const bool mine = (jg == (pl & (L - 1)));
                    os[0] = mine ? po[0] : os[0]; os[1] = mine ? po[1] : os[1];
                    if ((pl & (L - 1)) == L - 1 && (ls > 0 || ch > 0)) {
                        const int i = (ls > 0 ? ch : ch - 1) * TS + (pl - (L - 1)) + jg; const int t = dir ? (S - 1 - i) : i;
                        *(unsigned*)(OD + ((size_t)dir * TC + seqbase + t) * 1024 + head * 64 + row0) = cvt_pk_bf16(os[0], os[1]);
                    }
                }
#pragma unroll
                for (int r = 0; r < RR; ++r) { const f32x2 sv = {sa[r], sa[r]}, vv = {V[r], V[r]}; f32x2 u = {0.f, 0.f};
#pragma unroll
                    for (int q = 0; q < J / 2; ++q) { const int qq = q >> 1, e = (q & 1) * 2;
                        st_[r][q] = st_[r][q] * (f32x2){W[qq][e], W[qq][e + 1]} + (sv * (f32x2){Bb[qq][e], Bb[qq][e + 1]} + vv * (f32x2){K[qq][e], K[qq][e + 1]});
                        u = st_[r][q] * (f32x2){R[qq][e], R[qq][e + 1]} + u; }
                    po[r] = u[0] + u[1]; }
                __builtin_amdgcn_sched_barrier(0);
#pragma unroll
                for (int q = 0; q < J / 4; ++q) { W[q] = nW[q]; A[q] = nA[q]; Bb[q] = nB[q]; K[q] = nK[q]; R[q] = nR[q]; }
#pragma unroll
                for (int r = 0; r < RR; ++r) V[r] = nV[r];
            }
        }
        if (ch + 1 < nch) SCAN_PREP((ch + 1) & 1, ch + 1);
        __syncthreads();
    }
    if (w < NACT) {
        if (J == 4) row_reduce2(po[0], po[1]); else half_reduce2(po[0], po[1]);
        const bool mine = (jg == L - 1);
        os[0] = mine ? po[0] : os[0]; os[1] = mine ? po[1] : os[1];
        const int i = (nch - 1) * TS + (TS - L) + jg; const int t = dir ? (S - 1 - i) : i;
        *(unsigned*)(OD + ((size_t)dir * TC + seqbase + t) * 1024 + head * 64 + row0) = cvt_pk_bf16(os[0], os[1]);
    }
#undef SCAN_LOAD
#undef SCAN_PREP
}
__device__ __forceinline__ void scan_phase(LAS unsigned char* lds, const u16* RKV, const u16* EAG, const float* kkw, const float* kaw, const float* rkw, u16* OD, float* BON, int S) {
    for (int item = blockIdx.x; item < 256; item += gridDim.x) {
        if (S == 4096) { const int id = item >> 1, half = item & 1, seq = id >> 5, rem = id & 31, head = rem >> 1, dir = rem & 1;
            scan_item<2, 4>(lds, RKV, EAG + (size_t)dir * TC * 1024, EAG + (size_t)(2 + dir) * TC * 1024, kkw, kaw, rkw, OD, BON, S, seq * S, head, dir, half * 32);
        } else { const int seq = item >> 5, rem = item & 31, head = rem >> 1, dir = rem & 1;
            scan_item<2, 8>(lds, RKV, EAG + (size_t)dir * TC * 1024, EAG + (size_t)(2 + dir) * TC * 1024, kkw, kaw, rkw, OD, BON, S, seq * S, head, dir, 0);
        }
        __syncthreads();
    }
}
__device__ __forceinline__ float quad_sum(float v) { v = dpp_add<0xB1>(v); v = dpp_add<0x4E>(v); return v; }
__device__ __forceinline__ void rwkv_post_phase(const u16* __restrict__ OD, const float* __restrict__ BON, const u16* __restrict__ RKV, const u16* __restrict__ EAG,
                                const float* __restrict__ lnw, const float* __restrict__ lnb, u16* Y) {
    const int lane = ltid() & 63, gw = blockIdx.x * 8 + (ltid() >> 6), nw = gridDim.x * 8, c0 = lane * 16;
    float lw[16], lb[16];
#pragma unroll
    for (int i = 0; i < 4; ++i) { const f32x4 c = *(const f32x4*)(lnw + c0 + 4 * i), d = *(const f32x4*)(lnb + c0 + 4 * i);
#pragma unroll
        for (int e = 0; e < 4; ++e) { lw[4 * i + e] = c[e]; lb[4 * i + e] = d[e]; } }
    for (int t = gw; t < TC; t += nw) {
        u32x4 oa[2], ob[2], vv[2], gg[2];
#pragma unroll
        for (int i = 0; i < 2; ++i) { oa[i] = *(const u32x4*)(OD + (size_t)t * 1024 + c0 + 8 * i); ob[i] = *(const u32x4*)(OD + ((size_t)TC + t) * 1024 + c0 + 8 * i);
            vv[i] = *(const u32x4*)(RKV + (size_t)t * 3072 + 2048 + c0 + 8 * i); gg[i] = *(const u32x4*)(EAG + ((size_t)4 * TC + t) * 1024 + c0 + 8 * i); }
        const float bsum = BON[(size_t)t * 16 + (lane >> 2)] + BON[((size_t)TC + t) * 16 + (lane >> 2)];
        float y[16];
#pragma unroll
        for (int i = 0; i < 16; ++i) { const int w_ = (i & 7) >> 1; const bool hi = i & 1; y[i] = (hi ? bfhi(oa[i >> 3][w_]) : bflo(oa[i >> 3][w_])) + (hi ? bfhi(ob[i >> 3][w_]) : bflo(ob[i >> 3][w_])); }
        float sm = 0.f;
#pragma unroll
        for (int i = 0; i < 16; ++i) sm += y[i];
        const float mean = quad_sum(sm) * (1.0f / 64.0f);
        float sv = 0.f;
#pragma unroll
        for (int i = 0; i < 16; ++i) { y[i] -= mean; sv += y[i] * y[i]; }
        const float rstd = rsqrtf(quad_sum(sv) * (1.0f / 64.0f) + 64e-5f);
        float o[16];
#pragma unroll
        for (int i = 0; i < 16; ++i) { const int w_ = (i & 7) >> 1; const bool hi = i & 1;
            const float v = hi ? bfhi(vv[i >> 3][w_]) : bflo(vv[i >> 3][w_]), g = hi ? bfhi(gg[i >> 3][w_]) : bflo(gg[i >> 3][w_]);
            o[i] = (y[i] * rstd * lw[i] + lb[i] + bsum * v) * g; }
#pragma unroll
        for (int i = 0; i < 2; ++i) { u32x4 w; w.x = cvt_pk_bf16(o[8 * i], o[8 * i + 1]); w.y = cvt_pk_bf16(o[8 * i + 2], o[8 * i + 3]); w.z = cvt_pk_bf16(o[8 * i + 4], o[8 * i + 5]); w.w = cvt_pk_bf16(o[8 * i + 6], o[8 * i + 7]);
            *(u32x4*)(Y + (size_t)t * 1024 + c0 + 8 * i) = w; }
    }
}
__device__ __forceinline__ void build_w2comb(u16* W2, const float* __restrict__ w2, const float* __restrict__ a2, const float* __restrict__ g2) {
    const size_t total = (size_t)384 * 5120, stride = (size_t)gridDim.x * NTHREADS;
    for (size_t idx = (size_t)blockIdx.x * NTHREADS + ltid(); idx < total; idx += stride) {
        const int k = (int)(idx / 5120), n = (int)(idx % 5120), sel = n >> 10, nn = n & 1023; float v = 0.f;
        if (sel == 0 && k < 64) v = w2[(size_t)k * 1024 + nn];
        else if (sel == 1 && k >= 64 && k < 128) v = w2[(size_t)(64 + (k - 64)) * 1024 + nn];
        else if (sel == 2 && k >= 128 && k < 192) v = a2[(size_t)(k - 128) * 1024 + nn];
        else if (sel == 3 && k >= 192 && k < 256) v = a2[(size_t)(64 + (k - 192)) * 1024 + nn];
        else if (sel == 4 && k >= 256 && k < 384) v = g2[(size_t)(k - 256) * 1024 + nn];
        W2[(size_t)n * 384 + k] = f2bf(v);
    }
}

namespace pg8 {
struct EpiAny {
    static constexpr bool PERM = true, AFTER_DRAIN = false;
    int mode; u16* o16; u16* o16b; u16* x; const float* b0; const float* b1; int ldc; int M; unsigned long long* ssw; const unsigned long long* ssr; const float* xin;
    __device__ __forceinline__ void operator()(const f32x4 (&acc)[2][2][4][2], const Unit& u, int wr, int wc, int fr, int fq) const {
        if (mode == 0) EpiStore16{o16, ldc, ssr}(acc, u, wr, wc, fr, fq);
        else if (mode == 1) EpiResid{x, xin, ssw}(acc, u, wr, wc, fr, fq);
        else if (mode == 2) EpiSwiglu{o16, ssr}(acc, u, wr, wc, fr, fq);
        else if (mode == 3) EpiRwkv{o16}(acc, u, wr, wc, fr, fq);
        else EpiLora2{o16, b0, b1, M}(acc, u, wr, wc, fr, fq);
    }
};
}

__global__ void __launch_bounds__(NTHREADS, 2) mega(Params p) {
    extern __shared__ __attribute__((aligned(16))) unsigned char lds_raw[];
    LAS unsigned char* lds = (LAS unsigned char*)lds_raw;
    ltid_setup();
    cg::grid_group grid = cg::this_grid();
    unsigned char* const ws = p.ws;
    u16* const Xb = (u16*)(ws + WS_ARENA + AR_A);
    unsigned char* const RA = (unsigned char*)p.out;
    const size_t gstride = (size_t)gridDim.x * NTHREADS;

    {
        float* const ROPE = (float*)(ws + WS_ROPE);
        for (size_t i = (size_t)blockIdx.x * NTHREADS + ltid(); i < 4096 * 8; i += gstride) { const int pos = (int)(i >> 3), fi = (int)(i & 7);
            const float inv = powf(500000.0f, -2.0f * (float)fi / 16.0f); const float ang = (float)pos * inv;
            ROPE[i * 2] = (float)cos((double)ang); ROPE[i * 2 + 1] = (float)sin((double)ang); }
    }
    if (blockIdx.x == 0) for (int i = ltid(); i < XCD_BAR_WORDS; i += NTHREADS) ((unsigned*)(ws + WS_BAR))[i] = 0u;
    __syncthreads();
    grid.sync();
    volatile LAS unsigned* xst = (volatile LAS unsigned*)(lds + LDS_BYTES - 16);
    if (ltid() == 0) { xst[0] = 0u; xst[1] = 0u; }
    __syncthreads();
    XcdBarrier xbar = xcd_barrier_post((unsigned*)(ws + WS_BAR), xst);
#ifndef DUP_MISC
#define DUP_MISC 1
#endif
#ifndef DUP_SYNC
#define DUP_SYNC 1
#endif
#ifndef DUP_STEP
#define DUP_STEP -1
#define DUP_PAR -1
#endif
#ifndef DUP_SCAN
#define DUP_SCAN 1
#endif
    for (int ph = 0; ph < 4 * NCHUNK * 15; ++ph) {
        const int l = ph / (NCHUNK * 15), c = (ph / 15) % NCHUNK, s = ph % 15;
        const int e = l >> 1; const bool odd = (l & 1) != 0;
        if (s < 3 && c != 0) continue;
        if (s == 6 && !odd) continue;
        if (s == 8 || s == 12 || s == 10) continue;
        const int S = c < 2 ? 4096 : 2048;
        u16* const Xc = Xb + (size_t)c * TC * 1024;
        const float* const Xin0 = c < 2 ? p.in[0] + (size_t)c * TC * 1024 : p.in[1];
        unsigned char* const AR = ws + WS_ARENA;
        u16* const XN = (u16*)RA; u16* const BUFB = (u16*)(AR + AR_B); u16* const BUFC = (u16*)(AR + AR_C); u16* const Y = (u16*)(AR + AR_D);
        bool do_gemm = false; const u16* gA = nullptr; const u16* gB = nullptr; int gM = TC, gN = 1024, gK = 1024; size_t g_grp = 0; int g_shift = 0, ngemm = 1;
        pg8::EpiAny E{0, nullptr, nullptr, nullptr, nullptr, nullptr, 0, TC, nullptr, nullptr, nullptr};
        unsigned long long* const SSC = (unsigned long long*)(ws + WS_SS); unsigned long long* const SSF = SSC + TC;
        for (int dup = 0; dup < ((s == 5 && odd) ? DUP_SCAN : ((s == DUP_STEP && (DUP_PAR < 0 || (int)odd == DUP_PAR)) ? 2 : DUP_MISC)); ++dup) {
        if (s == 0) {
            const float* mu = p.in[12] + (size_t)e * 6 * 1024;
            u16* const WMIX = (u16*)(ws + WS_WMIX);
            for (int j = 0; j < 22; ++j) {
                const float* src = nullptr; int ld_src = 1024, K = 1024, N = 1024, ld_dst = 1024, col0 = 0, mode = 0; u16* dst = nullptr; const float* s1 = nullptr;
                if (j < 17) {
                    if (!odd) {
                        if (j == 0) { src = p.in[9] + (size_t)e * 1024 * 3072; ld_src = 3072; N = 3072; dst = WMIX; }
                        else if (j == 1) { src = p.in[10] + (size_t)e * 1024 * 1024; dst = WMIX + (size_t)3072 * 1024; }
                        else continue;
                    } else {
                        const int half = j & 1, q = j >> 1;
                        u16* const WL1 = WMIX + (size_t)3072 * 1024;
                        if (q < 3) { if (half) continue; src = p.in[13 + q] + (size_t)e * 1024 * 1024; dst = WMIX + (size_t)q * 1024 * 1024; }
                        else if (q < 5) { const int d = q - 3; src = p.in[18] + ((size_t)e * 2 + d) * 1024 * 64; ld_src = 64; N = 64; dst = WL1 + (size_t)(d * 64) * 2048; ld_dst = 2048; col0 = half * 1024; if (half) s1 = mu + 1 * 1024; }
                        else if (q < 7) { const int d = q - 5; src = p.in[21] + ((size_t)e * 2 + d) * 1024 * 64; ld_src = 64; N = 64; dst = WL1 + (size_t)(128 + d * 64) * 2048; ld_dst = 2048; col0 = half * 1024; if (half) s1 = mu + 4 * 1024; }
                        else if (q == 7) { src = p.in[23] + (size_t)e * 1024 * 128; ld_src = 128; N = 128; dst = WL1 + (size_t)256 * 2048; ld_dst = 2048; col0 = half * 1024; if (half) s1 = mu + 5 * 1024; }
                        else { if (half) continue; src = p.in[16] + (size_t)e * 1024 * 1024; dst = (u16*)(ws + WS_WMIX + WMIX_C); }
                    }
                } else if (j == 17) { src = p.in[30] + (size_t)l * 1024 * 1024; dst = (u16*)(ws + WS_WQ); s1 = p.in[5] + l * 1024; }
                else if (j == 18) { src = p.in[31] + (size_t)l * 1024 * 2048; ld_src = 2048; N = 2048; dst = (u16*)(ws + WS_WKV); }
                else if (j == 19) { src = p.in[32] + (size_t)l * 1024 * 1024; dst = (u16*)(ws + WS_WO); }
                else if (j == 20) { src = p.in[33] + (size_t)l * 1024 * 5632; ld_src = 5632; N = 5632; dst = (u16*)(ws + WS_WGU); mode = 1; s1 = p.in[7] + l * 1024; }
                else { src = p.in[34] + (size_t)l * 2816 * 1024; K = 2816; dst = (u16*)(ws + WS_WDN); ld_dst = 2816; }
                tr_job(lds, src, ld_src, K, N, dst, ld_dst, col0, s1, mode, j * 37);
            }
            if (odd) {
                for (size_t i = (size_t)blockIdx.x * NTHREADS + ltid(); i < (size_t)128 * 2048 / 8; i += gstride) ((u32x4*)(WMIX + (size_t)3072 * 1024 + (size_t)384 * 2048))[i] = (u32x4){0u, 0u, 0u, 0u};
                build_w2comb((u16*)(ws + WS_WMIX + WMIX_B), p.in[19] + (size_t)e * 2 * 64 * 1024, p.in[22] + (size_t)e * 2 * 64 * 1024, p.in[24] + (size_t)e * 128 * 1024);
            }
        }
        if (s == 0) {
            for (int rep = 0; rep < 2; ++rep) norm_rows(p.in[2 + rep], nullptr, p.in[6] + l * 1024, (u16*)(ws + WS_MN) + (size_t)rep * 2048 * 1024, 1024, 2048);
        }
        else if (s == 1) { do_gemm = true; gA = (u16*)(ws + WS_MN); gB = (u16*)(ws + WS_WKV); gM = 4096; gN = 2048; E.o16 = (u16*)(ws + WS_KV); E.ldc = 2048; }
        else if (s == 3) { do_gemm = true; gB = (u16*)(ws + WS_WMIX);
            if (!odd) { gA = XN; gN = 3072; E.o16 = BUFB; E.ldc = 3072; }
            else { gA = BUFC; gN = 3072; E.o16 = BUFB; E.ldc = 3072; g_grp = (size_t)TC * 1024 * 2; g_shift = 2; ngemm = 2; } }
        else if (s == 4) {
            if (!odd) dil_attn_phase(lds, BUFB, BUFC, (float*)(AR + AR_C + (size_t)3 * TC * 512 * 2), (const float*)(ws + WS_ROPE), S);
            else { do_gemm = true; gA = (u16*)(RA + (size_t)TC * 4096); gB = (u16*)(ws + WS_WMIX + WMIX_B); gN = 5120; gK = 384; E.mode = 4; E.o16 = BUFC; E.b0 = p.in[17] + (size_t)e * 2048; E.b1 = p.in[20] + (size_t)e * 2048; }
        }
        else if (s == 5) {
            if (!odd) merge_conv_phase(BUFB, BUFC, (const float*)(AR + AR_C + (size_t)3 * TC * 512 * 2), p.in[11] + (size_t)e * 3 * 512, Y, S);
            else scan_phase(lds, BUFB, BUFC, p.in[25] + (size_t)e * 1024, p.in[26] + (size_t)e * 1024, p.in[27] + (size_t)e * 1024, (u16*)RA, (float*)(RA + (size_t)TC * 4096), S);
        }
        else if (s == 6) rwkv_post_phase((const u16*)RA, (const float*)(RA + (size_t)TC * 4096), BUFB, BUFC, p.in[28] + (size_t)e * 1024, p.in[29] + (size_t)e * 1024, Y);
        else if (s == 7) { do_gemm = true; gA = Y; gB = odd ? (u16*)(ws + WS_WMIX + WMIX_C) : (u16*)(ws + WS_WMIX) + (size_t)3072 * 1024; E.mode = 1; E.x = Xc; E.xin = (l == 0) ? Xin0 : nullptr; E.ssw = SSC; }
        else if (s == 9) { do_gemm = true; gA = Xc; gB = (u16*)(ws + WS_WQ); E.o16 = BUFB; E.ldc = 1024; E.ssr = SSC; }
        else if (s == 11) { do_gemm = true; gA = BUFC; gB = (u16*)(ws + WS_WO); E.mode = 1; E.x = Xc; E.xin = nullptr; E.ssw = SSF; }
        else if (s == 13) { do_gemm = true; gA = Xc; gB = (u16*)(ws + WS_WGU); gN = 5632; E.mode = 2; E.o16 = BUFB; E.ssr = SSF; }
        else if (s == 14) { do_gemm = true; gA = BUFB; gB = (u16*)(ws + WS_WDN); gK = 2816; E.mode = 1; E.x = Xc; E.xin = nullptr; }
        }
        if (do_gemm) {
            for (int gi = 0; gi < ngemm; ++gi) {
                if (gi == 1) { gA = XN; gB = (u16*)(ws + WS_WMIX) + (size_t)3072 * 1024; gN = 512; gK = 2048; g_grp = 0; g_shift = 0; E.mode = 3; E.o16 = (u16*)(RA + (size_t)TC * 4096); }
                pg8::Gemm g{gA, gB, gM, gN, gK, g_grp, g_shift}; pg8::StaticOrder SO; SO.init(gM, gN, (int)gridDim.x, (int)blockIdx.x);
                pg8::gemm_phase<pg8::EpiAny, pg8::StaticOrder, false>(lds, g, SO, E, nullptr);
            }
        }
        if (s == 9) {
            pg8::StaticOrder SO2; SO2.init(TC, 1024, (int)gridDim.x, (int)blockIdx.x); pg8::Unit u;
            for (int i = 0; SO2.next(i, u); ++i) { const int t0 = u.pm * 256, seq = t0 / S, qt = (t0 % S) >> 7;
                cross_attn_pair(lds, BUFB, (const u16*)(ws + WS_KV), c < 2 ? c * 1024 : 2048, BUFC, S, seq, u.pn, qt); }
        }
        {
            const int nc = (s == 2 && c == 0) ? 0 : ((s == 14 && c < 2) ? c + 1 : -1);
            if (nc >= 0) {
                const int Sn = nc < 2 ? 4096 : 2048;
                const float* xs = (nc < 2 ? p.in[0] + (size_t)nc * TC * 1024 : p.in[1]);
                const u16* xh = (l == 0) ? nullptr : Xb + (size_t)nc * TC * 1024;
                for (size_t i = (size_t)blockIdx.x * NTHREADS + ltid(); i < (size_t)2 * TC; i += gstride) SSC[i] = 0ull;
                if (odd) norm_shift(xs, xh, p.in[4] + l * 1024, p.in[12] + (size_t)e * 6 * 1024, XN, BUFC, Sn);
                else norm_rows(xs, xh, p.in[4] + l * 1024, XN, 1024, TC);
            }
        }
        if (s == 1) continue;
        for (int dup = 0; dup < DUP_SYNC; ++dup) xcd_barrier(xbar);
    }
    norm_final(Xb, p.out, p.in[8], 49152);
}

extern "C" void kernel_launch(void* const* d_in, const int* in_sizes, int n_in, void* d_out, int out_size, void* d_ws, size_t ws_size, hipStream_t stream) {
    static int grid_blocks = 0;
    if (!grid_blocks) {
        int dev = 0, cus = 0, per_cu = 0;
        if (n_in != 35 || out_size != 49152 * 1024 || ws_size < WS_END) { fprintf(stderr, "kernel_launch: unexpected problem (n_in %d out %d ws %zu need %zu)\n", n_in, out_size, ws_size, (size_t)WS_END); grid_blocks = -1; return; }
        (void)hipGetDevice(&dev);
        (void)hipDeviceGetAttribute(&cus, hipDeviceAttributeMultiprocessorCount, dev);
        (void)hipFuncSetAttribute((const void*)mega, hipFuncAttributeMaxDynamicSharedMemorySize, LDS_BYTES);
        (void)hipOccupancyMaxActiveBlocksPerMultiprocessor(&per_cu, (const void*)mega, NTHREADS, LDS_BYTES);
        if (per_cu < 1) { fprintf(stderr, "kernel_launch: occupancy query says %d blocks per CU\n", per_cu); }
        grid_blocks = cus > 0 ? cus : 256;
    }
    if (grid_blocks < 0) return;
    Params p{};
    for (int i = 0; i < 35; ++i) p.in[i] = (const float*)d_in[i];
    p.out = (float*)d_out; p.ws = (unsigned char*)d_ws;
    void* args[] = {&p};
    hipError_t err = hipLaunchCooperativeKernel((void*)mega, dim3(grid_blocks), dim3(NTHREADS), args, LDS_BYTES, stream);
    if (err != hipSuccess) fprintf(stderr, "cooperative launch failed: %s (grid %d)\n", hipGetErrorString(err), grid_blocks);
}
```

```cpp
#include <hip/hip_runtime.h>
#include <hip/hip_cooperative_groups.h>
#include <cstdio>
namespace cg = cooperative_groups;

#define LAS __attribute__((address_space(3)))
typedef unsigned short u16;
typedef short bf16x8 __attribute__((ext_vector_type(8)));
typedef float f32x4 __attribute__((ext_vector_type(4)));
typedef float f32x2 __attribute__((ext_vector_type(2)));
typedef unsigned u32x4 __attribute__((ext_vector_type(4)));
typedef unsigned u32x2 __attribute__((ext_vector_type(2)));

constexpr int DM = 1024;
constexpr int TC = 16384;
constexpr int NCHUNK = 3;
constexpr int NTHREADS = 512;
constexpr int LDS_BYTES = 139264;

__device__ __forceinline__ unsigned cvt_pk_bf16(float lo, float hi) { unsigned r; asm volatile("v_cvt_pk_bf16_f32 %0, %1, %2" : "=v"(r) : "v"(lo), "v"(hi)); return r; }
__device__ __forceinline__ u16 f2bf(float x) { return (u16)(cvt_pk_bf16(x, 0.f) & 0xffffu); }
__device__ __forceinline__ float bf2f(u16 b) { return __uint_as_float(((unsigned)b) << 16); }
__device__ __forceinline__ float bflo(unsigned w) { return __uint_as_float(w << 16); }
__device__ __forceinline__ float bfhi(unsigned w) { return __uint_as_float(w & 0xffff0000u); }
__device__ __forceinline__ float sigmoidf_(float x) { return 1.0f / (1.0f + __expf(-x)); }
__device__ __forceinline__ float wave_sum(float v) {
#pragma unroll
    for (int o = 32; o >= 1; o >>= 1) v += __shfl_xor(v, o);
    return v;
}
constexpr int WVMAP_OFF = LDS_BYTES - 16 - 256;
__device__ __forceinline__ unsigned hw_slot() { return (unsigned)__builtin_amdgcn_s_getreg((5 << 11) | 4) & 63u; }
__device__ __forceinline__ int ltid() {
    extern __shared__ __attribute__((aligned(16))) unsigned char lds_dyn_[];
    const int wv = __builtin_amdgcn_readfirstlane(*(const volatile LAS int*)((LAS unsigned char*)lds_dyn_ + WVMAP_OFF + hw_slot() * 4));
    int lane; asm volatile("v_mbcnt_lo_u32_b32 %0, -1, 0\n\tv_mbcnt_hi_u32_b32 %0, -1, %0" : "=v"(lane));
    return (wv << 6) | lane;
}
__device__ __forceinline__ void ltid_setup() {
    extern __shared__ __attribute__((aligned(16))) unsigned char lds_dyn_[];
    if ((threadIdx.x & 63) == 0) *(volatile LAS int*)((LAS unsigned char*)lds_dyn_ + WVMAP_OFF + hw_slot() * 4) = (int)(threadIdx.x >> 6);
    __syncthreads();
}
#define XB_TMO      128
#define XB_XCNT(j)  (256  + 64 * (j))
#define XB_XSUB(j)  (1280 + 64 * (j))
#define XB_XGEN(j)  (2304 + 64 * (j))
#define XB_TOP      3328
#define XB_TOPGEN   3392
#define XCD_BAR_WORDS 3456
#define XB_SPIN_CAP (1u << 18)

__device__ __forceinline__ unsigned xb_ld(unsigned* p)              { return __hip_atomic_load(p, __ATOMIC_RELAXED, __HIP_MEMORY_SCOPE_AGENT); }
__device__ __forceinline__ unsigned xb_add(unsigned* p, unsigned v) { return __hip_atomic_fetch_add(p, v, __ATOMIC_RELAXED, __HIP_MEMORY_SCOPE_AGENT); }
__device__ __forceinline__ unsigned xb_xcc_id() { return (unsigned)__builtin_amdgcn_s_getreg((3 << 11) | 20) & 0xFu; }
#define XB_SPIN(cond, bar) do { unsigned _sp = 0; while (cond) { __builtin_amdgcn_s_sleep(1); \
    if ((++_sp & 255u) == 0u) { if (xb_ld(&(bar)[XB_TMO])) break; if (_sp > XB_SPIN_CAP) { atomicAdd(&(bar)[XB_TMO], 1u); break; } } } } while (0)

struct XcdBarrier {
    unsigned* bar; unsigned x;
    volatile LAS unsigned* st;
};

__device__ __forceinline__ XcdBarrier xcd_barrier_post(unsigned* bar, volatile LAS unsigned* st) {
    XcdBarrier b; b.bar = bar; b.x = xb_xcc_id(); b.st = st;
    if (ltid() == 0) (void)xb_add(&bar[XB_XCNT(b.x)], 1u);
    return b;
}
__device__ __forceinline__ void xcd_barrier_complete(unsigned* bar, unsigned x, unsigned& nloc, unsigned& nx) {
    const unsigned G = gridDim.x * gridDim.y * gridDim.z;
    unsigned sum, cnt, mine, sp = 0u;
    for (;;) {
        sum = 0u; cnt = 0u; mine = 0u;
#pragma unroll
        for (unsigned j = 0; j < 16; ++j) { const unsigned c = xb_ld(&bar[XB_XCNT(j)]); sum += c; cnt += (c > 0u) ? 1u : 0u; mine = (j == x) ? c : mine; }
        if (sum == G) break;
        __builtin_amdgcn_s_sleep(1);
        if ((++sp & 255u) == 0u) { if (xb_ld(&bar[XB_TMO])) break; if (sp > XB_SPIN_CAP) { atomicAdd(&bar[XB_TMO], 1u); break; } }
    }
    nloc = mine > 0u ? mine : 1u; nx = cnt > 0u ? cnt : 1u;
}

__device__ __forceinline__ void xcd_barrier(const XcdBarrier& b) {
    asm volatile("s_waitcnt vmcnt(0)" ::: "memory");
    __syncthreads();
    if (ltid() == 0) {
        unsigned* bar = b.bar;
        __builtin_amdgcn_s_waitcnt(0);
        unsigned nloc = b.st[0], nx = b.st[1];
        if (nloc == 0u) { xcd_barrier_complete(bar, b.x, nloc, nx); b.st[0] = nloc; b.st[1] = nx; }
        const unsigned old = xb_add(&bar[XB_XSUB(b.x)], 1u);
        const unsigned gen = old / nloc;
        if (old + 1u == (gen + 1u) * nloc) {
            __builtin_amdgcn_fence(__ATOMIC_RELEASE, "agent");
            asm volatile("s_waitcnt vmcnt(0)" ::: "memory");
            const unsigned og = xb_add(&bar[XB_TOP], 1u);
            const unsigned tg = og / nx;
            if (og + 1u == (tg + 1u) * nx) xb_add(&bar[XB_TOPGEN], 1u);
            else XB_SPIN(xb_ld(&bar[XB_TOPGEN]) == tg, bar);
            __builtin_amdgcn_fence(__ATOMIC_ACQUIRE, "agent");
            xb_add(&bar[XB_XGEN(b.x)], 1u);
            asm volatile("s_waitcnt vmcnt(0)" ::: "memory");
        } else {
            XB_SPIN(xb_ld(&bar[XB_XGEN(b.x)]) == gen, bar);
            __builtin_amdgcn_fence(__ATOMIC_ACQUIRE, "agent");
            asm volatile("s_waitcnt vmcnt(0)" ::: "memory");
        }
    }
    __syncthreads();
}
namespace pg8 {
#define PG8_LAS __attribute__((address_space(3)))
typedef unsigned short bf16_t;
typedef short bf16x8 __attribute__((ext_vector_type(8)));
typedef float f32x4 __attribute__((ext_vector_type(4)));
typedef unsigned u32x4 __attribute__((ext_vector_type(4)));
constexpr int BM = 256, BK = 64, HALF = 128, HTB = HALF * BK * 2  , STAGE_BYTES = 8 * HTB, NXCD = 8, WGM = 8;

__host__ __device__ __forceinline__ int lds_byte(int r, int c) { const int st = (r >> 4) * 2 + (c >> 5), rr = r & 15, cc = c & 31, ob = rr * 64 + cc * 2; return st * 1024 + (ob ^ (((ob >> 9) & 1) << 5)); }
__host__ __device__ __forceinline__ void stage_rc(int b, int& R, int& C) { const int st = b / 1024, sb = b % 1024, swz = sb ^ (((sb >> 9) & 1) << 5); R = (st >> 1) * 16 + swz / 64; C = (st & 1) * 32 + (swz % 64) / 2; }
__host__ __device__ __forceinline__ int perm32(int rho) { const int n = rho >> 4, i = rho & 15; return 8 * (i >> 2) + 4 * n + (i & 3); }

struct Unit { int pm, pn; };
struct Gemm { const bf16_t* A; const bf16_t* Bt; int M, N, K; size_t a_grp_bytes; int a_grp_shift; };

struct StaticOrder {
    int nM, nN, nwg, G, c;
    __host__ __device__ __forceinline__ void init(int M, int N, int G_, int c_) { nM = M / BM; nN = N / BM; nwg = nM * nN; G = G_; c = c_; }
    __host__ __device__ __forceinline__ bool next(int i, Unit& u) const {
        const long L = (long)i * G + c; if (L >= nwg) return false;
        int wgid = (int)L; { const int q = nwg / NXCD, r = nwg % NXCD, xcd = wgid % NXCD, off = wgid / NXCD; wgid = (xcd < r ? xcd * (q + 1) : r * (q + 1) + (xcd - r) * q) + off; }
        const int nig = WGM * nN, gid = wgid / nig, fm = gid * WGM, gsz = (nM - fm) < WGM ? (nM - fm) : WGM;
        u.pm = fm + ((wgid % nig) % gsz); u.pn = (wgid % nig) / gsz; return true;
    }
    __device__ __forceinline__ void a_ready(const Unit&) const {}
    __device__ __forceinline__ void done(const Unit&) const {}
};
struct EpiStore16 {
    static constexpr bool PERM = true, AFTER_DRAIN = false;
    u16* O; int ldc; const unsigned long long* SS;
    __device__ __forceinline__ void operator()(const f32x4 (&acc)[2][2][4][2], const Unit& u, int wr, int wc, int fr, int fq) const {
        const int row0 = u.pm * BM + wr * 64 + fr, col0 = u.pn * BM + wc * 32 + 8 * fq;
#pragma unroll
        for (int ai = 0; ai < 2; ++ai)
#pragma unroll
            for (int m = 0; m < 4; ++m) { const int row = row0 + ai * HALF + m * 16; u16* rowp = O + (size_t)row * ldc + col0;
                const float rs = SS ? rsqrtf((float)SS[row] * (1.0f / (1024.0f * 1048576.0f)) + 1e-6f) : 1.0f;
#pragma unroll
                for (int bj = 0; bj < 2; ++bj) { const f32x4 v0 = acc[ai][bj][m][0] * rs, v1 = acc[ai][bj][m][1] * rs; u32x4 w; w.x = cvt_pk_bf16(v0[0], v0[1]); w.y = cvt_pk_bf16(v0[2], v0[3]); w.z = cvt_pk_bf16(v1[0], v1[1]); w.w = cvt_pk_bf16(v1[2], v1[3]);
                    *(u32x4*)(rowp + bj * HALF) = w; } }
    }
};
struct EpiResid {
    static constexpr bool PERM = true, AFTER_DRAIN = false;
    u16* Xb; const float* Xin32; unsigned long long* SS;
    __device__ __forceinline__ void operator()(const f32x4 (&acc)[2][2][4][2], const Unit& u, int wr, int wc, int fr, int fq) const {
        const int row0 = u.pm * BM + wr * 64 + fr, col0 = u.pn * BM + wc * 32 + 8 * fq;
#pragma unroll
        for (int ai = 0; ai < 2; ++ai)
#pragma unroll
            for (int m = 0; m < 4; ++m) { const int row = row0 + ai * HALF + m * 16; const unsigned off = (unsigned)(row * 1024 + col0); float ss = 0.f;
#pragma unroll
                for (int bj = 0; bj < 2; ++bj) { const unsigned o = off + bj * HALF; f32x4 x0, x1;
                    if (Xin32) { x0 = *(const f32x4*)(Xin32 + o); x1 = *(const f32x4*)(Xin32 + o + 4); }
                    else { const u32x4 h = *(const u32x4*)(Xb + o); x0 = (f32x4){bflo(h.x), bfhi(h.x), bflo(h.y), bfhi(h.y)}; x1 = (f32x4){bflo(h.z), bfhi(h.z), bflo(h.w), bfhi(h.w)}; }
                    const f32x4 v0 = x0 + acc[ai][bj][m][0], v1 = x1 + acc[ai][bj][m][1];
                    u32x4 w; w.x = cvt_pk_bf16(v0[0], v0[1]); w.y = cvt_pk_bf16(v0[2], v0[3]); w.z = cvt_pk_bf16(v1[0], v1[1]); w.w = cvt_pk_bf16(v1[2], v1[3]);
                    *(u32x4*)(Xb + o) = w;
                    if (SS) ss += (v0[0] * v0[0] + v0[1] * v0[1]) + (v0[2] * v0[2] + v0[3] * v0[3]) + (v1[0] * v1[0] + v1[1] * v1[1]) + (v1[2] * v1[2] + v1[3] * v1[3]); }
                if (SS) { ss += __shfl_xor(ss, 16); ss += __shfl_xor(ss, 32); if (fq == 0) atomicAdd(SS + row, (unsigned long long)(ss * 1048576.0f)); } }
    }
};
struct EpiSwiglu {
    static constexpr bool PERM = true, AFTER_DRAIN = false;
    u16* H; const unsigned long long* SS;
    __device__ __forceinline__ void operator()(const f32x4 (&acc)[2][2][4][2], const Unit& u, int wr, int wc, int fr, int fq) const {
        const int row0 = u.pm * BM + wr * 64 + fr, col0 = u.pn * 128 + wc * 16 + 4 * fq;
#pragma unroll
        for (int ai = 0; ai < 2; ++ai)
#pragma unroll
            for (int m = 0; m < 4; ++m) { const int row = row0 + ai * HALF + m * 16; u16* rowp = H + (size_t)row * 2816 + col0;
                const float rs = rsqrtf((float)SS[row] * (1.0f / (1024.0f * 1048576.0f)) + 1e-6f);
#pragma unroll
                for (int bj = 0; bj < 2; ++bj) { const f32x4 g = acc[ai][bj][m][0] * rs, up = acc[ai][bj][m][1] * rs; float h[4];
#pragma unroll
                    for (int j = 0; j < 4; ++j) h[j] = g[j] / (1.0f + __expf(-g[j])) * up[j];
                    u32x2 w; w.x = cvt_pk_bf16(h[0], h[1]); w.y = cvt_pk_bf16(h[2], h[3]); *(u32x2*)(rowp + bj * 64) = w; } }
    }
};
struct EpiRwkv {
    static constexpr bool PERM = true, AFTER_DRAIN = false;
    u16* L1;
    __device__ __forceinline__ void operator()(const f32x4 (&acc)[2][2][4][2], const Unit& u, int wr, int wc, int fr, int fq) const {
        const int row0 = u.pm * BM + wr * 64 + fr;
        const int col0 = u.pn * BM + wc * 32 + 8 * fq; const int t = u.pn;
#pragma unroll
        for (int ai = 0; ai < 2; ++ai)
#pragma unroll
            for (int m = 0; m < 4; ++m) { u16* rowp = L1 + (size_t)(row0 + ai * HALF + m * 16) * 384 + col0;
#pragma unroll
                for (int bj = 0; bj < 2; ++bj) if (!(t == 1 && bj == 1)) {
#pragma unroll
                    for (int n = 0; n < 2; ++n) { f32x4 v = acc[ai][bj][m][n];
#pragma unroll
                        for (int j = 0; j < 4; ++j) { float x = v[j]; if (t == 1) x = sigmoidf_(x); else if (bj == 0) x = tanhf(x); v[j] = x; }
                        u32x2 w; w.x = cvt_pk_bf16(v[0], v[1]); w.y = cvt_pk_bf16(v[2], v[3]); *(u32x2*)(rowp + bj * HALF + n * 4) = w; } } }
    }
};
struct EpiLora2 {
    static constexpr bool PERM = true, AFTER_DRAIN = false;
    u16* EAG; const float* w0; const float* a0; int M;
    __device__ __forceinline__ void operator()(const f32x4 (&acc)[2][2][4][2], const Unit& u, int wr, int wc, int fr, int fq) const {
        const int row0 = u.pm * BM + wr * 64 + fr; const int sel = u.pn >> 2; const int col0 = (u.pn & 3) * BM + wc * 32 + 8 * fq;
        u16* base = EAG + (size_t)sel * M * 1024;
        const float* bias = sel < 2 ? (w0 + sel * 1024) : (a0 + ((sel - 2) & 1) * 1024);
        f32x4 bv[2][2];
#pragma unroll
        for (int bj = 0; bj < 2; ++bj)
#pragma unroll
            for (int n = 0; n < 2; ++n) bv[bj][n] = (sel < 4) ? *(const f32x4*)(bias + col0 + bj * HALF + n * 4) : (f32x4){0.f, 0.f, 0.f, 0.f};
#pragma unroll
        for (int ai = 0; ai < 2; ++ai)
#pragma unroll
            for (int m = 0; m < 4; ++m) { u16* rowp = base + (size_t)(row0 + ai * HALF + m * 16) * 1024 + col0;
#pragma unroll
                for (int bj = 0; bj < 2; ++bj)
#pragma unroll
                    for (int n = 0; n < 2; ++n) { const f32x4 v = acc[ai][bj][m][n] + bv[bj][n]; u32x2 w;
                        if (sel < 2) { _Float16 h[4];
#pragma unroll
                            for (int j = 0; j < 4; ++j) h[j] = (_Float16)(0.60653066f * sigmoidf_(v[j]));
                            w.x = (unsigned)__builtin_bit_cast(u16, h[0]) | ((unsigned)__builtin_bit_cast(u16, h[1]) << 16);
                            w.y = (unsigned)__builtin_bit_cast(u16, h[2]) | ((unsigned)__builtin_bit_cast(u16, h[3]) << 16);
                        } else if (sel < 4) { w.x = cvt_pk_bf16(sigmoidf_(v[0]), sigmoidf_(v[1])); w.y = cvt_pk_bf16(sigmoidf_(v[2]), sigmoidf_(v[3]));
                        } else { w.x = cvt_pk_bf16(v[0], v[1]); w.y = cvt_pk_bf16(v[2], v[3]); }
                        *(u32x2*)(rowp + bj * HALF + n * 4) = w; } }
    }
};
template <class Epi, class Sched, bool STAMP = false>
__device__ __forceinline__ void gemm_phase(PG8_LAS unsigned char* lds, const Gemm g, const Sched& S, const Epi& E, unsigned long long* stamps) {
    const int tid = ltid(), wid = __builtin_amdgcn_readfirstlane(tid >> 6), lane = tid & 63, wr = wid >> 2, wc = wid & 3, fr = lane & 15, fq = lane >> 4;
    const int K = g.K, nt = K / BK;
    int ts_lo = 0, ts_hi = 0, nts = 0; const unsigned long long rt_entry = STAMP ? (unsigned long long)wall_clock64() : 0ull;
#define PG8_STAMP() do { if (STAMP && wid == 0 && nts < 64) { const unsigned long long _c = (unsigned long long)clock64(); \
        ts_lo = (lane == nts) ? (int)(unsigned)_c : ts_lo; ts_hi = (lane == nts) ? (int)(unsigned)(_c >> 32) : ts_hi; ++nts; } } while (0)
    PG8_STAMP();
    unsigned voffA[2], voffB[2];
#pragma unroll
    for (int i = 0; i < 2; ++i) { int R, C; stage_rc(tid * 16 + i * 8192, R, C); const int Rb = Epi::PERM ? ((R & ~31) + perm32(R & 31)) : R;
        voffA[i] = (unsigned)(R * K + C) * 2u; voffB[i] = (unsigned)(Rb * K + C) * 2u; }
    const size_t kstep = (size_t)(BK * 2);
    const size_t hstep = (size_t)HALF * K * 2;
    const size_t tstep = 2 * hstep;
    const unsigned ldsw = (unsigned)wid * 1024u;
    const int aoff = lds_byte(wr * 64 + fr, fq * 8), boff = lds_byte(wc * 32 + fr, fq * 8);
#define PG8_SA(b, h) (((b) * 2 + (h)) * HTB)
#define PG8_SB(b, h) ((4 + (b) * 2 + (h)) * HTB)
#define PG8_STAGE(bufoff, gbase, voff) do { _Pragma("unroll") for (int _i = 0; _i < 2; ++_i) \
        __builtin_amdgcn_global_load_lds((const unsigned*)((const char*)(gbase) + (voff)[_i]), (PG8_LAS unsigned*)(lds + (bufoff) + ldsw + _i * 8192), 16, 0, 0); } while (0)
#define PG8_LDA(dst, b, h) do { _Pragma("unroll") for (int m = 0; m < 4; ++m) _Pragma("unroll") for (int k = 0; k < 2; ++k) dst[m][k] = *(const PG8_LAS bf16x8*)(lds + PG8_SA(b, h) + aoff + m * 2048 + k * 1024); } while (0)
#define PG8_LDB(dst, b, h) do { _Pragma("unroll") for (int n = 0; n < 2; ++n) _Pragma("unroll") for (int k = 0; k < 2; ++k) dst[n][k] = *(const PG8_LAS bf16x8*)(lds + PG8_SB(b, h) + boff + n * 2048 + k * 1024); } while (0)
#define PG8_MMA(ai, bj, At, Bt) do { __builtin_amdgcn_s_setprio(1); _Pragma("unroll") for (int m = 0; m < 4; ++m) _Pragma("unroll") for (int n = 0; n < 2; ++n) _Pragma("unroll") for (int k = 0; k < 2; ++k) \
        acc[ai][bj][m][n] = __builtin_amdgcn_mfma_f32_16x16x32_bf16(Bt[n][k], At[m][k], acc[ai][bj][m][n], 0, 0, 0); __builtin_amdgcn_s_setprio(0); } while (0)
#define PG8_WAIT_V(n) asm volatile("s_waitcnt vmcnt(" #n ")" ::: "memory")
#define PG8_WAIT_L(n) asm volatile("s_waitcnt lgkmcnt(" #n ")" ::: "memory")
#define PG8_BAR __builtin_amdgcn_s_barrier()
#define PG8_SCHED __builtin_amdgcn_sched_barrier(0)
    Unit cur, nxt; int ui = 0;
    if (!S.next(0, cur)) return;
    f32x4 acc[2][2][4][2];
#pragma unroll
    for (int a = 0; a < 2; ++a)
#pragma unroll
        for (int b = 0; b < 2; ++b)
#pragma unroll
            for (int m = 0; m < 4; ++m)
#pragma unroll
                for (int n = 0; n < 2; ++n) acc[a][b][m][n] = (f32x4){0.f, 0.f, 0.f, 0.f};
    bf16x8 At[4][2], B0[2][2], B1[2][2];
    const char* cA = (const char*)g.A + (size_t)cur.pm * tstep + (size_t)(cur.pn >> g.a_grp_shift) * g.a_grp_bytes; const char* cB = (const char*)g.Bt + (size_t)cur.pn * tstep;
    S.a_ready(cur);
    PG8_STAGE(PG8_SB(0, 0), cB, voffB); PG8_STAGE(PG8_SA(0, 0), cA, voffA); PG8_STAGE(PG8_SB(0, 1), cB + hstep, voffB); PG8_STAGE(PG8_SA(0, 1), cA + hstep, voffA);
    if (wr == 1) PG8_BAR;
    PG8_WAIT_V(4); PG8_BAR;
    PG8_STAGE(PG8_SB(1, 0), cB + kstep, voffB); PG8_STAGE(PG8_SA(1, 0), cA + kstep, voffA); PG8_STAGE(PG8_SB(1, 1), cB + hstep + kstep, voffB);
    PG8_WAIT_V(6); PG8_BAR;
    PG8_STAMP();
    for (;;) {
        const bool has_next = S.next(ui + 1, nxt);
        const char* nA = has_next ? (const char*)g.A + (size_t)nxt.pm * tstep + (size_t)(nxt.pn >> g.a_grp_shift) * g.a_grp_bytes : cA; const char* nB = has_next ? (const char*)g.Bt + (size_t)nxt.pn * tstep : cB;
        for (int t = 0; t < nt; t += 2) {
            const bool last = (t == nt - 2);
            const char* a1 = cA + (size_t)(t + 1) * kstep;
            const char* a2 = last ? nA : cA + (size_t)(t + 2) * kstep; const char* b2 = last ? nB : cB + (size_t)(t + 2) * kstep;
            const char* a3 = a2 + kstep; const char* b3 = b2 + kstep;
            if (last && has_next) S.a_ready(nxt);
            PG8_LDB(B0, 0, 0); PG8_SCHED; PG8_LDA(At, 0, 0); PG8_STAGE(PG8_SA(1, 1), a1 + hstep, voffA);
            PG8_WAIT_L(8); PG8_BAR; PG8_WAIT_L(0); PG8_MMA(0, 0, At, B0); PG8_BAR; PG8_SCHED;
            PG8_LDB(B1, 0, 1); PG8_STAGE(PG8_SB(0, 0), b2, voffB);
            PG8_BAR; PG8_WAIT_L(0); PG8_MMA(0, 1, At, B1); PG8_BAR;
            PG8_LDA(At, 0, 1); PG8_STAGE(PG8_SA(0, 0), a2, voffA);
            PG8_BAR; PG8_WAIT_L(0); PG8_MMA(1, 0, At, B0); PG8_BAR; PG8_SCHED;
            PG8_STAGE(PG8_SB(0, 1), b2 + hstep, voffB);
            PG8_WAIT_V(6); PG8_BAR; PG8_MMA(1, 1, At, B1); PG8_BAR;
            PG8_LDB(B0, 1, 0); PG8_SCHED; PG8_LDA(At, 1, 0); PG8_STAGE(PG8_SA(0, 1), a2 + hstep, voffA);
            PG8_WAIT_L(8); PG8_BAR; PG8_WAIT_L(0); PG8_MMA(0, 0, At, B0); PG8_BAR; PG8_SCHED;
            PG8_LDB(B1, 1, 1); PG8_STAGE(PG8_SB(1, 0), b3, voffB);
            PG8_BAR; PG8_WAIT_L(0); PG8_MMA(0, 1, At, B1); PG8_BAR;
            PG8_LDA(At, 1, 1); PG8_STAGE(PG8_SA(1, 0), a3, voffA);
            PG8_BAR; PG8_WAIT_L(0); PG8_MMA(1, 0, At, B0); PG8_BAR; PG8_SCHED;
            PG8_STAGE(PG8_SB(1, 1), b3 + hstep, voffB);
            PG8_WAIT_V(6); PG8_BAR; PG8_MMA(1, 1, At, B1); PG8_BAR;
        }
        PG8_STAMP();
        if constexpr (!Epi::AFTER_DRAIN) { E(acc, cur, wr, wc, fr, fq); S.done(cur); }
        PG8_STAMP();
        if (!has_next) break;
#pragma unroll
        for (int a = 0; a < 2; ++a)
#pragma unroll
            for (int b = 0; b < 2; ++b)
#pragma unroll
                for (int m = 0; m < 4; ++m)
#pragma unroll
                    for (int n = 0; n < 2; ++n) acc[a][b][m][n] = (f32x4){0.f, 0.f, 0.f, 0.f};
        cur = nxt; cA = nA; cB = nB; ++ui;
    }
    PG8_WAIT_V(0);
    if (wr == 0) PG8_BAR;
    PG8_BAR;
    if constexpr (Epi::AFTER_DRAIN) { E.fused(acc, cur, wr, wc, fr, fq, lds, wid, lane); S.done(cur); }
    PG8_STAMP();
    if (STAMP && wid == 0) { stamps[lane] = lane < nts ? (((unsigned long long)(unsigned)ts_hi << 32) | (unsigned)ts_lo) : 0ull;
        if (lane == 62) stamps[62] = rt_entry; if (lane == 63) stamps[63] = (unsigned long long)wall_clock64(); }
#undef PG8_STAMP
#undef PG8_SA
#undef PG8_SB
#undef PG8_STAGE
#undef PG8_LDA
#undef PG8_LDB
#undef PG8_MMA
#undef PG8_WAIT_V
#undef PG8_WAIT_L
#undef PG8_BAR
#undef PG8_SCHED
}
}
struct Params { const float* in[35]; float* out; unsigned char* ws; int pad0, pad1; };

constexpr size_t MB = 1u << 20;
constexpr size_t WS_WMIX  = 0;
constexpr size_t WMIX_B   = (size_t)3584 * 2048 * 2;
constexpr size_t WMIX_C   = WMIX_B + (size_t)5120 * 512 * 2;
constexpr size_t WS_WQ    = WS_WMIX + WMIX_C + (size_t)1024 * 1024 * 2;
constexpr size_t WS_WKV   = WS_WQ + (size_t)1024 * 1024 * 2;
constexpr size_t WS_WO    = WS_WKV + (size_t)2048 * 1024 * 2;
constexpr size_t WS_WGU   = WS_WO + (size_t)1024 * 1024 * 2;
constexpr size_t WS_WDN   = WS_WGU + (size_t)5632 * 1024 * 2;
constexpr size_t WS_MN    = WS_WDN + (size_t)1024 * 2816 * 2;
constexpr size_t WS_KV    = WS_MN + (size_t)4096 * 1024 * 2;
constexpr size_t WS_ROPE  = WS_KV + (size_t)4096 * 2048 * 2;
constexpr size_t WS_ARENA = WS_ROPE + (size_t)4096 * 16 * 4;
constexpr size_t AR_A = 0, AR_B = (size_t)TC * 8192, AR_C = (size_t)TC * 14336, AR_D = (size_t)TC * 24576, AR_END = (size_t)TC * 26624;
constexpr size_t WS_BAR = WS_ARENA + AR_END;
constexpr size_t WS_SS = WS_BAR + 16384;
constexpr size_t WS_END = WS_SS + (size_t)2 * TC * 8;

__device__ __forceinline__ int map_row(int n, int mode) {
    if (mode == 0) return n;
    const int up = n >= 2816, c = up ? n - 2816 : n;
    return (c >> 4) * 32 + ((c & 15) >> 2) * 8 + up * 4 + (c & 3);
}
__device__ __forceinline__ void tr_job(LAS unsigned char* lds, const float* __restrict__ src, int ld_src, int K, int N, u16* dst, int ld_dst, int col0, const float* __restrict__ s1, int mode, int rot) {
    LAS float* T = (LAS float*)lds;
    const int tid = ltid(), nkt = K >> 6, nnt = N >> 6, ntile = nkt * nnt;
    for (int t = (blockIdx.x + rot) % gridDim.x; t < ntile; t += gridDim.x) {
        const int kt = t / nnt, nt = t % nnt;
#pragma unroll
        for (int it = 0; it < 2; ++it) {
            const int kk = (tid >> 4) + it * 32, n4 = (tid & 15) * 4;
            f32x4 v = *(const f32x4*)(src + (size_t)(kt * 64 + kk) * ld_src + nt * 64 + n4);
            const float s = s1 ? s1[kt * 64 + kk] : 1.0f;
#pragma unroll
            for (int e = 0; e < 4; ++e) T[(n4 + e) * 65 + kk] = v[e] * s;
        }
        __syncthreads();
        {
            const int n = tid >> 3, k8 = (tid & 7) * 8; float f[8];
#pragma unroll
            for (int e = 0; e < 8; ++e) f[e] = T[n * 65 + k8 + e];
            u32x4 w; w.x = cvt_pk_bf16(f[0], f[1]); w.y = cvt_pk_bf16(f[2], f[3]); w.z = cvt_pk_bf16(f[4], f[5]); w.w = cvt_pk_bf16(f[6], f[7]);
            *(u32x4*)(dst + (size_t)map_row(nt * 64 + n, mode) * ld_dst + col0 + kt * 64 + k8) = w;
        }
        __syncthreads();
    }
}

__device__ __forceinline__ void norm_rows(const float* __restrict__ X, const u16* __restrict__ Xh, const float* __restrict__ g, u16* dst, int ld_dst, int nrows) {
    const int lane = ltid() & 63, gw = blockIdx.x * 8 + (ltid() >> 6), nw = gridDim.x * 8;
    f32x4 gv[4];
#pragma unroll
    for (int i = 0; i < 4; ++i) gv[i] = *(const f32x4*)(g + i * 256 + lane * 4);
    for (int r = gw; r < nrows; r += nw) {
        f32x4 v[4]; float ss = 0.f;
#pragma unroll
        for (int i = 0; i < 4; ++i) {
            if (Xh) { const u32x2 h = *(const u32x2*)(Xh + (size_t)r * 1024 + i * 256 + lane * 4); v[i] = (f32x4){bflo(h.x), bfhi(h.x), bflo(h.y), bfhi(h.y)}; }
            else v[i] = *(const f32x4*)(X + (size_t)r * 1024 + i * 256 + lane * 4);
            ss += v[i][0] * v[i][0] + v[i][1] * v[i][1] + v[i][2] * v[i][2] + v[i][3] * v[i][3]; }
        ss = wave_sum(ss); const float rs = rsqrtf(ss * (1.0f / 1024.0f) + 1e-6f);
#pragma unroll
        for (int i = 0; i < 4; ++i) { u32x2 w; w.x = cvt_pk_bf16(v[i][0] * rs * gv[i][0], v[i][1] * rs * gv[i][1]); w.y = cvt_pk_bf16(v[i][2] * rs * gv[i][2], v[i][3] * rs * gv[i][3]);
            *(u32x2*)(dst + (size_t)r * ld_dst + i * 256 + lane * 4) = w; }
    }
}
__device__ __forceinline__ void norm_final(const u16* __restrict__ Xh, float* out, const float* __restrict__ g, int nrows) {
    const int lane = ltid() & 63, gw = blockIdx.x * 8 + (ltid() >> 6), nw = gridDim.x * 8;
    f32x4 gv[4];
#pragma unroll
    for (int i = 0; i < 4; ++i) gv[i] = *(const f32x4*)(g + i * 256 + lane * 4);
    for (int r = gw; r < nrows; r += nw) {
        f32x4 v[4]; float ss = 0.f;
#pragma unroll
        for (int i = 0; i < 4; ++i) { const u32x2 h = *(const u32x2*)(Xh + (size_t)r * 1024 + i * 256 + lane * 4); v[i] = (f32x4){bflo(h.x), bfhi(h.x), bflo(h.y), bfhi(h.y)};
            ss += v[i][0] * v[i][0] + v[i][1] * v[i][1] + v[i][2] * v[i][2] + v[i][3] * v[i][3]; }
        ss = wave_sum(ss); const float rs = rsqrtf(ss * (1.0f / 1024.0f) + 1e-6f);
#pragma unroll
        for (int i = 0; i < 4; ++i) *(f32x4*)(out + (size_t)r * 1024 + i * 256 + lane * 4) = v[i] * rs * gv[i];
    }
}
__device__ __forceinline__ void norm_shift(const float* __restrict__ X, const u16* __restrict__ Xh, const float* __restrict__ g, const float* __restrict__ mu, u16* XNX, u16* XM, int S) {
    const int lane = ltid() & 63, gw = blockIdx.x * 8 + (ltid() >> 6), nw = gridDim.x * 8;
    f32x4 gv[4], m0[4], m2[4], m3[4];
#pragma unroll
    for (int i = 0; i < 4; ++i) { gv[i] = *(const f32x4*)(g + i * 256 + lane * 4); m0[i] = *(const f32x4*)(mu + i * 256 + lane * 4); m2[i] = *(const f32x4*)(mu + 2048 + i * 256 + lane * 4); m3[i] = *(const f32x4*)(mu + 3072 + i * 256 + lane * 4); }
    for (int run = gw; run < TC / 8; run += nw) {
        const int r0 = run * 8;
        f32x4 xp[4], xc[4], xq[4];
#define NS_LOAD(dst, rr) do { const int r_ = (rr); const bool in_ = (r_ >= 0) && (r_ < TC) && ((r_ / S) == (r0 / S)); float ss_ = 0.f; \
            _Pragma("unroll") for (int i = 0; i < 4; ++i) { if (!in_) dst[i] = (f32x4){0.f, 0.f, 0.f, 0.f}; \
                else if (Xh) { const u32x2 h_ = *(const u32x2*)(Xh + (size_t)r_ * 1024 + i * 256 + lane * 4); dst[i] = (f32x4){bflo(h_.x), bfhi(h_.x), bflo(h_.y), bfhi(h_.y)}; } \
                else dst[i] = *(const f32x4*)(X + (size_t)r_ * 1024 + i * 256 + lane * 4); \
                ss_ += dst[i][0] * dst[i][0] + dst[i][1] * dst[i][1] + dst[i][2] * dst[i][2] + dst[i][3] * dst[i][3]; } \
            ss_ = wave_sum(ss_); const float rs_ = in_ ? rsqrtf(ss_ * (1.0f / 1024.0f) + 1e-6f) : 0.f; \
            _Pragma("unroll") for (int i = 0; i < 4; ++i) dst[i] = dst[i] * rs_ * gv[i]; } while (0)
        NS_LOAD(xp, r0 - 1); NS_LOAD(xc, r0);
#pragma unroll 1
        for (int k = 0; k < 8; ++k) {
            const int r = r0 + k;
            NS_LOAD(xq, r + 1);
#pragma unroll
            for (int i = 0; i < 4; ++i) { float xn[4], xx[4];
#pragma unroll
                for (int e = 0; e < 4; ++e) { xn[e] = xc[i][e]; xx[e] = 0.5f * (xp[i][e] + xq[i][e]) - xn[e]; }
                const size_t o = (size_t)r * 2048 + i * 256 + lane * 4, om = (size_t)r * 1024 + i * 256 + lane * 4;
                u32x2 w; w.x = cvt_pk_bf16(xn[0], xn[1]); w.y = cvt_pk_bf16(xn[2], xn[3]); *(u32x2*)(XNX + o) = w;
                u32x2 z; z.x = cvt_pk_bf16(xx[0], xx[1]); z.y = cvt_pk_bf16(xx[2], xx[3]); *(u32x2*)(XNX + o + 1024) = z;
                u32x2 a; a.x = cvt_pk_bf16(xn[0] + xx[0] * m0[i][0], xn[1] + xx[1] * m0[i][1]); a.y = cvt_pk_bf16(xn[2] + xx[2] * m0[i][2], xn[3] + xx[3] * m0[i][3]); *(u32x2*)(XM + om) = a;
                u32x2 b; b.x = cvt_pk_bf16(xn[0] + xx[0] * m2[i][0], xn[1] + xx[1] * m2[i][1]); b.y = cvt_pk_bf16(xn[2] + xx[2] * m2[i][2], xn[3] + xx[3] * m2[i][3]); *(u32x2*)(XM + (size_t)TC * 1024 + om) = b;
                u32x2 c; c.x = cvt_pk_bf16(xn[0] + xx[0] * m3[i][0], xn[1] + xx[1] * m3[i][1]); c.y = cvt_pk_bf16(xn[2] + xx[2] * m3[i][2], xn[3] + xx[3] * m3[i][3]); *(u32x2*)(XM + (size_t)2 * TC * 1024 + om) = c; }
#pragma unroll
            for (int i = 0; i < 4; ++i) { xp[i] = xc[i]; xc[i] = xq[i]; }
        }
#undef NS_LOAD
    }
}

__device__ __forceinline__ bf16x8 as_bf16x8(u32x4 v) { return __builtin_bit_cast(bf16x8, v); }
__device__ __forceinline__ u32x4 rot8(u32x4 mine, u32x4 partner, int c, const float* __restrict__ rope, float scale) {
    float cs[16];
#pragma unroll
    for (int i = 0; i < 4; ++i) { const f32x4 t = *(const f32x4*)(rope + 4 * i); cs[4 * i] = t[0]; cs[4 * i + 1] = t[1]; cs[4 * i + 2] = t[2]; cs[4 * i + 3] = t[3]; }
    float o[8];
#pragma unroll
    for (int i = 0; i < 4; ++i) {
        const unsigned mw = mine[i], pw = partner[i];
        const float m0 = bflo(mw), m1 = bfhi(mw), p0 = bflo(pw), p1 = bfhi(pw);
        const float c0 = cs[4 * i], s0 = cs[4 * i + 1], c1 = cs[4 * i + 2], s1 = cs[4 * i + 3];
        if (c == 0) { o[2 * i] = (m0 * c0 - p0 * s0) * scale; o[2 * i + 1] = (m1 * c1 - p1 * s1) * scale; }
        else        { o[2 * i] = (m0 * c0 + p0 * s0) * scale; o[2 * i + 1] = (m1 * c1 + p1 * s1) * scale; }
    }
    u32x4 r; r.x = cvt_pk_bf16(o[0], o[1]); r.y = cvt_pk_bf16(o[2], o[3]); r.z = cvt_pk_bf16(o[4], o[5]); r.w = cvt_pk_bf16(o[6], o[7]); return r;
}
__device__ __forceinline__ u32x4 scale8(u32x4 v, float scale) {
    u32x4 r;
#pragma unroll
    for (int i = 0; i < 4; ++i) r[i] = cvt_pk_bf16(bflo(v[i]) * scale, bfhi(v[i]) * scale);
    return r;
}

__device__ __forceinline__ void dil_attn_phase(LAS unsigned char* lds, const u16* __restrict__ Z, u16* PART, float* LSE, const float* __restrict__ ROPE, int S) {
    const int tid = ltid(), lane = tid & 63, w = tid >> 6, fr = lane & 15, fq = lane >> 4;
    LAS u16* Ks = (LAS u16*)lds;
    LAS u16* Vt = (LAS u16*)(lds + 272 * 144);
    const int upb = S >> 7, nunits = (TC / S) * 8 * 3 * upb;
    for (int u = blockIdx.x; u < nunits; u += gridDim.x) {
        const int sh = u / (3 * upb), rem = u % (3 * upb), g = rem / upb, idx = rem % upb, seq = sh >> 3, head = sh & 7;
        const int d = 1 << (2 * g), L = S / d, nb2 = upb / d, r = idx / nb2, pair = idx % nb2;
        const int seqbase = seq * S, kl0 = 128 * pair - 64;
        {
            const int c = tid & 7, klb = tid >> 3;
            u32x4 kv[5], pk[5], vv[5]; int sp[5];
#pragma unroll
            for (int i = 0; i < 5; ++i) {
                const int kl = klb + 64 * i, lp = kl0 + kl; const bool ok = (kl < 272) && (lp >= 0) && (lp < L);
                const int s = ok ? lp * d + r : 0; sp[i] = ok ? s : -1;
                const u16* row = Z + (size_t)(seqbase + s) * 3072 + head * 64;
                kv[i] = ok ? *(const u32x4*)(row + 512 + c * 8) : (u32x4){0u, 0u, 0u, 0u};
                pk[i] = (ok && c < 2) ? *(const u32x4*)(row + 512 + (c ^ 1) * 8) : (u32x4){0u, 0u, 0u, 0u};
                const int klv = lane + 64 * i, lpv = kl0 + klv; const bool okv = (klv < 272) && (lpv >= 0) && (lpv < L);
                const int sv = okv ? lpv * d + r : 0;
                vv[i] = okv ? *(const u32x4*)(Z + (size_t)(seqbase + sv) * 3072 + head * 64 + 1024 + w * 8) : (u32x4){0u, 0u, 0u, 0u};
            }
            __builtin_amdgcn_sched_barrier(0);
#pragma unroll
            for (int i = 0; i < 5; ++i) {
                const int kl = klb + 64 * i;
                if (kl < 272) { u32x4 kk = kv[i]; if (c < 2 && sp[i] >= 0) kk = rot8(kk, pk[i], c, ROPE + sp[i] * 16, 1.0f); *(LAS u32x4*)(Ks + kl * 72 + c * 8) = kk; }
                const int klv = lane + 64 * i;
                if (klv < 272) {
#pragma unroll
                    for (int e = 0; e < 4; ++e) { Vt[(w * 8 + 2 * e) * 280 + klv] = (u16)(vv[i][e] & 0xffffu); Vt[(w * 8 + 2 * e + 1) * 280 + klv] = (u16)(vv[i][e] >> 16); } }
            }
        }
        const int lq = 128 * pair + 16 * w + fr, sq = lq * d + r; const int tokq = seqbase + sq;
        bf16x8 qf[2];
        {
            const u16* row = Z + (size_t)tokq * 3072 + head * 64;
            u32x4 q0 = *(const u32x4*)(row + fq * 8), q1 = *(const u32x4*)(row + 32 + fq * 8);
            if (fq < 2) { const u32x4 pk = *(const u32x4*)(row + (fq ^ 1) * 8); q0 = rot8(q0, pk, fq, ROPE + sq * 16, 0.125f); } else q0 = scale8(q0, 0.125f);
            q1 = scale8(q1, 0.125f);
            qf[0] = as_bf16x8(q0); qf[1] = as_bf16x8(q1);
        }
        __syncthreads();
        f32x4 sacc[10];
#pragma unroll
        for (int kt = 0; kt < 10; ++kt) { sacc[kt] = (f32x4){0.f, 0.f, 0.f, 0.f};
#pragma unroll
            for (int sl = 0; sl < 2; ++sl) { const bf16x8 a = *(const LAS bf16x8*)(Ks + (16 * w + 16 * kt + fr) * 72 + sl * 32 + fq * 8); sacc[kt] = __builtin_amdgcn_mfma_f32_16x16x32_bf16(a, qf[sl], sacc[kt], 0, 0, 0); } }
        float mx = -3.0e38f;
#pragma unroll
        for (int kt = 0; kt < 10; ++kt)
#pragma unroll
            for (int j = 0; j < 4; ++j) { const int diff = 16 * kt + fq * 4 + j - 64 - fr, lp = lq + diff; const bool ok = (diff >= -64) && (diff <= 64) && (lp >= 0) && (lp < L);
                const float sv = ok ? sacc[kt][j] : -1.0e30f; sacc[kt][j] = sv; mx = fmaxf(mx, sv); }
        mx = fmaxf(mx, __shfl_xor(mx, 16)); mx = fmaxf(mx, __shfl_xor(mx, 32));
        float den = 0.f;
#pragma unroll
        for (int kt = 0; kt < 10; ++kt)
#pragma unroll
            for (int j = 0; j < 4; ++j) { const float sv = sacc[kt][j]; const float p = (sv > -1.0e29f) ? __expf(sv - mx) : 0.f; sacc[kt][j] = p; den += p; }
        den += __shfl_xor(den, 16); den += __shfl_xor(den, 32);
        bf16x8 pb[5];
#pragma unroll
        for (int uu = 0; uu < 5; ++uu) { u32x4 t; t.x = cvt_pk_bf16(sacc[2 * uu][0], sacc[2 * uu][1]); t.y = cvt_pk_bf16(sacc[2 * uu][2], sacc[2 * uu][3]);
            t.z = cvt_pk_bf16(sacc[2 * uu + 1][0], sacc[2 * uu + 1][1]); t.w = cvt_pk_bf16(sacc[2 * uu + 1][2], sacc[2 * uu + 1][3]); pb[uu] = as_bf16x8(t); }
        const float inv = 1.0f / den;
        u16* po = PART + ((size_t)g * TC + tokq) * 512 + head * 64 + fq * 4;
#pragma unroll
        for (int mt = 0; mt < 4; ++mt) { f32x4 o = (f32x4){0.f, 0.f, 0.f, 0.f};
#pragma unroll
            for (int uu = 0; uu < 5; ++uu) { const LAS u16* vp = Vt + (mt * 16 + fr) * 280 + 16 * w + 32 * uu + fq * 4;
                const u32x2 lo = *(const LAS u32x2*)vp, hi = *(const LAS u32x2*)(vp + 16); u32x4 t; t.x = lo.x; t.y = lo.y; t.z = hi.x; t.w = hi.y;
                o = __builtin_amdgcn_mfma_f32_16x16x32_bf16(as_bf16x8(t), pb[uu], o, 0, 0, 0); }
            u32x2 wv; wv.x = cvt_pk_bf16(o[0] * inv, o[1] * inv); wv.y = cvt_pk_bf16(o[2] * inv, o[3] * inv); *(u32x2*)(po + mt * 16) = wv; }
        if (fq == 0) LSE[((size_t)g * TC + tokq) * 8 + head] = mx + __logf(den);
        __syncthreads();
    }
}

__device__ __forceinline__ void merge_conv_phase(const u16* __restrict__ Z, const u16* __restrict__ PART, const float* __restrict__ LSE, const float* __restrict__ convw, u16* Y, int S) {
    const int lane = ltid() & 63, gw = blockIdx.x * 8 + (ltid() >> 6), nw = gridDim.x * 8;
    float cw[3][8];
#pragma unroll
    for (int j = 0; j < 3; ++j)
#pragma unroll
        for (int e = 0; e < 8; ++e) cw[j][e] = convw[j * 512 + lane * 8 + e];
    for (int t = gw; t < TC; t += nw) {
        const int s = t % S, head = lane >> 3;
        const float l0 = LSE[((size_t)0 * TC + t) * 8 + head], l1 = LSE[((size_t)1 * TC + t) * 8 + head], l2 = LSE[((size_t)2 * TC + t) * 8 + head];
        const float lm = fmaxf(l0, fmaxf(l1, l2)); float w0 = __expf(l0 - lm), w1 = __expf(l1 - lm), w2 = __expf(l2 - lm); const float wi = 1.0f / (w0 + w1 + w2); w0 *= wi; w1 *= wi; w2 *= wi;
        const u32x4 p0 = *(const u32x4*)(PART + ((size_t)0 * TC + t) * 512 + lane * 8), p1 = *(const u32x4*)(PART + ((size_t)1 * TC + t) * 512 + lane * 8), p2 = *(const u32x4*)(PART + ((size_t)2 * TC + t) * 512 + lane * 8);
        u32x4 ya;
#pragma unroll
        for (int i = 0; i < 4; ++i) ya[i] = cvt_pk_bf16(w0 * bflo(p0[i]) + w1 * bflo(p1[i]) + w2 * bflo(p2[i]), w0 * bfhi(p0[i]) + w1 * bfhi(p1[i]) + w2 * bfhi(p2[i]));
        *(u32x4*)(Y + (size_t)t * 1024 + lane * 8) = ya;
        const u16* zr = Z + (size_t)t * 3072;
        const u32x4 bg = *(const u32x4*)(zr + 1536 + lane * 8);
        float acc[8];
#pragma unroll
        for (int e = 0; e < 8; ++e) acc[e] = 0.f;
#pragma unroll
        for (int j = 0; j < 3; ++j) { const int sj = s + j - 1;
            if (sj >= 0 && sj < S) { const u16* zj = zr + (ptrdiff_t)(j - 1) * 3072; const u32x4 cg = *(const u32x4*)(zj + 2048 + lane * 8), hh = *(const u32x4*)(zj + 2560 + lane * 8);
#pragma unroll
                for (int i = 0; i < 4; ++i) { acc[2 * i] += cw[j][2 * i] * (bflo(cg[i]) * bflo(hh[i])); acc[2 * i + 1] += cw[j][2 * i + 1] * (bfhi(cg[i]) * bfhi(hh[i])); } } }
        u32x4 yb;
#pragma unroll
        for (int i = 0; i < 4; ++i) yb[i] = cvt_pk_bf16(bflo(bg[i]) * acc[2 * i], bfhi(bg[i]) * acc[2 * i + 1]);
        *(u32x4*)(Y + (size_t)t * 1024 + 512 + lane * 8) = yb;
    }
}

__device__ __forceinline__ void cross_attn_pair(LAS unsigned char* lds, const u16* __restrict__ Q, const u16* __restrict__ KV, int memrow0, u16* O, int S, int seq, int head, int qt0) {
    const int tid = ltid(), lane = tid & 63, w = tid >> 6, fr = lane & 15, fq = lane >> 4;
    LAS u16* Ks = (LAS u16*)lds;
    const u16* kvb = KV + (size_t)(memrow0 + seq * 256) * 2048 + head * 256;
    { u32x4 tmp[16];
#pragma unroll
      for (int i = 0; i < 16; ++i) { const int task = tid + i * NTHREADS, key = task >> 5, c = task & 31; tmp[i] = *(const u32x4*)(kvb + (size_t)key * 2048 + c * 8); }
#pragma unroll
      for (int i = 0; i < 16; ++i) { const int task = tid + i * NTHREADS, key = task >> 5, c = task & 31; *(LAS u32x4*)(Ks + key * 264 + c * 8) = tmp[i]; } }
    const int tok0 = seq * S + qt0 * 128 + 16 * w + fr;
    bf16x8 pb[2][8]; float inv[2];
    __syncthreads();
#pragma unroll
    for (int h = 0; h < 2; ++h) {
        bf16x8 qf[8];
        { const u16* row = Q + (size_t)(tok0 + 128 * h) * 1024 + head * 256;
#pragma unroll
          for (int sl = 0; sl < 8; ++sl) qf[sl] = as_bf16x8(scale8(*(const u32x4*)(row + sl * 32 + fq * 8), 0.0625f)); }
        f32x4 sacc[16];
#pragma unroll
        for (int kt = 0; kt < 16; ++kt) { sacc[kt] = (f32x4){0.f, 0.f, 0.f, 0.f};
#pragma unroll
            for (int sl = 0; sl < 8; ++sl) { const bf16x8 a = *(const LAS bf16x8*)(Ks + (16 * kt + fr) * 264 + sl * 32 + fq * 8); sacc[kt] = __builtin_amdgcn_mfma_f32_16x16x32_bf16(a, qf[sl], sacc[kt], 0, 0, 0); } }
        float mx = -3.0e38f;
#pragma unroll
        for (int kt = 0; kt < 16; ++kt)
#pragma unroll
            for (int j = 0; j < 4; ++j) mx = fmaxf(mx, sacc[kt][j]);
        mx = fmaxf(mx, __shfl_xor(mx, 16)); mx = fmaxf(mx, __shfl_xor(mx, 32));
        float den = 0.f;
#pragma unroll
        for (int kt = 0; kt < 16; ++kt)
#pragma unroll
            for (int j = 0; j < 4; ++j) { const float pe = __expf(sacc[kt][j] - mx); sacc[kt][j] = pe; den += pe; }
        den += __shfl_xor(den, 16); den += __shfl_xor(den, 32);
        inv[h] = 1.0f / den;
#pragma unroll
        for (int uu = 0; uu < 8; ++uu) { u32x4 t; t.x = cvt_pk_bf16(sacc[2 * uu][0], sacc[2 * uu][1]); t.y = cvt_pk_bf16(sacc[2 * uu][2], sacc[2 * uu][3]);
            t.z = cvt_pk_bf16(sacc[2 * uu + 1][0], sacc[2 * uu + 1][1]); t.w = cvt_pk_bf16(sacc[2 * uu + 1][2], sacc[2 * uu + 1][3]); pb[h][uu] = as_bf16x8(t); }
    }
    __syncthreads();
    { u32x4 tmp[16]; const int key = (w & 3) * 64 + lane, cb = (w >> 2) * 16;
#pragma unroll
      for (int i = 0; i < 16; ++i) tmp[i] = *(const u32x4*)(kvb + 1024 + (size_t)key * 2048 + (cb + i) * 8);
#pragma unroll
      for (int i = 0; i < 16; ++i) {
#pragma unroll
        for (int e = 0; e < 4; ++e) { Ks[((cb + i) * 8 + 2 * e) * 264 + key] = (u16)(tmp[i][e] & 0xffffu); Ks[((cb + i) * 8 + 2 * e + 1) * 264 + key] = (u16)(tmp[i][e] >> 16); } } }
    __syncthreads();
#pragma unroll
    for (int h = 0; h < 2; ++h) {
        u16* po = O + (size_t)(tok0 + 128 * h) * 1024 + head * 256 + fq * 4;
#pragma unroll
        for (int mt = 0; mt < 16; ++mt) { f32x4 o = (f32x4){0.f, 0.f, 0.f, 0.f};
#pragma unroll
            for (int uu = 0; uu < 8; ++uu) { const LAS u16* vp = Ks + (mt * 16 + fr) * 264 + 32 * uu + fq * 4;
                const u32x2 lo = *(const LAS u32x2*)vp, hi = *(const LAS u32x2*)(vp + 16); u32x4 t; t.x = lo.x; t.y = lo.y; t.z = hi.x; t.w = hi.y;
                o = __builtin_amdgcn_mfma_f32_16x16x32_bf16(as_bf16x8(t), pb[h][uu], o, 0, 0, 0); }
            u32x2 wv; wv.x = cvt_pk_bf16(o[0] * inv[h], o[1] * inv[h]); wv.y = cvt_pk_bf16(o[2] * inv[h], o[3] * inv[h]); *(u32x2*)(po + mt * 16) = wv; }
    }
    __syncthreads();
}
template <int CTRL> __device__ __forceinline__ float dpp_add(float v) { const int t = __builtin_amdgcn_update_dpp(__float_as_int(v), __float_as_int(v), CTRL, 0xf, 0xf, true); return v + __int_as_float(t); }
template <int L> __device__ __forceinline__ float row_reduce(float v) {
    v = dpp_add<0xB1>(v); v = dpp_add<0x4E>(v); v = dpp_add<0x141>(v);
    if (L == 16) v = dpp_add<0x140>(v);
    return v;
}
__device__ __forceinline__ void row_reduce2(float& a, float& b) {
    asm volatile("s_nop 1\n\t"
        "v_add_f32_dpp %0, %0, %0 quad_perm:[1,0,3,2] row_mask:0xf bank_mask:0xf bound_ctrl:1\n\t"
        "v_add_f32_dpp %1, %1, %1 quad_perm:[1,0,3,2] row_mask:0xf bank_mask:0xf bound_ctrl:1\n\t"
        "s_nop 0\n\t"
        "v_add_f32_dpp %0, %0, %0 quad_perm:[2,3,0,1] row_mask:0xf bank_mask:0xf bound_ctrl:1\n\t"
        "v_add_f32_dpp %1, %1, %1 quad_perm:[2,3,0,1] row_mask:0xf bank_mask:0xf bound_ctrl:1\n\t"
        "s_nop 0\n\t"
        "v_add_f32_dpp %0, %0, %0 row_half_mirror row_mask:0xf bank_mask:0xf bound_ctrl:1\n\t"
        "v_add_f32_dpp %1, %1, %1 row_half_mirror row_mask:0xf bank_mask:0xf bound_ctrl:1\n\t"
        "s_nop 0\n\t"
        "v_add_f32_dpp %0, %0, %0 row_mirror row_mask:0xf bank_mask:0xf bound_ctrl:1\n\t"
        "v_add_f32_dpp %1, %1, %1 row_mirror row_mask:0xf bank_mask:0xf bound_ctrl:1"
        : "+v"(a), "+v"(b));
}
__device__ __forceinline__ void half_reduce2(float& a, float& b) {
    asm volatile("s_nop 1\n\t"
        "v_add_f32_dpp %0, %0, %0 quad_perm:[1,0,3,2] row_mask:0xf bank_mask:0xf bound_ctrl:1\n\t"
        "v_add_f32_dpp %1, %1, %1 quad_perm:[1,0,3,2] row_mask:0xf bank_mask:0xf bound_ctrl:1\n\t"
        "s_nop 0\n\t"
        "v_add_f32_dpp %0, %0, %0 quad_perm:[2,3,0,1] row_mask:0xf bank_mask:0xf bound_ctrl:1\n\t"
        "v_add_f32_dpp %1, %1, %1 quad_perm:[2,3,0,1] row_mask:0xf bank_mask:0xf bound_ctrl:1\n\t"
        "s_nop 0\n\t"
        "v_add_f32_dpp %0, %0, %0 row_half_mirror row_mask:0xf bank_mask:0xf bound_ctrl:1\n\t"
        "v_add_f32_dpp %1, %1, %1 row_half_mirror row_mask:0xf bank_mask:0xf bound_ctrl:1"
        : "+v"(a), "+v"(b));
}
__device__ __forceinline__ void half_reduce1(float& a) {
    asm volatile("s_nop 1\n\t"
        "v_add_f32_dpp %0, %0, %0 quad_perm:[1,0,3,2] row_mask:0xf bank_mask:0xf bound_ctrl:1\n\t"
        "s_nop 1\n\t"
        "v_add_f32_dpp %0, %0, %0 quad_perm:[2,3,0,1] row_mask:0xf bank_mask:0xf bound_ctrl:1\n\t"
        "s_nop 1\n\t"
        "v_add_f32_dpp %0, %0, %0 row_half_mirror row_mask:0xf bank_mask:0xf bound_ctrl:1\n\t"
        "s_nop 1"
        : "+v"(a));
}
__device__ __forceinline__ void row_reduce4(float& a, float& b, float& c, float& d) {
#define RR4_STEP(ctl) "v_add_f32_dpp %0, %0, %0 " ctl " row_mask:0xf bank_mask:0xf bound_ctrl:1\n\t" "v_add_f32_dpp %1, %1, %1 " ctl " row_mask:0xf bank_mask:0xf bound_ctrl:1\n\t" \
                      "v_add_f32_dpp %2, %2, %2 " ctl " row_mask:0xf bank_mask:0xf bound_ctrl:1\n\t" "v_add_f32_dpp %3, %3, %3 " ctl " row_mask:0xf bank_mask:0xf bound_ctrl:1\n\t"
    asm volatile("s_nop 1\n\t" RR4_STEP("quad_perm:[1,0,3,2]") RR4_STEP("quad_perm:[2,3,0,1]") RR4_STEP("row_half_mirror") RR4_STEP("row_mirror") "s_nop 1"
        : "+v"(a), "+v"(b), "+v"(c), "+v"(d));
#undef RR4_STEP
}
__device__ __forceinline__ void half_reduce4(float& a, float& b, float& c, float& d) {
#define HR4_STEP(ctl) "v_add_f32_dpp %0, %0, %0 " ctl " row_mask:0xf bank_mask:0xf bound_ctrl:1\n\t" "v_add_f32_dpp %1, %1, %1 " ctl " row_mask:0xf bank_mask:0xf bound_ctrl:1\n\t" \
                      "v_add_f32_dpp %2, %2, %2 " ctl " row_mask:0xf bank_mask:0xf bound_ctrl:1\n\t" "v_add_f32_dpp %3, %3, %3 " ctl " row_mask:0xf bank_mask:0xf bound_ctrl:1\n\t"
    asm volatile("s_nop 1\n\t" HR4_STEP("quad_perm:[1,0,3,2]") HR4_STEP("quad_perm:[2,3,0,1]") HR4_STEP("row_half_mirror") "s_nop 0"
        : "+v"(a), "+v"(b), "+v"(c), "+v"(d));
#undef HR4_STEP
}
#define MR_STEP(ctl) "v_add_f32_dpp %2, %2, %2 " ctl " row_mask:0xf bank_mask:0xf bound_ctrl:1\n\t" "v_add_f32_dpp %3, %3, %3 " ctl " row_mask:0xf bank_mask:0xf bound_ctrl:1\n\t" \
                     "v_add_f32_dpp %0, %0, %0 " ctl " row_mask:0xf bank_mask:0xf bound_ctrl:1\n\t" "v_add_f32_dpp %1, %1, %1 " ctl " row_mask:0xf bank_mask:0xf bound_ctrl:1\n\t"
__device__ __forceinline__ void merged_reduce16(float& a, float& b, float& c, float& d) {
    asm volatile(MR_STEP("quad_perm:[1,0,3,2]") MR_STEP("quad_perm:[2,3,0,1]") MR_STEP("row_half_mirror") MR_STEP("row_mirror") "" : "+v"(a), "+v"(b), "+v"(c), "+v"(d)); }
__device__ __forceinline__ void merged_reduce8(float& a, float& b, float& c, float& d) {
    asm volatile(MR_STEP("quad_perm:[1,0,3,2]") MR_STEP("quad_perm:[2,3,0,1]") MR_STEP("row_half_mirror") "" : "+v"(a), "+v"(b), "+v"(c), "+v"(d)); }
#undef MR_STEP
__device__ __forceinline__ float wave_sum_fast(float v) { v = dpp_add<0xB1>(v); v = dpp_add<0x4E>(v); v = dpp_add<0x141>(v); v = dpp_add<0x140>(v); v += __shfl_xor(v, 16); v += __shfl_xor(v, 32); return v; }
constexpr int TS = 32;
struct ScanRaw { u32x4 r, k, v, e, a; };
template <int RR, int J>
__device__ __forceinline__ void scan_item(LAS unsigned char* lds, const u16* __restrict__ RKV, const u16* __restrict__ Ed, const u16* __restrict__ Ad, const float* __restrict__ kkw, const float* __restrict__ kaw,
                          const float* __restrict__ rkw, u16* OD, float* BON, int S, int seqbase, int head, int dir, int rowbase) {
    constexpr int NACT = 4;
    const int tid = ltid(), lane = tid & 63, w = tid >> 6;
    constexpr int L = 64 / J, NRG = 64 / L;
    const int rg = lane / L, jg = lane % L, j0 = jg * J, row0 = rowbase + w * (NRG * RR) + rg * RR;
    const int pg = lane & 7, ptk = lane >> 3;
    float kkc[8], kac[8], rkc[8];
#pragma unroll
    for (int i = 0; i < 2; ++i) { const f32x4 x = *(const f32x4*)(kkw + head * 64 + pg * 8 + 4 * i), y = *(const f32x4*)(kaw + head * 64 + pg * 8 + 4 * i), z = *(const f32x4*)(rkw + head * 64 + pg * 8 + 4 * i);
#pragma unroll
        for (int e = 0; e < 4; ++e) { kkc[4 * i + e] = x[e]; kac[4 * i + e] = y[e]; rkc[4 * i + e] = z[e]; } }
    f32x2 st_[RR][J / 2];
#pragma unroll
    for (int r = 0; r < RR; ++r)
#pragma unroll
        for (int q = 0; q < J / 2; ++q) st_[r][q] = (f32x2){0.f, 0.f};
    const int nch = S / TS;
    ScanRaw raw;
    const bool prep = (w >= 4); const int pw = w - 4;
#define SCAN_LOAD(ch) do { if (prep) { const int i = (ch) * TS + pw * 8 + ptk; const int t = dir ? (S - 1 - i) : i; const size_t tok = (size_t)(seqbase + t); \
        raw.r = *(const u32x4*)(RKV + tok * 3072 + head * 64 + pg * 8); raw.k = *(const u32x4*)(RKV + tok * 3072 + 1024 + head * 64 + pg * 8); raw.v = *(const u32x4*)(RKV + tok * 3072 + 2048 + head * 64 + pg * 8); \
        raw.e = *(const u32x4*)(Ed + tok * 1024 + head * 64 + pg * 8); raw.a = *(const u32x4*)(Ad + tok * 1024 + head * 64 + pg * 8); } } while (0)
#define SCAN_PREP(buf, ch) do { if (prep) { LAS float* B_ = (LAS float*)(lds + (buf) * 49152); const int ls = pw * 8 + ptk; \
        float r_[8], k_[8], v_[8], a_[8], e_[8], kr_[8]; float ss_ = 0.f; \
        _Pragma("unroll") for (int x = 0; x < 4; ++x) { r_[2 * x] = bflo(raw.r[x]); r_[2 * x + 1] = bfhi(raw.r[x]); k_[2 * x] = bflo(raw.k[x]); k_[2 * x + 1] = bfhi(raw.k[x]); v_[2 * x] = bflo(raw.v[x]); v_[2 * x + 1] = bfhi(raw.v[x]); \
            a_[2 * x] = bflo(raw.a[x]); a_[2 * x + 1] = bfhi(raw.a[x]); e_[2 * x] = (float)__builtin_bit_cast(_Float16, (u16)(raw.e[x] & 0xffffu)); e_[2 * x + 1] = (float)__builtin_bit_cast(_Float16, (u16)(raw.e[x] >> 16)); } \
        _Pragma("unroll") for (int x = 0; x < 8; ++x) { kr_[x] = k_[x] * kkc[x]; ss_ += kr_[x] * kr_[x]; } \
        ss_ = dpp_add<0xB1>(ss_); ss_ = dpp_add<0x4E>(ss_); ss_ = dpp_add<0x141>(ss_); \
        const float rs_ = rsqrtf(fmaxf(ss_, 1e-24f)); float bn_ = 0.f; float o0_[8], o1_[8], o2_[8], o3_[8]; \
        _Pragma("unroll") for (int x = 0; x < 8; ++x) { const float kk_ = kr_[x] * rs_; o0_[x] = __expf(-e_[x]); o1_[x] = -kk_; o2_[x] = kk_ * a_[x]; o3_[x] = k_[x] * (1.0f + (a_[x] - 1.0f) * kac[x]); bn_ += r_[x] * o3_[x] * rkc[x]; } \
        bn_ = dpp_add<0xB1>(bn_); bn_ = dpp_add<0x4E>(bn_); bn_ = dpp_add<0x141>(bn_); \
        { const int i_ = (ch) * TS + ls; const int t_ = dir ? (S - 1 - i_) : i_; if (pg == 0) BON[((size_t)dir * TC + seqbase + t_) * 16 + head] = bn_; } \
        _Pragma("unroll") for (int x = 0; x < 2; ++x) { \
            *(LAS f32x4*)(B_ + (0 * TS + ls) * 64 + pg * 8 + 4 * x) = (f32x4){o0_[4 * x], o0_[4 * x + 1], o0_[4 * x + 2], o0_[4 * x + 3]}; \
            *(LAS f32x4*)(B_ + (1 * TS + ls) * 64 + pg * 8 + 4 * x) = (f32x4){o1_[4 * x], o1_[4 * x + 1], o1_[4 * x + 2], o1_[4 * x + 3]}; \
            *(LAS f32x4*)(B_ + (2 * TS + ls) * 64 + pg * 8 + 4 * x) = (f32x4){o2_[4 * x], o2_[4 * x + 1], o2_[4 * x + 2], o2_[4 * x + 3]}; \
            *(LAS f32x4*)(B_ + (3 * TS + ls) * 64 + pg * 8 + 4 * x) = (f32x4){o3_[4 * x], o3_[4 * x + 1], o3_[4 * x + 2], o3_[4 * x + 3]}; \
            *(LAS f32x4*)(B_ + (4 * TS + ls) * 64 + pg * 8 + 4 * x) = (f32x4){r_[4 * x], r_[4 * x + 1], r_[4 * x + 2], r_[4 * x + 3]}; \
            *(LAS f32x4*)(B_ + (5 * TS + ls) * 64 + pg * 8 + 4 * x) = (f32x4){v_[4 * x], v_[4 * x + 1], v_[4 * x + 2], v_[4 * x + 3]}; } } } while (0)
    float os[RR], po[RR];
#pragma unroll
    for (int r = 0; r < RR; ++r) { os[r] = 0.f; po[r] = 0.f; }
    SCAN_LOAD(0);
    SCAN_PREP(0, 0);
    __syncthreads();
    for (int ch = 0; ch < nch; ++ch) {
        if (ch + 1 < nch) SCAN_LOAD(ch + 1);
        if (w < NACT) {
            const LAS float* B = (const LAS float*)(lds + (ch & 1) * 49152);
            f32x4 W[J / 4], A[J / 4], Bb[J / 4], K[J / 4], R[J / 4];
#pragma unroll
            for (int q = 0; q < J / 4; ++q) { W[q] = *(const LAS f32x4*)(B + (0 * TS) * 64 + j0 + 4 * q); A[q] = *(const LAS f32x4*)(B + (1 * TS) * 64 + j0 + 4 * q); Bb[q] = *(const LAS f32x4*)(B + (2 * TS) * 64 + j0 + 4 * q);
                K[q] = *(const LAS f32x4*)(B + (3 * TS) * 64 + j0 + 4 * q); R[q] = *(const LAS f32x4*)(B + (4 * TS) * 64 + j0 + 4 * q); }
            float V[RR];
#pragma unroll
            for (int r = 0; r < RR; ++r) V[r] = B[(5 * TS) * 64 + row0 + r];
#pragma unroll
            for (int ls = 0; ls < TS; ++ls) {
                f32x4 nW[J / 4], nA[J / 4], nB[J / 4], nK[J / 4], nR[J / 4]; float nV[RR];
#pragma unroll
                for (int q = 0; q < J / 4; ++q) { nW[q] = W[q]; nA[q] = A[q]; nB[q] = Bb[q]; nK[q] = K[q]; nR[q] = R[q]; }
#pragma unroll
                for (int r = 0; r < RR; ++r) nV[r] = V[r];
                if (ls + 1 < TS) {
#pragma unroll
                    for (int q = 0; q < J / 4; ++q) { nW[q] = *(const LAS f32x4*)(B + (0 * TS + ls + 1) * 64 + j0 + 4 * q); nA[q] = *(const LAS f32x4*)(B + (1 * TS + ls + 1) * 64 + j0 + 4 * q); nB[q] = *(const LAS f32x4*)(B + (2 * TS + ls + 1) * 64 + j0 + 4 * q);
                        nK[q] = *(const LAS f32x4*)(B + (3 * TS + ls + 1) * 64 + j0 + 4 * q); nR[q] = *(const LAS f32x4*)(B + (4 * TS + ls + 1) * 64 + j0 + 4 * q); }
                    if (RR == 1) nV[0] = B[(5 * TS + ls + 1) * 64 + row0];
                    else if (RR == 2) { const f32x2 t = *(const LAS f32x2*)(B + (5 * TS + ls + 1) * 64 + row0); nV[0] = t[0]; nV[RR - 1] = t[1]; }
                    else { const f32x4 t = *(const LAS f32x4*)(B + (5 * TS + ls + 1) * 64 + row0);
#pragma unroll
                        for (int r = 0; r < RR; ++r) nV[r] = t[r]; }
                }
                __builtin_amdgcn_sched_barrier(0);
                float sa[RR];
#pragma unroll
                for (int r = 0; r < RR; ++r) { f32x2 p = st_[r][0] * (f32x2){A[0][0], A[0][1]};
#pragma unroll
                    for (int q = 1; q < J / 2; ++q) p = st_[r][q] * (f32x2){A[q >> 1][(q & 1) * 2], A[q >> 1][(q & 1) * 2 + 1]} + p;
                    sa[r] = p[0] + p[1]; }
                static_assert(RR == 2, "merged reduction written for two rows per lane");
                if (J == 4) merged_reduce16(sa[0], sa[1], po[0], po[1]); else merged_reduce8(sa[0], sa[1], po[0], po[1]);
                {
                    const int pl = (ls + TS - 1) & (TS - 1);
                    const bool mine = (jg == (pl & (L - 1)));
                    os[0] = mine ? po[0] : os[0]; os[1] = mine ? po[1] : os[1];
                    if ((pl & (L - 1)) == L - 1 && (ls > 0 || ch > 0)) {
                        const int i = (ls > 0 ? ch : ch - 1) * TS + (pl - (L - 1)) + jg; const int t = dir ? (S - 1 - i) : i;
                        *(unsigned*)(OD + ((size_t)dir * TC + seqbase + t) * 1024 + head * 64 + row0) = cvt_pk_bf16(os[0], os[1]);
                    }
                }
#pragma unroll
                for (int r = 0; r < RR; ++r) { const f32x2 sv = {sa[r], sa[r]}, vv = {V[r], V[r]}; f32x2 u = {0.f, 0.f};
#pragma unroll
                    for (int q = 0; q < J / 2; ++q) { const int qq = q >> 1, e = (q & 1) * 2;
                        st_[r][q] = st_[r][q] * (f32x2){W[qq][e], W[qq][e + 1]} + (sv * (f32x2){Bb[qq][e], Bb[qq][e + 1]} + vv * (f32x2){K[qq][e], K[qq][e + 1]});
                        u = st_[r][q] * (f32x2){R[qq][e], R[qq][e + 1]} + u; }
                    po[r] = u[0] + u[1]; }
                __builtin_amdgcn_sched_barrier(0);
#pragma unroll
                for (int q = 0; q < J / 4; ++q) { W[q] = nW[q]; A[q] = nA[q]; Bb[q] = nB[q]; K[q] = nK[q]; R[q] = nR[q]; }
#pragma unroll
                for (int r = 0; r < RR; ++r) V[r] = nV[r];
            }
        }
        if (ch + 1 < nch) SCAN_PREP((ch + 1) & 1, ch + 1);
        __syncthreads();
    }
    if (w < NACT) {
        if (J == 4) row_reduce2(po[0], po[1]); else half_reduce2(po[0], po[1]);
        const bool mine = (jg == L - 1);
        os[0] = mine ? po[0] : os[0]; os[1] = mine ? po[1] : os[1];
        const int i = (nch - 1) * TS + (TS - L) + jg; const int t = dir ? (S - 1 - i) : i;
        *(unsigned*)(OD + ((size_t)dir * TC + seqbase + t) * 1024 + head * 64 + row0) = cvt_pk_bf16(os[0], os[1]);
    }
#undef SCAN_LOAD
#undef SCAN_PREP
}
__device__ __forceinline__ void scan_phase(LAS unsigned char* lds, const u16* RKV, const u16* EAG, const float* kkw, const float* kaw, const float* rkw, u16* OD, float* BON, int S) {
    for (int item = blockIdx.x; item < 256; item += gridDim.x) {
        if (S == 4096) { const int id = item >> 1, half = item & 1, seq = id >> 5, rem = id & 31, head = rem >> 1, dir = rem & 1;
            scan_item<2, 4>(lds, RKV, EAG + (size_t)dir * TC * 1024, EAG + (size_t)(2 + dir) * TC * 1024, kkw, kaw, rkw, OD, BON, S, seq * S, head, dir, half * 32);
        } else { const int seq = item >> 5, rem = item & 31, head = rem >> 1, dir = rem & 1;
            scan_item<2, 8>(lds, RKV, EAG + (size_t)dir * TC * 1024, EAG + (size_t)(2 + dir) * TC * 1024, kkw, kaw, rkw, OD, BON, S, seq * S, head, dir, 0);
        }
        __syncthreads();
    }
}
__device__ __forceinline__ float quad_sum(float v) { v = dpp_add<0xB1>(v); v = dpp_add<0x4E>(v); return v; }
__device__ __forceinline__ void rwkv_post_phase(const u16* __restrict__ OD, const float* __restrict__ BON, const u16* __restrict__ RKV, const u16* __restrict__ EAG,
                                const float* __restrict__ lnw, const float* __restrict__ lnb, u16* Y) {
    const int lane = ltid() & 63, gw = blockIdx.x * 8 + (ltid() >> 6), nw = gridDim.x * 8, c0 = lane * 16;
    float lw[16], lb[16];
#pragma unroll
    for (int i = 0; i < 4; ++i) { const f32x4 c = *(const f32x4*)(lnw + c0 + 4 * i), d = *(const f32x4*)(lnb + c0 + 4 * i);
#pragma unroll
        for (int e = 0; e < 4; ++e) { lw[4 * i + e] = c[e]; lb[4 * i + e] = d[e]; } }
    for (int t = gw; t < TC; t += nw) {
        u32x4 oa[2], ob[2], vv[2], gg[2];
#pragma unroll
        for (int i = 0; i < 2; ++i) { oa[i] = *(const u32x4*)(OD + (size_t)t * 1024 + c0 + 8 * i); ob[i] = *(const u32x4*)(OD + ((size_t)TC + t) * 1024 + c0 + 8 * i);
            vv[i] = *(const u32x4*)(RKV + (size_t)t * 3072 + 2048 + c0 + 8 * i); gg[i] = *(const u32x4*)(EAG + ((size_t)4 * TC + t) * 1024 + c0 + 8 * i); }
        const float bsum = BON[(size_t)t * 16 + (lane >> 2)] + BON[((size_t)TC + t) * 16 + (lane >> 2)];
        float y[16];
#pragma unroll
        for (int i = 0; i < 16; ++i) { const int w_ = (i & 7) >> 1; const bool hi = i & 1; y[i] = (hi ? bfhi(oa[i >> 3][w_]) : bflo(oa[i >> 3][w_])) + (hi ? bfhi(ob[i >> 3][w_]) : bflo(ob[i >> 3][w_])); }
        float sm = 0.f;
#pragma unroll
        for (int i = 0; i < 16; ++i) sm += y[i];
        const float mean = quad_sum(sm) * (1.0f / 64.0f);
        float sv = 0.f;
#pragma unroll
        for (int i = 0; i < 16; ++i) { y[i] -= mean; sv += y[i] * y[i]; }
        const float rstd = rsqrtf(quad_sum(sv) * (1.0f / 64.0f) + 64e-5f);
        float o[16];
#pragma unroll
        for (int i = 0; i < 16; ++i) { const int w_ = (i & 7) >> 1; const bool hi = i & 1;
            const float v = hi ? bfhi(vv[i >> 3][w_]) : bflo(vv[i >> 3][w_]), g = hi ? bfhi(gg[i >> 3][w_]) : bflo(gg[i >> 3][w_]);
            o[i] = (y[i] * rstd * lw[i] + lb[i] + bsum * v) * g; }
#pragma unroll
        for (int i = 0; i < 2; ++i) { u32x4 w; w.x = cvt_pk_bf16(o[8 * i], o[8 * i + 1]); w.y = cvt_pk_bf16(o[8 * i + 2], o[8 * i + 3]); w.z = cvt_pk_bf16(o[8 * i + 4], o[8 * i + 5]); w.w = cvt_pk_bf16(o[8 * i + 6], o[8 * i + 7]);
            *(u32x4*)(Y + (size_t)t * 1024 + c0 + 8 * i) = w; }
    }
}
__device__ __forceinline__ void build_w2comb(u16* W2, const float* __restrict__ w2, const float* __restrict__ a2, const float* __restrict__ g2) {
    const size_t total = (size_t)384 * 5120, stride = (size_t)gridDim.x * NTHREADS;
    for (size_t idx = (size_t)blockIdx.x * NTHREADS + ltid(); idx < total; idx += stride) {
        const int k = (int)(idx / 5120), n = (int)(idx % 5120), sel = n >> 10, nn = n & 1023; float v = 0.f;
        if (sel == 0 && k < 64) v = w2[(size_t)k * 1024 + nn];
        else if (sel == 1 && k >= 64 && k < 128) v = w2[(size_t)(64 + (k - 64)) * 1024 + nn];
        else if (sel == 2 && k >= 128 && k < 192) v = a2[(size_t)(k - 128) * 1024 + nn];
        else if (sel == 3 && k >= 192 && k < 256) v = a2[(size_t)(64 + (k - 192)) * 1024 + nn];
        else if (sel == 4 && k >= 256 && k < 384) v = g2[(size_t)(k - 256) * 1024 + nn];
        W2[(size_t)n * 384 + k] = f2bf(v);
    }
}

namespace pg8 {
struct EpiAny {
    static constexpr bool PERM = true, AFTER_DRAIN = false;
    int mode; u16* o16; u16* o16b; u16* x; const float* b0; const float* b1; int ldc; int M; unsigned long long* ssw; const unsigned long long* ssr; const float* xin;
    __device__ __forceinline__ void operator()(const f32x4 (&acc)[2][2][4][2], const Unit& u, int wr, int wc, int fr, int fq) const {
        if (mode == 0) EpiStore16{o16, ldc, ssr}(acc, u, wr, wc, fr, fq);
        else if (mode == 1) EpiResid{x, xin, ssw}(acc, u, wr, wc, fr, fq);
        else if (mode == 2) EpiSwiglu{o16, ssr}(acc, u, wr, wc, fr, fq);
        else if (mode == 3) EpiRwkv{o16}(acc, u, wr, wc, fr, fq);
        else EpiLora2{o16, b0, b1, M}(acc, u, wr, wc, fr, fq);
    }
};
}

__global__ void __launch_bounds__(NTHREADS, 2) mega(Params p) {
    extern __shared__ __attribute__((aligned(16))) unsigned char lds_raw[];
    LAS unsigned char* lds = (LAS unsigned char*)lds_raw;
    ltid_setup();
    cg::grid_group grid = cg::this_grid();
    unsigned char* const ws = p.ws;
    u16* const Xb = (u16*)(ws + WS_ARENA + AR_A);
    unsigned char* const RA = (unsigned char*)p.out;
    const size_t gstride = (size_t)gridDim.x * NTHREADS;

    {
        float* const ROPE = (float*)(ws + WS_ROPE);
        for (size_t i = (size_t)blockIdx.x * NTHREADS + ltid(); i < 4096 * 8; i += gstride) { const int pos = (int)(i >> 3), fi = (int)(i & 7);
            const float inv = powf(500000.0f, -2.0f * (float)fi / 16.0f); const float ang = (float)pos * inv;
            ROPE[i * 2] = (float)cos((double)ang); ROPE[i * 2 + 1] = (float)sin((double)ang); }
    }
    if (blockIdx.x == 0) for (int i = ltid(); i < XCD_BAR_WORDS; i += NTHREADS) ((unsigned*)(ws + WS_BAR))[i] = 0u;
    __syncthreads();
    grid.sync();
    volatile LAS unsigned* xst = (volatile LAS unsigned*)(lds + LDS_BYTES - 16);
    if (ltid() == 0) { xst[0] = 0u; xst[1] = 0u; }
    __syncthreads();
    XcdBarrier xbar = xcd_barrier_post((unsigned*)(ws + WS_BAR), xst);
#ifndef DUP_MISC
#define DUP_MISC 1
#endif
#ifndef DUP_SYNC
#define DUP_SYNC 1
#endif
#ifndef DUP_STEP
#define DUP_STEP -1
#define DUP_PAR -1
#endif
#ifndef DUP_SCAN
#define DUP_SCAN 1
#endif
    for (int ph = 0; ph < 4 * NCHUNK * 15; ++ph) {
        const int l = ph / (NCHUNK * 15), c = (ph / 15) % NCHUNK, s = ph % 15;
        const int e = l >> 1; const bool odd = (l & 1) != 0;
        if (s < 3 && c != 0) continue;
        if (s == 6 && !odd) continue;
        if (s == 8 || s == 12 || s == 10) continue;
        const int S = c < 2 ? 4096 : 2048;
        u16* const Xc = Xb + (size_t)c * TC * 1024;
        const float* const Xin0 = c < 2 ? p.in[0] + (size_t)c * TC * 1024 : p.in[1];
        unsigned char* const AR = ws + WS_ARENA;
        u16* const XN = (u16*)RA; u16* const BUFB = (u16*)(AR + AR_B); u16* const BUFC = (u16*)(AR + AR_C); u16* const Y = (u16*)(AR + AR_D);
        bool do_gemm = false; const u16* gA = nullptr; const u16* gB = nullptr; int gM = TC, gN = 1024, gK = 1024; size_t g_grp = 0; int g_shift = 0, ngemm = 1;
        pg8::EpiAny E{0, nullptr, nullptr, nullptr, nullptr, nullptr, 0, TC, nullptr, nullptr, nullptr};
        unsigned long long* const SSC = (unsigned long long*)(ws + WS_SS); unsigned long long* const SSF = SSC + TC;
        for (int dup = 0; dup < ((s == 5 && odd) ? DUP_SCAN : ((s == DUP_STEP && (DUP_PAR < 0 || (int)odd == DUP_PAR)) ? 2 : DUP_MISC)); ++dup) {
        if (s == 0) {
            const float* mu = p.in[12] + (size_t)e * 6 * 1024;
            u16* const WMIX = (u16*)(ws + WS_WMIX);
            for (int j = 0; j < 22; ++j) {
                const float* src = nullptr; int ld_src = 1024, K = 1024, N = 1024, ld_dst = 1024, col0 = 0, mode = 0; u16* dst = nullptr; const float* s1 = nullptr;
                if (j < 17) {
                    if (!odd) {
                        if (j == 0) { src = p.in[9] + (size_t)e * 1024 * 3072; ld_src = 3072; N = 3072; dst = WMIX; }
                        else if (j == 1) { src = p.in[10] + (size_t)e * 1024 * 1024; dst = WMIX + (size_t)3072 * 1024; }
                        else continue;
                    } else {
                        const int half = j & 1, q = j >> 1;
                        u16* const WL1 = WMIX + (size_t)3072 * 1024;
                        if (q < 3) { if (half) continue; src = p.in[13 + q] + (size_t)e * 1024 * 1024; dst = WMIX + (size_t)q * 1024 * 1024; }
                        else if (q < 5) { const int d = q - 3; src = p.in[18] + ((size_t)e * 2 + d) * 1024 * 64; ld_src = 64; N = 64; dst = WL1 + (size_t)(d * 64) * 2048; ld_dst = 2048; col0 = half * 1024; if (half) s1 = mu + 1 * 1024; }
                        else if (q < 7) { const int d = q - 5; src = p.in[21] + ((size_t)e * 2 + d) * 1024 * 64; ld_src = 64; N = 64; dst = WL1 + (size_t)(128 + d * 64) * 2048; ld_dst = 2048; col0 = half * 1024; if (half) s1 = mu + 4 * 1024; }
                        else if (q == 7) { src = p.in[23] + (size_t)e * 1024 * 128; ld_src = 128; N = 128; dst = WL1 + (size_t)256 * 2048; ld_dst = 2048; col0 = half * 1024; if (half) s1 = mu + 5 * 1024; }
                        else { if (half) continue; src = p.in[16] + (size_t)e * 1024 * 1024; dst = (u16*)(ws + WS_WMIX + WMIX_C); }
                    }
                } else if (j == 17) { src = p.in[30] + (size_t)l * 1024 * 1024; dst = (u16*)(ws + WS_WQ); s1 = p.in[5] + l * 1024; }
                else if (j == 18) { src = p.in[31] + (size_t)l * 1024 * 2048; ld_src = 2048; N = 2048; dst = (u16*)(ws + WS_WKV); }
                else if (j == 19) { src = p.in[32] + (size_t)l * 1024 * 1024; dst = (u16*)(ws + WS_WO); }
                else if (j == 20) { src = p.in[33] + (size_t)l * 1024 * 5632; ld_src = 5632; N = 5632; dst = (u16*)(ws + WS_WGU); mode = 1; s1 = p.in[7] + l * 1024; }
                else { src = p.in[34] + (size_t)l * 2816 * 1024; K = 2816; dst = (u16*)(ws + WS_WDN); ld_dst = 2816; }
                tr_job(lds, src, ld_src, K, N, dst, ld_dst, col0, s1, mode, j * 37);
            }
            if (odd) {
                for (size_t i = (size_t)blockIdx.x * NTHREADS + ltid(); i < (size_t)128 * 2048 / 8; i += gstride) ((u32x4*)(WMIX + (size_t)3072 * 1024 + (size_t)384 * 2048))[i] = (u32x4){0u, 0u, 0u, 0u};
                build_w2comb((u16*)(ws + WS_WMIX + WMIX_B), p.in[19] + (size_t)e * 2 * 64 * 1024, p.in[22] + (size_t)e * 2 * 64 * 1024, p.in[24] + (size_t)e * 128 * 1024);
            }
        }
        if (s == 0) {
            for (int rep = 0; rep < 2; ++rep) norm_rows(p.in[2 + rep], nullptr, p.in[6] + l * 1024, (u16*)(ws + WS_MN) + (size_t)rep * 2048 * 1024, 1024, 2048);
        }
        else if (s == 1) { do_gemm = true; gA = (u16*)(ws + WS_MN); gB = (u16*)(ws + WS_WKV); gM = 4096; gN = 2048; E.o16 = (u16*)(ws + WS_KV); E.ldc = 2048; }
        else if (s == 3) { do_gemm = true; gB = (u16*)(ws + WS_WMIX);
            if (!odd) { gA = XN; gN = 3072; E.o16 = BUFB; E.ldc = 3072; }
            else { gA = BUFC; gN = 3072; E.o16 = BUFB; E.ldc = 3072; g_grp = (size_t)TC * 1024 * 2; g_shift = 2; ngemm = 2; } }
        else if (s == 4) {
            if (!odd) dil_attn_phase(lds, BUFB, BUFC, (float*)(AR + AR_C + (size_t)3 * TC * 512 * 2), (const float*)(ws + WS_ROPE), S);
            else { do_gemm = true; gA = (u16*)(RA + (size_t)TC * 4096); gB = (u16*)(ws + WS_WMIX + WMIX_B); gN = 5120; gK = 384; E.mode = 4; E.o16 = BUFC; E.b0 = p.in[17] + (size_t)e * 2048; E.b1 = p.in[20] + (size_t)e * 2048; }
        }
        else if (s == 5) {
            if (!odd) merge_conv_phase(BUFB, BUFC, (const float*)(AR + AR_C + (size_t)3 * TC * 512 * 2), p.in[11] + (size_t)e * 3 * 512, Y, S);
            else scan_phase(lds, BUFB, BUFC, p.in[25] + (size_t)e * 1024, p.in[26] + (size_t)e * 1024, p.in[27] + (size_t)e * 1024, (u16*)RA, (float*)(RA + (size_t)TC * 4096), S);
        }
        else if (s == 6) rwkv_post_phase((const u16*)RA, (const float*)(RA + (size_t)TC * 4096), BUFB, BUFC, p.in[28] + (size_t)e * 1024, p.in[29] + (size_t)e * 1024, Y);
        else if (s == 7) { do_gemm = true; gA = Y; gB = odd ? (u16*)(ws + WS_WMIX + WMIX_C) : (u16*)(ws + WS_WMIX) + (size_t)3072 * 1024; E.mode = 1; E.x = Xc; E.xin = (l == 0) ? Xin0 : nullptr; E.ssw = SSC; }
        else if (s == 9) { do_gemm = true; gA = Xc; gB = (u16*)(ws + WS_WQ); E.o16 = BUFB; E.ldc = 1024; E.ssr = SSC; }
        else if (s == 11) { do_gemm = true; gA = BUFC; gB = (u16*)(ws + WS_WO); E.mode = 1; E.x = Xc; E.xin = nullptr; E.ssw = SSF; }
        else if (s == 13) { do_gemm = true; gA = Xc; gB = (u16*)(ws + WS_WGU); gN = 5632; E.mode = 2; E.o16 = BUFB; E.ssr = SSF; }
        else if (s == 14) { do_gemm = true; gA = BUFB; gB = (u16*)(ws + WS_WDN); gK = 2816; E.mode = 1; E.x = Xc; E.xin = nullptr; }
        }
        if (do_gemm) {
            for (int gi = 0; gi < ngemm; ++gi) {
                if (gi == 1) { gA = XN; gB = (u16*)(ws + WS_WMIX) + (size_t)3072 * 1024; gN = 512; gK = 2048; g_grp = 0; g_shift = 0; E.mode = 3; E.o16 = (u16*)(RA + (size_t)TC * 4096); }
                pg8::Gemm g{gA, gB, gM, gN, gK, g_grp, g_shift}; pg8::StaticOrder SO; SO.init(gM, gN, (int)gridDim.x, (int)blockIdx.x);
                pg8::gemm_phase<pg8::EpiAny, pg8::StaticOrder, false>(lds, g, SO, E, nullptr);
            }
        }
        if (s == 9) {
            pg8::StaticOrder SO2; SO2.init(TC, 1024, (int)gridDim.x, (int)blockIdx.x); pg8::Unit u;
            for (int i = 0; SO2.next(i, u); ++i) { const int t0 = u.pm * 256, seq = t0 / S, qt = (t0 % S) >> 7;
                cross_attn_pair(lds, BUFB, (const u16*)(ws + WS_KV), c < 2 ? c * 1024 : 2048, BUFC, S, seq, u.pn, qt); }
        }
        {
            const int nc = (s == 2 && c == 0) ? 0 : ((s == 14 && c < 2) ? c + 1 : -1);
            if (nc >= 0) {
                const int Sn = nc < 2 ? 4096 : 2048;
                const float* xs = (nc < 2 ? p.in[0] + (size_t)nc * TC * 1024 : p.in[1]);
                const u16* xh = (l == 0) ? nullptr : Xb + (size_t)nc * TC * 1024;
                for (size_t i = (size_t)blockIdx.x * NTHREADS + ltid(); i < (size_t)2 * TC; i += gstride) SSC[i] = 0ull;
                if (odd) norm_shift(xs, xh, p.in[4] + l * 1024, p.in[12] + (size_t)e * 6 * 1024, XN, BUFC, Sn);
                else norm_rows(xs, xh, p.in[4] + l * 1024, XN, 1024, TC);
            }
        }
        if (s == 1) continue;
        for (int dup = 0; dup < DUP_SYNC; ++dup) xcd_barrier(xbar);
    }
    norm_final(Xb, p.out, p.in[8], 49152);
}

extern "C" void kernel_launch(void* const* d_in, const int* in_sizes, int n_in, void* d_out, int out_size, void* d_ws, size_t ws_size, hipStream_t stream) {
    static int grid_blocks = 0;
    if (!grid_blocks) {
        int dev = 0, cus = 0, per_cu = 0;
        if (n_in != 35 || out_size != 49152 * 1024 || ws_size < WS_END) { fprintf(stderr, "kernel_launch: unexpected problem (n_in %d out %d ws %zu need %zu)\n", n_in, out_size, ws_size, (size_t)WS_END); grid_blocks = -1; return; }
        (void)hipGetDevice(&dev);
        (void)hipDeviceGetAttribute(&cus, hipDeviceAttributeMultiprocessorCount, dev);
        (void)hipFuncSetAttribute((const void*)mega, hipFuncAttributeMaxDynamicSharedMemorySize, LDS_BYTES);
        (void)hipOccupancyMaxActiveBlocksPerMultiprocessor(&per_cu, (const void*)mega, NTHREADS, LDS_BYTES);
        if (per_cu < 1) { fprintf(stderr, "kernel_launch: occupancy query says %d blocks per CU\n", per_cu); }
        grid_blocks = cus > 0 ? cus : 256;
    }
    if (grid_blocks < 0) return;
    Params p{};
    for (int i = 0; i < 35; ++i) p.in[i] = (const float*)d_in[i];
    p.out = (float*)d_out; p.ws = (unsigned char*)d_ws;
    void* args[] = {&p};
    hipError_t err = hipLaunchCooperativeKernel((void*)mega, dim3(grid_blocks), dim3(NTHREADS), args, LDS_BYTES, stream);
    if (err != hipSuccess) fprintf(stderr, "cooperative launch failed: %s (grid %d)\n", hipGetErrorString(err), grid_blocks);
}
```
